# Optimizing an MI355X kernel written in HIP

```python
import jax, jax.numpy as jnp
from jax import lax
import numpy as np

D_MODEL = 1024
BATCH = 8
SEQ = 4096
DEPTH = 1

A_HEADS = 8
A_KV_HEADS = 2
A_HEAD_DIM = 64
IDX_HEADS = 16
IDX_DIM = 64
IDX_TOPK_MAX = 256
Q_BLOCK = 128
B_HEADS = 8
B_KEY_DIM = 64
B_VAL_DIM = 64
CONV_WIDTH = 4
CHUNK = 64
ROPE_THETA = 500000.0
ROPE_FRACTION_DEN = 4
PEER_HEADS = 8
PEER_KEY_DIM = 128
PEER_N_KEYS = 128
PEER_N_EXPERTS = PEER_N_KEYS * PEER_N_KEYS
PEER_TOPK = 16
PEER_TOKEN_BLOCK = 128
EPS = 1e-6

A_WIDTH = A_HEADS * A_HEAD_DIM
KV_WIDTH = A_KV_HEADS * A_HEAD_DIM
B_QK_WIDTH = B_HEADS * B_KEY_DIM
B_V_WIDTH = B_HEADS * B_VAL_DIM
CONV_CHANNELS = 2 * B_QK_WIDTH + B_V_WIDTH
IN_SPLITS = (A_WIDTH, KV_WIDTH, KV_WIDTH, IDX_HEADS * IDX_DIM, IDX_DIM, IDX_HEADS,
             B_QK_WIDTH, B_QK_WIDTH, B_V_WIDTH, B_V_WIDTH, B_HEADS, B_HEADS, D_MODEL, D_MODEL)
IN_WIDTH = sum(IN_SPLITS)

kernel_name = 'hybrid_dsa_gdn_peer_adaln'


def rms_norm(x, gain=None):
    xf = x.astype(jnp.float32)
    y = xf * lax.rsqrt(jnp.mean(xf * xf, axis=-1, keepdims=True) + EPS)
    if gain is not None:
        y = y * gain.astype(jnp.float32)
    return y.astype(x.dtype)


def l2_normalize(x):
    return x * lax.rsqrt(jnp.sum(x * x, axis=-1, keepdims=True) + EPS)


def partial_rotary(x, positions):
    hd = x.shape[-1]
    rd = hd // ROPE_FRACTION_DEN
    half = rd // 2
    inv_freq = jnp.power(jnp.float32(ROPE_THETA), -jnp.arange(half, dtype=jnp.float32) * (2.0 / rd))
    ang = positions.astype(jnp.float32)[..., None] * inv_freq
    cos = jnp.cos(ang)[:, :, None, :].astype(x.dtype)
    sin = jnp.sin(ang)[:, :, None, :].astype(x.dtype)
    x1 = x[..., :half]
    x2 = x[..., half:rd]
    return jnp.concatenate([x1 * cos - x2 * sin, x2 * cos + x1 * sin, x[..., rd:]], axis=-1)


def causal_short_conv(x, w):
    width = w.shape[0]
    seq = x.shape[1]
    xp = jnp.pad(x, ((0, 0), (width - 1, 0), (0, 0)))
    out = xp[:, 0:seq] * w[0]
    for i in range(1, width):
        out = out + xp[:, i:i + seq] * w[i]
    return out


def dsa_attention(q, k, v, q_idx, k_idx, w_idx):
    bsz, seq, _, dh = q.shape
    topk = min(IDX_TOPK_MAX, seq // 4)
    n_blocks = seq // Q_BLOCK
    rep = A_HEADS // A_KV_HEADS
    idx_scale = (IDX_HEADS ** -0.5) * (IDX_DIM ** -0.5)
    spos = jnp.arange(seq)

    def block(blk):
        t0 = blk * Q_BLOCK
        q_b = lax.dynamic_slice_in_dim(q, t0, Q_BLOCK, axis=1)
        qi_b = lax.dynamic_slice_in_dim(q_idx, t0, Q_BLOCK, axis=1)
        wi_b = lax.dynamic_slice_in_dim(w_idx, t0, Q_BLOCK, axis=1).astype(jnp.float32) * idx_scale
        tpos = t0 + jnp.arange(Q_BLOCK)
        logits = jnp.einsum('bthd,bsd->bths', qi_b, k_idx).astype(jnp.float32)
        score = jnp.einsum('bth,bths->bts', wi_b, jax.nn.relu(logits))
        causal = spos[None, :] <= tpos[:, None]
        score = jnp.where(causal[None], score, -jnp.inf)
        _, sel = lax.top_k(score, topk)
        valid = sel <= tpos[None, :, None]
        k_sel = jax.vmap(lambda kb_, ib: kb_[ib])(k, sel)
        v_sel = jax.vmap(lambda vb_, ib: vb_[ib])(v, sel)
        qg = q_b.reshape(bsz, Q_BLOCK, A_KV_HEADS, rep, dh)
        s = jnp.einsum('btgrd,btkgd->btgrk', qg, k_sel).astype(jnp.float32) * (dh ** -0.5)
        s = jnp.where(valid[:, :, None, None, :], s, -jnp.inf)
        p = jax.nn.softmax(s, axis=-1).astype(v.dtype)
        o = jnp.einsum('btgrk,btkgd->btgrd', p, v_sel)
        return o.reshape(bsz, Q_BLOCK, A_HEADS * dh)

    out = lax.map(block, jnp.arange(n_blocks))
    return jnp.moveaxis(out, 0, 1).reshape(bsz, seq, A_HEADS * dh)


def gated_delta_rule(q, k, v, g, beta):
    bsz, seq, nh, dk = q.shape
    dv = v.shape[-1]
    n = seq // CHUNK

    def chunks(t):
        t = jnp.moveaxis(t, 2, 1)
        return t.reshape(t.shape[:2] + (n, CHUNK) + t.shape[3:])

    q = chunks(q * (dk ** -0.5))
    k = chunks(k)
    v = chunks(v)
    g = chunks(g)
    beta = chunks(beta)
    gc = jnp.cumsum(g, axis=-1)
    pos = jnp.arange(CHUNK)
    incl = pos[:, None] >= pos[None, :]
    strict = pos[:, None] > pos[None, :]
    decay = jnp.exp(jnp.where(incl, gc[..., :, None] - gc[..., None, :], -jnp.inf))
    kb = k * beta[..., None]
    vb = v * beta[..., None]
    lower = jnp.where(strict, jnp.einsum('bhncd,bhnjd->bhncj', kb, k) * decay, 0.0)
    eye = jnp.eye(CHUNK, dtype=q.dtype)
    tmat = lax.linalg.triangular_solve(eye + lower, jnp.broadcast_to(eye, lower.shape),
                                       left_side=True, lower=True, unit_diagonal=True)
    u = tmat @ vb
    kcd = tmat @ (kb * jnp.exp(gc)[..., None])
    intra = jnp.einsum('bhncd,bhnjd->bhncj', q, k) * decay

    def step(state, xs):
        qc, kc, uc, kcdc, gcc, intrac = xs
        v_new = uc - kcdc @ state
        out = (qc * jnp.exp(gcc)[..., None]) @ state + intrac @ v_new
        glast = gcc[..., -1]
        state = state * jnp.exp(glast)[..., None, None] + jnp.einsum(
            'bhcd,bhce->bhde', kc * jnp.exp(glast[..., None] - gcc)[..., None], v_new)
        return state, out

    xs = tuple(jnp.moveaxis(t, 2, 0) for t in (q, k, u, kcd, gc, intra))
    state0 = jnp.zeros((bsz, nh, dk, dv), q.dtype)
    _, out = lax.scan(step, state0, xs)
    out = jnp.moveaxis(out, 0, 2).reshape(bsz, nh, seq, dv)
    return jnp.moveaxis(out, 1, 2)


def token_mixers(n, positions, w_in, conv_w, a_log, dt_bias, norm_b_w, w_pa, w_pb, w_o):
    bsz, seq, _ = n.shape
    proj = n @ w_in
    offs = np.cumsum(IN_SPLITS)[:-1].tolist()
    (qa, ka, va, qi, ki, wi, qb, kb, vb, zb, bb, ab, gate_a, gate_b) = jnp.split(proj, offs, axis=-1)

    qa = partial_rotary(qa.reshape(bsz, seq, A_HEADS, A_HEAD_DIM), positions)
    ka = partial_rotary(ka.reshape(bsz, seq, A_KV_HEADS, A_HEAD_DIM), positions)
    va = va.reshape(bsz, seq, A_KV_HEADS, A_HEAD_DIM)
    qi = partial_rotary(qi.reshape(bsz, seq, IDX_HEADS, IDX_DIM), positions)
    ki = partial_rotary(ki.reshape(bsz, seq, 1, IDX_DIM), positions)[:, :, 0]
    o_a = dsa_attention(qa, ka, va, qi, ki, wi)

    qkv = jax.nn.silu(causal_short_conv(jnp.concatenate([qb, kb, vb], axis=-1), conv_w))
    qb, kb, vb = jnp.split(qkv, [B_QK_WIDTH, 2 * B_QK_WIDTH], axis=-1)
    qb = l2_normalize(qb.reshape(bsz, seq, B_HEADS, B_KEY_DIM).astype(jnp.float32))
    kb = l2_normalize(kb.reshape(bsz, seq, B_HEADS, B_KEY_DIM).astype(jnp.float32))
    vb = vb.reshape(bsz, seq, B_HEADS, B_VAL_DIM).astype(jnp.float32)
    beta = jax.nn.sigmoid(bb.astype(jnp.float32))
    g = -jnp.exp(a_log.astype(jnp.float32)) * jax.nn.softplus(ab.astype(jnp.float32) + dt_bias.astype(jnp.float32))
    o_b = gated_delta_rule(qb, kb, vb, g, beta)
    z = jax.nn.silu(zb.reshape(bsz, seq, B_HEADS, B_VAL_DIM).astype(jnp.float32))
    o_b = (rms_norm(o_b, norm_b_w) * z).astype(n.dtype).reshape(bsz, seq, B_V_WIDTH)

    merged = jax.nn.sigmoid(gate_a) * (o_a @ w_pa) + jax.nn.sigmoid(gate_b) * (o_b @ w_pb)
    return merged @ w_o


def peer_channel_mixer(xn, wq, subkeys, u_tab, v_tab):
    bsz, seq, d = xn.shape
    kk = PEER_TOPK
    q = (xn @ wq).reshape(bsz, seq, PEER_HEADS, 2, PEER_KEY_DIM // 2)
    s = jnp.einsum('bshpd,hpnd->bshpn', q, subkeys).astype(jnp.float32)
    v1, i1 = lax.top_k(s[..., 0, :], kk)
    v2, i2 = lax.top_k(s[..., 1, :], kk)
    cand = (v1[..., :, None] + v2[..., None, :]).reshape(bsz, seq, PEER_HEADS, kk * kk)
    vals, ci = lax.top_k(cand, kk)
    e1 = jnp.take_along_axis(i1, ci // kk, axis=-1)
    e2 = jnp.take_along_axis(i2, ci % kk, axis=-1)
    experts = e1 * PEER_N_KEYS + e2
    gates = jax.nn.softmax(vals, axis=-1).astype(xn.dtype)
    n_tok = bsz * seq
    nb = n_tok // PEER_TOKEN_BLOCK
    xs = (xn.reshape(nb, PEER_TOKEN_BLOCK, d),
          experts.reshape(nb, PEER_TOKEN_BLOCK, PEER_HEADS, kk),
          gates.reshape(nb, PEER_TOKEN_BLOCK, PEER_HEADS, kk))

    def block(args):
        xb, eb, gb = args
        a = jnp.einsum('td,thkd->thk', xb, u_tab[eb])
        coef = jax.nn.gelu(a, approximate=False) * gb
        return jnp.einsum('thk,thkd->td', coef, v_tab[eb])

    out = lax.map(block, xs)
    return out.reshape(bsz, seq, d)


def setup_inputs(seed: int = 0) -> dict:
    key = jax.random.key(seed)
    ks = jax.random.split(key, 20)
    f32 = jnp.float32
    x = jax.random.normal(ks[0], (BATCH, SEQ, D_MODEL), f32)
    c = jax.random.normal(ks[1], (BATCH, D_MODEL), f32)
    offset = jax.random.randint(ks[2], (BATCH, 1), 0, SEQ)
    positions = (offset + jnp.arange(SEQ)[None, :]).astype(jnp.int32)
    w_ada = jax.random.normal(ks[3], (DEPTH, D_MODEL, 6 * D_MODEL), f32) * D_MODEL ** -0.5
    b_ada = 0.02 * jax.random.normal(ks[4], (DEPTH, 6 * D_MODEL), f32)
    w_in = jax.random.normal(ks[5], (DEPTH, D_MODEL, IN_WIDTH), f32) * D_MODEL ** -0.5
    conv_w = jax.random.normal(ks[6], (DEPTH, CONV_WIDTH, CONV_CHANNELS), f32) * CONV_WIDTH ** -0.5
    a_log = jnp.log(jax.random.uniform(ks[7], (DEPTH, B_HEADS), f32, minval=1.0, maxval=16.0))
    dt = jnp.exp(jax.random.uniform(ks[8], (DEPTH, B_HEADS), f32, minval=math_log(1e-3), maxval=math_log(1e-1)))
    dt_bias = dt + jnp.log(-jnp.expm1(-dt))
    norm_b_w = 1.0 + 0.02 * jax.random.normal(ks[9], (DEPTH, B_VAL_DIM), f32)
    w_pa = jax.random.normal(ks[10], (DEPTH, A_WIDTH, D_MODEL), f32) * A_WIDTH ** -0.5
    w_pb = jax.random.normal(ks[11], (DEPTH, B_V_WIDTH, D_MODEL), f32) * B_V_WIDTH ** -0.5
    w_o = jax.random.normal(ks[12], (DEPTH, D_MODEL, D_MODEL), f32) * D_MODEL ** -0.5
    peer_wq = jax.random.normal(ks[13], (DEPTH, D_MODEL, PEER_HEADS * PEER_KEY_DIM), f32) * D_MODEL ** -0.5
    peer_subkeys = jax.random.normal(ks[14], (DEPTH, PEER_HEADS, 2, PEER_N_KEYS, PEER_KEY_DIM // 2), f32) * (PEER_KEY_DIM // 2) ** -0.5
    peer_u = jax.random.normal(ks[15], (DEPTH, PEER_N_EXPERTS, D_MODEL), f32) * D_MODEL ** -0.5
    peer_v = jax.random.normal(ks[16], (DEPTH, PEER_N_EXPERTS, D_MODEL), f32) * PEER_HEADS ** -0.5
    final_norm_w = 1.0 + 0.02 * jax.random.normal(ks[17], (D_MODEL,), f32)
    return {'x': x, 'c': c, 'positions': positions, 'w_ada': w_ada, 'b_ada': b_ada, 'w_in': w_in,
            'conv_w': conv_w, 'a_log': a_log, 'dt_bias': dt_bias, 'norm_b_w': norm_b_w,
            'w_pa': w_pa, 'w_pb': w_pb, 'w_o': w_o, 'peer_wq': peer_wq, 'peer_subkeys': peer_subkeys,
            'peer_u': peer_u, 'peer_v': peer_v, 'final_norm_w': final_norm_w}


def math_log(v):
    return float(np.log(v))


def reference(x, c, positions, w_ada, b_ada, w_in, conv_w, a_log, dt_bias, norm_b_w,
              w_pa, w_pb, w_o, peer_wq, peer_subkeys, peer_u, peer_v, final_norm_w):
    h = x
    c_act = jax.nn.silu(c)
    for layer in range(DEPTH):
        mod = c_act @ w_ada[layer] + b_ada[layer]
        sh1, sc1, gt1, sh2, sc2, gt2 = jnp.split(mod, 6, axis=-1)
        n1 = rms_norm(h) * (1.0 + sc1[:, None, :]) + sh1[:, None, :]
        y1 = token_mixers(n1, positions, w_in[layer], conv_w[layer], a_log[layer], dt_bias[layer],
                          norm_b_w[layer], w_pa[layer], w_pb[layer], w_o[layer])
        h = h + gt1[:, None, :] * y1
        n2 = rms_norm(h) * (1.0 + sc2[:, None, :]) + sh2[:, None, :]
        y2 = peer_channel_mixer(n2, peer_wq[layer], peer_subkeys[layer], peer_u[layer], peer_v[layer])
        h = h + gt2[:, None, :] * y2
    return rms_norm(h, final_norm_w)
```

```cpp
#ifdef EMU
#include "hip_emu.h"
#else
#include <hip/hip_runtime.h>
#include <hip/hip_cooperative_groups.h>
#include <cstdio>
#include <cstdint>
#endif

#ifndef MULTI_LAUNCH
#define MULTI_LAUNCH 1
#endif

#ifdef EMU
#ifndef EMU_B
#define EMU_B 2
#endif
#ifndef EMU_S
#define EMU_S 512
#endif
#ifndef EMU_D
#define EMU_D 256
#endif
constexpr int BATCH = EMU_B, SEQ = EMU_S, DM = EMU_D;
#else
constexpr int BATCH = 8, SEQ = 4096, DM = 1024;
#endif
constexpr int NTOK = BATCH * SEQ;
constexpr int TOPK = (SEQ / 4 < 256) ? SEQ / 4 : 256;
constexpr int NCHK = SEQ / 64;
constexpr int NEXP = 16384;
constexpr int C_QA = 0, C_KA = 512, C_VA = 640, C_QI = 768, C_KI = 1792, C_WI = 1856, C_BB = 1872, C_AB = 1880;
constexpr int C_QB = 1920, C_ZB = 3456, C_GA = 3968;
constexpr int NP = 3968 + 2 * DM;
constexpr int IN_W = 3936 + 2 * DM;
constexpr int LP1 = 1920, LP2 = 1536, LP3 = 512, LP4 = 2 * DM;
constexpr int QBT = 16;
constexpr float EPSN = 1e-6f;

typedef _Float16 hf;
typedef _Float16 h8 __attribute__((ext_vector_type(8)));
typedef _Float16 h4 __attribute__((ext_vector_type(4)));
typedef float f4 __attribute__((ext_vector_type(4)));
#define DI __device__ __forceinline__

constexpr size_t al256(size_t x) { return (x + 255) & ~size_t(255); }
constexpr size_t O_MOD = 0;
constexpr size_t O_CNT = O_MOD + al256((size_t)BATCH * 6 * DM * 4);
constexpr size_t O_CS = O_CNT + 256;
constexpr size_t O_AUX = O_CS + al256((size_t)NTOK * 16 * 4);
constexpr size_t O_WIN = O_AUX + al256((size_t)NTOK * 32 * 4);
constexpr size_t O_WPA = O_WIN + al256((size_t)NP * DM * 2);
constexpr size_t O_WPB = O_WPA + al256((size_t)DM * 512 * 2);
constexpr size_t O_WO = O_WPB + al256((size_t)DM * 512 * 2);
constexpr size_t O_WQ = O_WO + al256((size_t)DM * DM * 2);
constexpr size_t O_SUBK = O_WQ + al256((size_t)1024 * DM * 2);
constexpr size_t O_EG = O_SUBK + al256((size_t)8 * 2 * 128 * 64 * 2);
constexpr size_t O_P1 = O_EG + al256((size_t)BATCH * 8 * NCHK * 4);
constexpr size_t O_P3 = O_P1 + al256((size_t)NTOK * LP1 * 2);
constexpr size_t O_P4 = O_P3 + al256((size_t)NTOK * LP3 * 2);
constexpr size_t R_BYTES = ((size_t)NTOK * DM * 2 > (size_t)NTOK * 1024) ? (size_t)NTOK * DM * 2 : (size_t)NTOK * 1024;
constexpr size_t O_R = O_P4 + al256((size_t)NTOK * LP4 * 2);
constexpr size_t O_P2 = O_R + al256(R_BYTES);
constexpr size_t O_OB = O_P2 + al256((size_t)NTOK * LP2 * 2);
constexpr size_t WS_TOTAL = O_OB + al256((size_t)NTOK * 512 * 2);
constexpr size_t O_INTRA = O_R;
constexpr size_t O_SCR = O_R + (size_t)NTOK * 1024;
constexpr size_t O_MERGED = O_R;
constexpr size_t O_N2H = O_R + (size_t)NTOK * DM * 2;
constexpr size_t DSCAN_BYTES = (size_t)NTOK * 4096;
constexpr size_t UV_BYTES = (size_t)2 * NEXP * DM * 2;

struct Params {
  const float *x, *c; const int* pos;
  const float *w_ada, *b_ada, *w_in, *conv_w, *a_log, *dt_bias, *norm_b_w, *w_pa, *w_pb, *w_o, *wq, *subk, *pu, *pv, *fnw;
  float* out; char* ws; char* dscan; char* uv;
};

DI f4 mfma16(h8 a, h8 b, f4 c) { return __builtin_amdgcn_mfma_f32_16x16x32_f16(a, b, c, 0, 0, 0); }
#ifdef EMU
DI void wave_sync() { int z = 0, r; emu_collective(&z, 4, &r, 4, [](EmuWave*) {}); }
DI void gmem_wave_sync() { wave_sync(); }
#else
DI void wave_sync() { __builtin_amdgcn_fence(__ATOMIC_RELEASE, "wavefront"); __builtin_amdgcn_wave_barrier(); __builtin_amdgcn_fence(__ATOMIC_ACQUIRE, "wavefront"); }
DI void gmem_wave_sync() { __builtin_amdgcn_fence(__ATOMIC_SEQ_CST, "workgroup"); __builtin_amdgcn_wave_barrier(); }
#endif
DI float wave_sum(float v) { for (int m = 32; m >= 1; m >>= 1) v += __shfl_xor(v, m); return v; }
DI int wave_sum_i(int v) { for (int m = 32; m >= 1; m >>= 1) v += __shfl_xor(v, m); return v; }
DI float sigmoidf_(float x) { return 1.0f / (1.0f + __expf(-x)); }
DI float siluf_(float x) { return x / (1.0f + __expf(-x)); }
DI float softplusf_(float x) { return x > 20.f ? x : log1pf(__expf(x)); }
DI unsigned f2ord(float f) { unsigned u = __builtin_bit_cast(unsigned, f); return (u & 0x80000000u) ? ~u : (u | 0x80000000u); }
DI float ord2f(unsigned k) { unsigned u = (k & 0x80000000u) ? (k & 0x7fffffffu) : ~k; return __builtin_bit_cast(float, u); }
DI h8 cat44(h4 a, h4 b) { h8 r; r[0] = a[0]; r[1] = a[1]; r[2] = a[2]; r[3] = a[3]; r[4] = b[0]; r[5] = b[1]; r[6] = b[2]; r[7] = b[3]; return r; }
DI h8 cvt_f4f4(f4 a, f4 b) { h8 r; r[0] = (hf)a[0]; r[1] = (hf)a[1]; r[2] = (hf)a[2]; r[3] = (hf)a[3]; r[4] = (hf)b[0]; r[5] = (hf)b[1]; r[6] = (hf)b[2]; r[7] = (hf)b[3]; return r; }
DI h8 permload(const hf* p, int q) { return cat44(*(const h4*)(p + 4 * q), *(const h4*)(p + 16 + 4 * q)); }

template <int BM>
DI void gemm_mainloop(f4 (&acc)[BM / 32][4], const hf* __restrict__ A, int lda, const hf* __restrict__ Bt, int ldb, int K, int m0, int n0, char* smem) {
  constexpr int MT = BM / 32, ACH = BM * 8 / 256;
  hf* sA = (hf*)smem; hf* sB = sA + BM * 72;
  const int tid = threadIdx.x, lane = tid & 63, wave = tid >> 6, wm = wave >> 1, wn = wave & 1;
  h8 ra[ACH], rb[4];
#pragma unroll
  for (int i = 0; i < ACH; ++i) { int idx = tid + i * 256, r = idx >> 3, c = idx & 7; ra[i] = *(const h8*)(A + (size_t)(m0 + r) * lda + c * 8); }
#pragma unroll
  for (int i = 0; i < 4; ++i) { int idx = tid + i * 256, r = idx >> 3, c = idx & 7; rb[i] = *(const h8*)(Bt + (size_t)(n0 + r) * ldb + c * 8); }
  for (int k0 = 0; k0 < K; k0 += 64) {
    __syncthreads();
#pragma unroll
    for (int i = 0; i < ACH; ++i) { int idx = tid + i * 256, r = idx >> 3, c = idx & 7; *(h8*)(sA + r * 72 + c * 8) = ra[i]; }
#pragma unroll
    for (int i = 0; i < 4; ++i) { int idx = tid + i * 256, r = idx >> 3, c = idx & 7; *(h8*)(sB + r * 72 + c * 8) = rb[i]; }
    __syncthreads();
    if (k0 + 64 < K) {
#pragma unroll
      for (int i = 0; i < ACH; ++i) { int idx = tid + i * 256, r = idx >> 3, c = idx & 7; ra[i] = *(const h8*)(A + (size_t)(m0 + r) * lda + k0 + 64 + c * 8); }
#pragma unroll
      for (int i = 0; i < 4; ++i) { int idx = tid + i * 256, r = idx >> 3, c = idx & 7; rb[i] = *(const h8*)(Bt + (size_t)(n0 + r) * ldb + k0 + 64 + c * 8); }
    }
#pragma unroll
    for (int ks = 0; ks < 2; ++ks) {
      h8 af[MT], bf[4];
#pragma unroll
      for (int mt = 0; mt < MT; ++mt) af[mt] = *(const h8*)(sA + (wm * (BM / 2) + mt * 16 + (lane & 15)) * 72 + ks * 32 + (lane >> 4) * 8);
#pragma unroll
      for (int nt = 0; nt < 4; ++nt) bf[nt] = *(const h8*)(sB + (wn * 64 + nt * 16 + (lane & 15)) * 72 + ks * 32 + (lane >> 4) * 8);
#pragma unroll
      for (int mt = 0; mt < MT; ++mt)
#pragma unroll
        for (int nt = 0; nt < 4; ++nt) acc[mt][nt] = mfma16(af[mt], bf[nt], acc[mt][nt]);
    }
  }
}
template <int MT> DI void zero_acc(f4 (&acc)[MT][4]) {
#pragma unroll
  for (int i = 0; i < MT; ++i)
#pragma unroll
    for (int j = 0; j < 4; ++j) acc[i][j] = f4{0.f, 0.f, 0.f, 0.f};
}

DI int win_colmap(int c) {
  if (c < 1872) return c;
  if (c < 1880) return 3920 + (c - 1872);
  if (c < 1888) return 3928 + (c - 1880);
  if (c < 1920) return -1;
  if (c < 3968) return 1872 + (c - 1920);
  return 3936 + (c - 3968);
}
DI void transpose_tile(const float* src, int lds_, hf* dst, int K, int k0, int n0, bool use_map, char* smem) {
  float* t = (float*)smem;
  const int tid = threadIdx.x, c = tid & 63, r0 = tid >> 6;
  int sc = use_map ? win_colmap(n0 + c) : (n0 + c);
  __syncthreads();
#pragma unroll 4
  for (int i = 0; i < 16; ++i) { int r = i * 4 + r0; float v = sc >= 0 ? src[(size_t)(k0 + r) * lds_ + sc] : 0.f; t[c * 65 + r] = v; }
  __syncthreads();
#pragma unroll 4
  for (int i = 0; i < 16; ++i) { int r = i * 4 + r0; dst[(size_t)(n0 + r) * K + k0 + c] = (hf)t[r * 65 + c]; }
}
DI void phase_A(const Params& p, char* smem) {
  float* mod = (float*)(p.ws + O_MOD);
  const int tid = threadIdx.x, lane = tid & 63, wave = tid >> 6;
  constexpr int N_MOD = 6 * DM / 64;
  constexpr int N_WIN = (NP / 64) * (DM / 64), N_WPA = (DM / 64) * 8, N_WO = (DM / 64) * (DM / 64), N_WQ = 16 * (DM / 64);
  constexpr int N_SUBK = 8, N_CS = NTOK / 256;
  constexpr int T1 = N_MOD, T2 = T1 + N_WIN, T3 = T2 + N_WPA, T4 = T3 + N_WPA, T5 = T4 + N_WO, T6 = T5 + N_WQ, T7 = T6 + N_SUBK, T8 = T7 + N_CS;
  if (blockIdx.x == 0 && tid < 16) ((int*)(p.ws + O_CNT))[tid] = 0;
  for (int it = blockIdx.x; it < T8; it += gridDim.x) {
    if (it < T1) {
      float* sil = (float*)smem;
      float* red = sil + BATCH * DM;
      __syncthreads();
      for (int i = tid; i < BATCH * DM; i += 256) sil[i] = siluf_(p.c[i]);
      __syncthreads();
      const int j = it * 64 + lane;
      float a[BATCH];
#pragma unroll
      for (int b = 0; b < BATCH; ++b) a[b] = 0.f;
      for (int k = wave * (DM / 4); k < (wave + 1) * (DM / 4); ++k) {
        float w = p.w_ada[(size_t)k * 6 * DM + j];
#pragma unroll
        for (int b = 0; b < BATCH; ++b) a[b] += sil[b * DM + k] * w;
      }
#pragma unroll
      for (int b = 0; b < BATCH; ++b) red[(wave * BATCH + b) * 64 + lane] = a[b];
      __syncthreads();
      if (wave == 0) {
#pragma unroll
        for (int b = 0; b < BATCH; ++b) {
          float s = red[(0 * BATCH + b) * 64 + lane] + red[(1 * BATCH + b) * 64 + lane] + red[(2 * BATCH + b) * 64 + lane] + red[(3 * BATCH + b) * 64 + lane];
          mod[(size_t)b * 6 * DM + j] = s + p.b_ada[j];
        }
      }
    } else if (it < T2) { int t = it - T1; transpose_tile(p.w_in, IN_W, (hf*)(p.ws + O_WIN), DM, (t % (DM / 64)) * 64, (t / (DM / 64)) * 64, true, smem); }
    else if (it < T3) { int t = it - T2; transpose_tile(p.w_pa, DM, (hf*)(p.ws + O_WPA), 512, (t % 8) * 64, (t / 8) * 64, false, smem); }
    else if (it < T4) { int t = it - T3; transpose_tile(p.w_pb, DM, (hf*)(p.ws + O_WPB), 512, (t % 8) * 64, (t / 8) * 64, false, smem); }
    else if (it < T5) { int t = it - T4; transpose_tile(p.w_o, DM, (hf*)(p.ws + O_WO), DM, (t % (DM / 64)) * 64, (t / (DM / 64)) * 64, false, smem); }
    else if (it < T6) { int t = it - T5; transpose_tile(p.wq, 1024, (hf*)(p.ws + O_WQ), DM, (t % (DM / 64)) * 64, (t / (DM / 64)) * 64, false, smem); }
    else if (it < T7) { int t = it - T6; hf* d = (hf*)(p.ws + O_SUBK); for (int i = tid; i < 16384; i += 256) d[t * 16384 + i] = (hf)p.subk[t * 16384 + i]; }
    else {
      int tok = (it - T7) * 256 + tid;
      float* cs = (float*)(p.ws + O_CS) + (size_t)tok * 16;
      float pos = (float)p.pos[tok];
#pragma unroll
      for (int i = 0; i < 8; ++i) { float inv = powf(500000.0f, -(float)i * 0.125f); float ang = pos * inv; cs[i] = cosf(ang); cs[8 + i] = sinf(ang); }
    }
  }
}

DI void adaln_rows(const float* src, hf* dst, const float* mod, int sh_off, int sc_off) {
  const int tid = threadIdx.x, lane = tid & 63, wave = tid >> 6;
  for (int row = blockIdx.x * 4 + wave; row < NTOK; row += gridDim.x * 4) {
    const float* xr = src + (size_t)row * DM; const int b = row / SEQ;
    float v[DM / 64]; float ss = 0.f;
#pragma unroll
    for (int i = 0; i < DM / 256; ++i) { f4 t = *(const f4*)(xr + i * 256 + lane * 4); v[4 * i] = t[0]; v[4 * i + 1] = t[1]; v[4 * i + 2] = t[2]; v[4 * i + 3] = t[3]; ss += t[0] * t[0] + t[1] * t[1] + t[2] * t[2] + t[3] * t[3]; }
    ss = wave_sum(ss);
    float rstd = rsqrtf(ss * (1.0f / DM) + EPSN);
    const float* mb = mod + (size_t)b * 6 * DM;
#pragma unroll
    for (int i = 0; i < DM / 256; ++i) {
      int d = i * 256 + lane * 4; h4 o;
#pragma unroll
      for (int j = 0; j < 4; ++j) o[j] = (hf)(v[4 * i + j] * rstd * (1.0f + mb[sc_off + d + j]) + mb[sh_off + d + j]);
      *(h4*)(dst + (size_t)row * DM + d) = o;
    }
  }
}

DI void phase_C(const Params& p, char* smem) {
  const hf* n1h = (const hf*)(p.ws + O_R); const hf* WinT = (const hf*)(p.ws + O_WIN);
  hf* P1 = (hf*)(p.ws + O_P1); hf* P2 = (hf*)(p.ws + O_P2); hf* P3 = (hf*)(p.ws + O_P3); hf* P4 = (hf*)(p.ws + O_P4);
  float* aux = (float*)(p.ws + O_AUX); const float* cs = (const float*)(p.ws + O_CS);
  const int lane = threadIdx.x & 63, wave = threadIdx.x >> 6, wm = wave >> 1, wn = wave & 1, q = lane >> 4, cl = lane & 15;
  constexpr int NTN = NP / 128, NTM = NTOK / 128;
  for (int t = blockIdx.x; t < NTN * NTM; t += gridDim.x) {
    const int tn = t % NTN, tm = t / NTN, m0 = tm * 128, n0 = tn * 128;
    f4 acc[4][4]; zero_acc<4>(acc);
    gemm_mainloop<128>(acc, n1h, DM, WinT, DM, DM, m0, n0, smem);
    const bool rope = (tn <= 4) || (tn >= 6 && tn <= 14);
#pragma unroll
    for (int mt = 0; mt < 4; ++mt) {
#pragma unroll
      for (int nt = 0; nt < 4; ++nt) {
        f4 v = acc[mt][nt];
        const int col = n0 + wn * 64 + nt * 16 + cl;
        const int rbase = m0 + wm * 64 + mt * 16 + q * 4;
        if (rope && nt == 0 && !(tn == 14 && wn == 1)) {
#pragma unroll
          for (int r = 0; r < 4; ++r) {
            float pv = __shfl_xor(v[r], 8);
            const float* c2 = cs + (size_t)(rbase + r) * 16; float co = c2[cl & 7], si = c2[8 + (cl & 7)];
            v[r] = (cl < 8) ? (v[r] * co - pv * si) : (v[r] * co + pv * si);
          }
        }
        if (tn < 4) { v = v * 0.125f; }
        if (tn < 14 || (tn == 14 && wn == 0)) {
#pragma unroll
          for (int r = 0; r < 4; ++r) P1[(size_t)(rbase + r) * LP1 + col] = (hf)v[r];
        } else if (tn == 14) {
          const int lc = nt * 16 + cl;
          if (lc < 32) {
            const int hh = lc & 7;
#pragma unroll
            for (int r = 0; r < 4; ++r) {
              float o;
              if (lc < 16) o = v[r] * (0.25f * 0.125f);
              else if (lc < 24) o = sigmoidf_(v[r]);
              else o = -__expf(p.a_log[hh]) * softplusf_(v[r] + p.dt_bias[hh]);
              aux[(size_t)(rbase + r) * 32 + lc] = o;
            }
          }
        } else if (col < C_ZB) {
#pragma unroll
          for (int r = 0; r < 4; ++r) P2[(size_t)(rbase + r) * LP2 + (col - C_QB)] = (hf)v[r];
        } else if (col < C_GA) {
#pragma unroll
          for (int r = 0; r < 4; ++r) P3[(size_t)(rbase + r) * LP3 + (col - C_ZB)] = (hf)v[r];
        } else {
#pragma unroll
          for (int r = 0; r < 4; ++r) P4[(size_t)(rbase + r) * LP4 + (col - C_GA)] = (hf)sigmoidf_(v[r]);
        }
      }
    }
  }
}

DI void phase_D1(const Params& p, char* smem) {
  const hf* P2 = (const hf*)(p.ws + O_P2); const float* aux = (const float*)(p.ws + O_AUX);
  hf* Qs = (hf*)smem;
  hf* Ks = Qs + 64 * 72;
  float* RHS = (float*)(Ks + 64 * 72);
  float* Lm = RHS + 64 * 128;
  float* gcs = Lm + 64 * 64;
  float* bts = gcs + 64;
  const int tid = threadIdx.x, lane = tid & 63, wave = tid >> 6, q = lane >> 4, cl = lane & 15;
  constexpr size_t MSZ = (size_t)NTOK * 512;
  hf* uT = (hf*)p.dscan; hf* wm_ = uT + MSZ; hf* qg = wm_ + MSZ; hf* kdT = qg + MSZ; hf* intra = (hf*)(p.ws + O_INTRA);
  float* eg = (float*)(p.ws + O_EG);
  for (int it = blockIdx.x; it < BATCH * 8 * NCHK; it += gridDim.x) {
    const int c = it % NCHK, h = (it / NCHK) % 8, b = it / (NCHK * 8);
    const size_t cbase = (size_t)it * 4096;
    const int tk = tid >> 2, qq = tid & 3, t0 = c * 64;
    const size_t grow = (size_t)b * SEQ + t0 + tk;
    __syncthreads();
    float g = aux[grow * 32 + 24 + h], beta = aux[grow * 32 + 16 + h];
    if (qq == 0) { gcs[tk] = g; bts[tk] = beta; }
    float val[3][16];
#pragma unroll
    for (int m = 0; m < 3; ++m) {
      const int ch0 = m * 512 + h * 64 + qq * 16;
#pragma unroll
      for (int e = 0; e < 16; ++e) val[m][e] = 0.f;
#pragma unroll
      for (int i = 0; i < 4; ++i) {
        const int tt = t0 + tk - 3 + i;
        if (tt >= 0) {
          const hf* src = P2 + ((size_t)b * SEQ + tt) * LP2 + ch0;
          h8 x0 = *(const h8*)src, x1 = *(const h8*)(src + 8);
          const float* wv = p.conv_w + (size_t)i * 1536 + ch0;
#pragma unroll
          for (int e = 0; e < 8; ++e) { val[m][e] += (float)x0[e] * wv[e]; val[m][8 + e] += (float)x1[e] * wv[8 + e]; }
        }
      }
#pragma unroll
      for (int e = 0; e < 16; ++e) val[m][e] = siluf_(val[m][e]);
    }
    float sq = 0.f, sk = 0.f;
#pragma unroll
    for (int e = 0; e < 16; ++e) { sq += val[0][e] * val[0][e]; sk += val[1][e] * val[1][e]; }
    sq += __shfl_xor(sq, 1); sq += __shfl_xor(sq, 2); sk += __shfl_xor(sk, 1); sk += __shfl_xor(sk, 2);
    const float nq = rsqrtf(sq + EPSN) * 0.125f, nk = rsqrtf(sk + EPSN);
    __syncthreads();
    if (tid == 0) { float s = 0.f; for (int i = 0; i < 64; ++i) { s += gcs[i]; gcs[i] = s; } }
    __syncthreads();
    const float gc = gcs[tk], glast = gcs[63];
    const float egc = __expf(gc), ekd = __expf(glast - gc);
    if (tid == 0) eg[it] = __expf(glast);
#pragma unroll
    for (int e = 0; e < 16; ++e) {
      const int ch = qq * 16 + e;
      const float qv = val[0][e] * nq, kv = val[1][e] * nk, vv = val[2][e];
      Qs[tk * 72 + ch] = (hf)qv; Ks[tk * 72 + ch] = (hf)kv;
      RHS[tk * 128 + ch] = vv * beta; RHS[tk * 128 + 64 + ch] = kv * beta * egc;
      qg[cbase + tk * 64 + ch] = (hf)(qv * egc);
      kdT[cbase + ch * 64 + tk] = (hf)(kv * ekd);
    }
    __syncthreads();
    {
      f4 akk[4], aqk[4];
#pragma unroll
      for (int nt = 0; nt < 4; ++nt) { akk[nt] = f4{0, 0, 0, 0}; aqk[nt] = f4{0, 0, 0, 0}; }
#pragma unroll
      for (int ks = 0; ks < 2; ++ks) {
        h8 ak = *(const h8*)(Ks + (wave * 16 + cl) * 72 + ks * 32 + q * 8);
        h8 aq = *(const h8*)(Qs + (wave * 16 + cl) * 72 + ks * 32 + q * 8);
#pragma unroll
        for (int nt = 0; nt < 4; ++nt) {
          h8 bk = *(const h8*)(Ks + (nt * 16 + cl) * 72 + ks * 32 + q * 8);
          akk[nt] = mfma16(ak, bk, akk[nt]); aqk[nt] = mfma16(aq, bk, aqk[nt]);
        }
      }
#pragma unroll
      for (int nt = 0; nt < 4; ++nt) {
        const int j = nt * 16 + cl; const float gj = gcs[j];
#pragma unroll
        for (int r = 0; r < 4; ++r) {
          const int i = wave * 16 + q * 4 + r;
          const float dec = (i >= j) ? __expf(gcs[i] - gj) : 0.f;
          Lm[i * 64 + j] = (i > j) ? bts[i] * akk[nt][r] * dec : 0.f;
          intra[cbase + i * 64 + j] = (hf)(aqk[nt][r] * dec);
        }
      }
    }
    __syncthreads();
    if (wave < 2) {
      float xr[64];
#pragma unroll
      for (int i = 0; i < 64; ++i) xr[i] = 0.f;
#pragma unroll
      for (int i = 0; i < 64; ++i) {
        float a = RHS[i * 128 + wave * 64 + lane];
#pragma unroll
        for (int j4 = 0; j4 < (i + 3) / 4; ++j4) {
          f4 l4 = *(const f4*)(Lm + i * 64 + j4 * 4);
          a -= l4[0] * xr[j4 * 4] + l4[1] * xr[j4 * 4 + 1] + l4[2] * xr[j4 * 4 + 2] + l4[3] * xr[j4 * 4 + 3];
        }
        xr[i] = a;
      }
      if (wave == 0) {
#pragma unroll
        for (int i8 = 0; i8 < 8; ++i8) { h8 o;
#pragma unroll
          for (int e = 0; e < 8; ++e) o[e] = (hf)xr[i8 * 8 + e];
          *(h8*)(uT + cbase + lane * 64 + i8 * 8) = o; }
      } else {
#pragma unroll
        for (int i = 0; i < 64; ++i) wm_[cbase + i * 64 + lane] = (hf)xr[i];
      }
    }
  }
}

DI void phase_E1(const Params& p) {
  const int lane = threadIdx.x & 63, wave = threadIdx.x >> 6, q = lane >> 4, cl = lane & 15;
  constexpr size_t MSZ = (size_t)NTOK * 512;
  const hf* uT = (const hf*)p.dscan; const hf* wm_ = uT + MSZ; const hf* qg = wm_ + MSZ; const hf* kdT = qg + MSZ; const hf* intra = (const hf*)(p.ws + O_INTRA);
  const float* eg = (const float*)(p.ws + O_EG);
  hf* ob = (hf*)(p.ws + O_OB);
  for (int bh = blockIdx.x; bh < BATCH * 8; bh += gridDim.x) {
    const int b = bh / 8, h = bh % 8, e0 = wave * 16;
    f4 S[4];
#pragma unroll
    for (int i = 0; i < 4; ++i) S[i] = f4{0, 0, 0, 0};
    for (int c = 0; c < NCHK; ++c) {
      const size_t cbase = ((size_t)bh * NCHK + c) * 4096;
      h8 Sb[2]; Sb[0] = cvt_f4f4(S[0], S[1]); Sb[1] = cvt_f4f4(S[2], S[3]);
      f4 vn[4];
#pragma unroll
      for (int mt = 0; mt < 4; ++mt) {
        f4 a = f4{0, 0, 0, 0};
#pragma unroll
        for (int ks = 0; ks < 2; ++ks) a = mfma16(permload(wm_ + cbase + (mt * 16 + cl) * 64 + ks * 32, q), Sb[ks], a);
        h4 u4 = *(const h4*)(uT + cbase + (e0 + cl) * 64 + mt * 16 + q * 4);
#pragma unroll
        for (int r = 0; r < 4; ++r) vn[mt][r] = (float)u4[r] - a[r];
      }
      h8 Vb[2]; Vb[0] = cvt_f4f4(vn[0], vn[1]); Vb[1] = cvt_f4f4(vn[2], vn[3]);
#pragma unroll
      for (int mt = 0; mt < 4; ++mt) {
        f4 o = f4{0, 0, 0, 0};
#pragma unroll
        for (int ks = 0; ks < 2; ++ks) {
          o = mfma16(permload(qg + cbase + (mt * 16 + cl) * 64 + ks * 32, q), Sb[ks], o);
          o = mfma16(permload(intra + cbase + (mt * 16 + cl) * 64 + ks * 32, q), Vb[ks], o);
        }
#pragma unroll
        for (int r = 0; r < 4; ++r) ob[((size_t)b * SEQ + c * 64 + mt * 16 + q * 4 + r) * 512 + h * 64 + e0 + cl] = (hf)o[r];
      }
      const float egl = eg[bh * NCHK + c];
#pragma unroll
      for (int mt = 0; mt < 4; ++mt) {
        f4 s = S[mt] * egl;
#pragma unroll
        for (int ks = 0; ks < 2; ++ks) s = mfma16(permload(kdT + cbase + (mt * 16 + cl) * 64 + ks * 32, q), Vb[ks], s);
        S[mt] = s;
      }
    }
  }
}

DI void obnorm_pass(const Params& p) {
  hf* ob = (hf*)(p.ws + O_OB); const hf* P3 = (const hf*)(p.ws + O_P3);
  const int lane = threadIdx.x & 63, wave = threadIdx.x >> 6;
  for (int row = blockIdx.x * 4 + wave; row < NTOK; row += gridDim.x * 4) {
    h8 v = *(const h8*)(ob + (size_t)row * 512 + lane * 8);
    h8 z = *(const h8*)(P3 + (size_t)row * 512 + lane * 8);
    float f[8], ss = 0.f;
#pragma unroll
    for (int e = 0; e < 8; ++e) { f[e] = (float)v[e]; ss += f[e] * f[e]; }
    ss += __shfl_xor(ss, 1); ss += __shfl_xor(ss, 2); ss += __shfl_xor(ss, 4);
    const float rstd = rsqrtf(ss * (1.0f / 64.0f) + EPSN);
    h8 o;
#pragma unroll
    for (int e = 0; e < 8; ++e) o[e] = (hf)(f[e] * rstd * p.norm_b_w[(lane & 7) * 8 + e] * siluf_((float)z[e]));
    *(h8*)(ob + (size_t)row * 512 + lane * 8) = o;
  }
}

constexpr int SB_LD = 264;
constexpr int E2_WAVE_LDS = (TOPK + 16) * 4 + 8 * SB_LD * 4;
DI void attn_token(const Params& p, int b, int t, const float* srow, int* sel, float* Sb, int lane) {
  hf* P1 = (hf*)(p.ws + O_P1);
  const int q = lane >> 4, cl = lane & 15;
  const int n = t + 1;
  int cnt;
  if (n <= TOPK) {
    cnt = n;
    for (int i = lane; i < TOPK + 16; i += 64) sel[i] = (i < n) ? i : 0;
  } else {
    cnt = TOPK;
    unsigned key[SEQ / 64];
    {
      const float* pb = srow + lane;
#pragma unroll
      for (int jg = 0; jg < SEQ / 64 / 8; ++jg) {
#ifndef EMU
        asm volatile("" : "+v"(pb));
#endif
#pragma unroll
        for (int jj = 0; jj < 8; ++jj) { const int j = jg * 8 + jj; const float v = pb[jj * 64]; key[j] = (j * 64 + lane < n) ? f2ord(v) : 0u; }
        pb += 512;
      }
    }
    unsigned T = 0;
    for (int bit = 31; bit >= 0; --bit) {
      const unsigned cand = T | (1u << bit);
      int cl_ = 0;
#pragma unroll
      for (int j = 0; j < SEQ / 64; ++j) cl_ += (key[j] >= cand) ? 1 : 0;
      if (wave_sum_i(cl_) >= TOPK) T = cand;
    }
    int cgt = 0;
#pragma unroll
    for (int j = 0; j < SEQ / 64; ++j) cgt += (key[j] > T) ? 1 : 0;
    cgt = wave_sum_i(cgt);
    int base_gt = 0, base_eq = cgt;
    const unsigned long long lt = (lane == 0) ? 0ull : (~0ull >> (64 - lane));
#pragma unroll
    for (int j = 0; j < SEQ / 64; ++j) {
      const bool mg = key[j] > T, me = key[j] == T;
      const unsigned long long bg = __ballot(mg), be = __ballot(me);
      if (mg) sel[base_gt + __popcll(bg & lt)] = j * 64 + lane;
      if (me) { int pos = base_eq + __popcll(be & lt); if (pos < TOPK) sel[pos] = j * 64 + lane; }
      base_gt += __popcll(bg); base_eq += __popcll(be);
    }
    if (lane < 16) sel[TOPK + lane] = 0;
  }
  wave_sync();
  const int ntile = (cnt + 15) / 16;
  const size_t trow = (size_t)b * SEQ + t;
#pragma unroll
  for (int g = 0; g < 2; ++g) {
    h8 a0, a1;
    if (cl < 4) { const hf* qp = P1 + trow * LP1 + C_QA + (g * 4 + cl) * 64 + q * 8; a0 = *(const h8*)qp; a1 = *(const h8*)(qp + 32); }
    else { a0 = h8{0, 0, 0, 0, 0, 0, 0, 0}; a1 = a0; }
    for (int kt = 0; kt < ntile; ++kt) {
      const int slot = kt * 16 + cl; const int kidx = sel[slot];
      const hf* kp = P1 + ((size_t)b * SEQ + kidx) * LP1 + C_KA + g * 64 + q * 8;
      f4 s = f4{0, 0, 0, 0};
      s = mfma16(a0, *(const h8*)kp, s); s = mfma16(a1, *(const h8*)(kp + 32), s);
      if (q == 0) {
#pragma unroll
        for (int r = 0; r < 4; ++r) Sb[(g * 4 + r) * SB_LD + slot] = (slot < cnt) ? s[r] : -INFINITY;
      }
    }
  }
  wave_sync();
  {
    const int hh = lane >> 3, l8 = lane & 7; float* sp = Sb + hh * SB_LD;
    const int nslot = ntile * 16;
    float mx = -INFINITY;
    for (int i = l8; i < nslot; i += 8) mx = fmaxf(mx, sp[i]);
    mx = fmaxf(mx, __shfl_xor(mx, 1)); mx = fmaxf(mx, __shfl_xor(mx, 2)); mx = fmaxf(mx, __shfl_xor(mx, 4));
    float sm = 0.f;
    for (int i = l8; i < nslot; i += 8) { float e = __expf(sp[i] - mx); sp[i] = e; sm += e; }
    sm += __shfl_xor(sm, 1); sm += __shfl_xor(sm, 2); sm += __shfl_xor(sm, 4);
    const float inv = 1.0f / sm;
    for (int i = l8; i < nslot; i += 8) sp[i] *= inv;
  }
  wave_sync();
#pragma unroll
  for (int g = 0; g < 2; ++g) {
    const int ksub = lane >> 3, dch = lane & 7;
    float acc[4][8];
#pragma unroll
    for (int hh = 0; hh < 4; ++hh)
#pragma unroll
      for (int e = 0; e < 8; ++e) acc[hh][e] = 0.f;
    const int nk8 = ntile * 2;
    for (int kk = 0; kk < nk8; ++kk) {
      const int slot = kk * 8 + ksub; const int kidx = sel[slot];
      h8 v = *(const h8*)(P1 + ((size_t)b * SEQ + kidx) * LP1 + C_VA + g * 64 + dch * 8);
#pragma unroll
      for (int hh = 0; hh < 4; ++hh) { const float pr = Sb[(g * 4 + hh) * SB_LD + slot];
#pragma unroll
        for (int e = 0; e < 8; ++e) acc[hh][e] += pr * (float)v[e]; }
    }
#pragma unroll
    for (int hh = 0; hh < 4; ++hh)
#pragma unroll
      for (int e = 0; e < 8; ++e) { float a = acc[hh][e]; a += __shfl_xor(a, 8); a += __shfl_xor(a, 16); a += __shfl_xor(a, 32); acc[hh][e] = a; }
    if (ksub == 0) {
#pragma unroll
      for (int hh = 0; hh < 4; ++hh) { h8 o;
#pragma unroll
        for (int e = 0; e < 8; ++e) o[e] = (hf)acc[hh][e];
        *(h8*)(P1 + trow * LP1 + C_QA + (g * 4 + hh) * 64 + dch * 8) = o; }
    }
  }
  wave_sync();
}

DI void phase_E2(const Params& p, char* smem) {
  obnorm_pass(p);
  const hf* P1 = (const hf*)(p.ws + O_P1); const float* aux = (const float*)(p.ws + O_AUX);
  int* cnt = (int*)(p.ws + O_CNT);
  const int tid = threadIdx.x, lane = tid & 63, wave = tid >> 6, q = lane >> 4, cl = lane & 15;
  float* scr = (float*)(p.ws + O_SCR) + (size_t)blockIdx.x * QBT * SEQ;
  int* item_s = (int*)smem;
  char* wl = smem + 16 + wave * E2_WAVE_LDS;
  int* sel = (int*)wl; float* Sb = (float*)(wl + (TOPK + 16) * 4);
  constexpr int NQB = SEQ / QBT, NITEM = BATCH * NQB;
  for (;;) {
    __syncthreads();
    if (tid == 0) item_s[0] = atomicAdd(cnt, 1);
    __syncthreads();
    const int item = item_s[0];
    if (item >= NITEM) break;
    const int b = item % BATCH, qb = NQB - 1 - item / BATCH;
    const int tw0 = qb * QBT + wave * 4;
    h8 aq[4][2]; f4 wts[4];
#pragma unroll
    for (int i = 0; i < 4; ++i) {
      const size_t row = (size_t)b * SEQ + tw0 + i;
      const hf* qp = P1 + row * LP1 + C_QI + cl * 64 + q * 8;
      aq[i][0] = *(const h8*)qp; aq[i][1] = *(const h8*)(qp + 32);
      wts[i] = *(const f4*)(aux + row * 32 + q * 4);
    }
    const int nkt = (tw0 + 3) / 16 + 1;
    for (int kt = 0; kt < nkt; ++kt) {
      const hf* kp = P1 + ((size_t)b * SEQ + kt * 16 + cl) * LP1 + C_KI + q * 8;
      const h8 b0 = *(const h8*)kp, b1 = *(const h8*)(kp + 32);
      float sc[4];
#pragma unroll
      for (int i = 0; i < 4; ++i) {
        f4 c4 = f4{0, 0, 0, 0};
        c4 = mfma16(aq[i][0], b0, c4); c4 = mfma16(aq[i][1], b1, c4);
        float ps = wts[i][0] * fmaxf(c4[0], 0.f) + wts[i][1] * fmaxf(c4[1], 0.f) + wts[i][2] * fmaxf(c4[2], 0.f) + wts[i][3] * fmaxf(c4[3], 0.f);
        ps += __shfl_xor(ps, 16); ps += __shfl_xor(ps, 32);
        sc[i] = ps;
      }
      const float mine = (q == 0) ? sc[0] : (q == 1) ? sc[1] : (q == 2) ? sc[2] : sc[3];
      scr[(size_t)(wave * 4 + q) * SEQ + kt * 16 + cl] = mine;
    }
    gmem_wave_sync();
#pragma unroll 1
    for (int i = 0; i < 4; ++i) attn_token(p, b, tw0 + i, scr + (size_t)(wave * 4 + i) * SEQ, sel, Sb, lane);
  }
}

DI void phase_F1(const Params& p, char* smem) {
  const hf* P1 = (const hf*)(p.ws + O_P1); const hf* ob = (const hf*)(p.ws + O_OB); const hf* P4 = (const hf*)(p.ws + O_P4);
  const hf* WpaT = (const hf*)(p.ws + O_WPA); const hf* WpbT = (const hf*)(p.ws + O_WPB);
  hf* merged = (hf*)(p.ws + O_MERGED);
  const int lane = threadIdx.x & 63, wave = threadIdx.x >> 6, wm = wave >> 1, wn = wave & 1, q = lane >> 4, cl = lane & 15;
  constexpr int NTN = DM / 128, NTM = NTOK / 128;
  for (int t = blockIdx.x; t < NTN * NTM; t += gridDim.x) {
    const int m0 = (t / NTN) * 128, n0 = (t % NTN) * 128;
    f4 a1[4][4], a2[4][4]; zero_acc<4>(a1); zero_acc<4>(a2);
    gemm_mainloop<128>(a1, P1 + C_QA, LP1, WpaT, 512, 512, m0, n0, smem);
    gemm_mainloop<128>(a2, ob, 512, WpbT, 512, 512, m0, n0, smem);
#pragma unroll
    for (int mt = 0; mt < 4; ++mt)
#pragma unroll
      for (int nt = 0; nt < 4; ++nt)
#pragma unroll
        for (int r = 0; r < 4; ++r) {
          const size_t row = m0 + wm * 64 + mt * 16 + q * 4 + r; const int col = n0 + wn * 64 + nt * 16 + cl;
          const float sa = (float)P4[row * LP4 + col], sb = (float)P4[row * LP4 + DM + col];
          merged[row * DM + col] = (hf)(sa * a1[mt][nt][r] + sb * a2[mt][nt][r]);
        }
  }
}
DI void phase_F2(const Params& p, char* smem) {
  const hf* merged = (const hf*)(p.ws + O_MERGED); const hf* WoT = (const hf*)(p.ws + O_WO); const float* mod = (const float*)(p.ws + O_MOD);
  const int lane = threadIdx.x & 63, wave = threadIdx.x >> 6, wm = wave >> 1, wn = wave & 1, q = lane >> 4, cl = lane & 15;
  constexpr int NTN = DM / 128, NTM = NTOK / 128;
  for (int t = blockIdx.x; t < NTN * NTM; t += gridDim.x) {
    const int m0 = (t / NTN) * 128, n0 = (t % NTN) * 128;
    f4 acc[4][4]; zero_acc<4>(acc);
    gemm_mainloop<128>(acc, merged, DM, WoT, DM, DM, m0, n0, smem);
#pragma unroll
    for (int mt = 0; mt < 4; ++mt)
#pragma unroll
      for (int nt = 0; nt < 4; ++nt)
#pragma unroll
        for (int r = 0; r < 4; ++r) {
          const size_t row = m0 + wm * 64 + mt * 16 + q * 4 + r; const int col = n0 + wn * 64 + nt * 16 + cl;
          const int b = (int)(row / SEQ);
          p.out[row * DM + col] = p.x[row * DM + col] + mod[(size_t)b * 6 * DM + 2 * DM + col] * acc[mt][nt][r];
        }
  }
}
DI void phase_F3(const Params& p) {
  adaln_rows(p.out, (hf*)(p.ws + O_N2H), (const float*)(p.ws + O_MOD), 3 * DM, 4 * DM);
  hf* u16 = (hf*)p.uv; hf* v16 = u16 + (size_t)NEXP * DM;
  const size_t n4 = (size_t)NEXP * DM / 4;
  for (size_t i = (size_t)blockIdx.x * 256 + threadIdx.x; i < n4; i += (size_t)gridDim.x * 256) {
    f4 a = *(const f4*)(p.pu + i * 4), bq = *(const f4*)(p.pv + i * 4);
    h4 ha, hb;
#pragma unroll
    for (int j = 0; j < 4; ++j) { ha[j] = (hf)a[j]; hb[j] = (hf)bq[j]; }
    *(h4*)(u16 + i * 4) = ha; *(h4*)(v16 + i * 4) = hb;
  }
}
DI void phase_G1(const Params& p, char* smem) {
  const hf* n2h = (const hf*)(p.ws + O_N2H); const hf* WqT = (const hf*)(p.ws + O_WQ); const hf* subk = (const hf*)(p.ws + O_SUBK);
  int* experts = (int*)(p.ws + O_P4); float* gates = (float*)(p.ws + O_P4 + (size_t)NTOK * 128 * 4);
  const int tid = threadIdx.x, lane = tid & 63, wave = tid >> 6, wm = wave >> 1, wn = wave & 1, q = lane >> 4, cl = lane & 15;
  constexpr int NTM = NTOK / 64;
  hf* qt = (hf*)smem;
  float* sb = (float*)smem;
  unsigned* tl = (unsigned*)(smem + 2 * 64 * 129 * 4);
  for (int t = blockIdx.x; t < NTM * 8; t += gridDim.x) {
    const int hh = t % 8, m0 = (t / 8) * 64, n0 = hh * 128;
    f4 acc[2][4]; zero_acc<2>(acc);
    gemm_mainloop<64>(acc, n2h, DM, WqT, DM, DM, m0, n0, smem);
    __syncthreads();
#pragma unroll
    for (int mt = 0; mt < 2; ++mt)
#pragma unroll
      for (int nt = 0; nt < 4; ++nt)
#pragma unroll
        for (int r = 0; r < 4; ++r) qt[(wm * 32 + mt * 16 + q * 4 + r) * 136 + wn * 64 + nt * 16 + cl] = (hf)acc[mt][nt][r];
    __syncthreads();
    const int pp = wave & 1, mh = wave >> 1;
    h8 af[2][2];
#pragma unroll
    for (int mt = 0; mt < 2; ++mt)
#pragma unroll
      for (int ks = 0; ks < 2; ++ks) af[mt][ks] = *(const h8*)(qt + (mh * 32 + mt * 16 + cl) * 136 + pp * 64 + ks * 32 + q * 8);
    __syncthreads();
    const hf* skp = subk + (size_t)(hh * 2 + pp) * 128 * 64;
#pragma unroll
    for (int nt = 0; nt < 8; ++nt) {
      h8 b0 = *(const h8*)(skp + (nt * 16 + cl) * 64 + q * 8), b1 = *(const h8*)(skp + (nt * 16 + cl) * 64 + 32 + q * 8);
#pragma unroll
      for (int mt = 0; mt < 2; ++mt) {
        f4 s = f4{0, 0, 0, 0};
        s = mfma16(af[mt][0], b0, s); s = mfma16(af[mt][1], b1, s);
#pragma unroll
        for (int r = 0; r < 4; ++r) sb[(pp * 64 + mh * 32 + mt * 16 + q * 4 + r) * 129 + nt * 16 + cl] = s[r];
      }
    }
    __syncthreads();
    if (tid < 128) {
      unsigned top[16];
#pragma unroll
      for (int i = 0; i < 16; ++i) top[i] = 0u;
      const float* sr = sb + tid * 129;
      for (int n = 0; n < 128; ++n) {
        unsigned k = (f2ord(sr[n]) & ~127u) | (unsigned)(127 - n);
#pragma unroll
        for (int i = 0; i < 16; ++i) { unsigned hi = top[i] > k ? top[i] : k; k = top[i] > k ? k : top[i]; top[i] = hi; }
      }
#pragma unroll
      for (int i = 0; i < 16; ++i) tl[tid * 16 + i] = top[i];
    }
    __syncthreads();
    if (tid < 64) {
      unsigned k1[16], k2[16];
#pragma unroll
      for (int i = 0; i < 16; ++i) { k1[i] = tl[tid * 16 + i]; k2[i] = tl[(64 + tid) * 16 + i]; }
      unsigned top[16];
#pragma unroll
      for (int i = 0; i < 16; ++i) top[i] = 0u;
#pragma unroll
      for (int i = 0; i < 16; ++i) {
#pragma unroll
        for (int j = 0; j < 16; ++j) {
          if ((i + 1) * (j + 1) <= 16) {
            float v = ord2f(k1[i] & ~127u) + ord2f(k2[j] & ~127u);
            unsigned k = (f2ord(v) & ~255u) | (unsigned)(255 - (i * 16 + j));
#pragma unroll
            for (int s = 0; s < 16; ++s) { unsigned hi = top[s] > k ? top[s] : k; k = top[s] > k ? k : top[s]; top[s] = hi; }
          }
        }
      }
      float vals[16], mx, sm = 0.f;
#pragma unroll
      for (int s = 0; s < 16; ++s) vals[s] = ord2f(top[s] & ~255u);
      mx = vals[0];
#pragma unroll
      for (int s = 0; s < 16; ++s) { vals[s] = __expf(vals[s] - mx); sm += vals[s]; }
      const float inv = 1.0f / sm;
      const size_t ob_ = ((size_t)(m0 + tid) * 8 + hh) * 16;
#pragma unroll
      for (int s = 0; s < 16; ++s) {
        const int ci = 255 - (int)(top[s] & 255u); const int i = ci >> 4, j = ci & 15;
        unsigned a = 0, bq = 0;
#pragma unroll
        for (int u = 0; u < 16; ++u) { a = (u == i) ? k1[u] : a; bq = (u == j) ? k2[u] : bq; }
        const int e1 = 127 - (int)(a & 127u), e2 = 127 - (int)(bq & 127u);
        experts[ob_ + s] = e1 * 128 + e2; gates[ob_ + s] = vals[s] * inv;
      }
    }
  }
}
constexpr int VPL = DM / 64;
constexpr int CH = (VPL >= 8) ? 8 : VPL;
constexpr int NCHUNK = VPL / CH;
typedef _Float16 hch __attribute__((ext_vector_type(CH)));
constexpr int G2_WAVE_LDS = DM * 2 + 128 * 4 + 128 * 4;
DI void phase_G2(const Params& p, char* smem) {
  const hf* n2h = (const hf*)(p.ws + O_N2H); const hf* u16 = (const hf*)p.uv; const hf* v16 = u16 + (size_t)NEXP * DM;
  const int* experts = (const int*)(p.ws + O_P4); const float* gates = (const float*)(p.ws + O_P4 + (size_t)NTOK * 128 * 4);
  const float* mod = (const float*)(p.ws + O_MOD);
  const int lane = threadIdx.x & 63, wave = threadIdx.x >> 6, q = lane >> 4, cl = lane & 15;
  char* wl = smem + wave * G2_WAVE_LDS;
  hf* xs = (hf*)wl; float* coef = (float*)(wl + DM * 2); int* eix = (int*)(wl + DM * 2 + 512);
  for (int tok = blockIdx.x * 4 + wave; tok < NTOK; tok += gridDim.x * 4) {
    const int b = tok / SEQ;
    wave_sync();
    for (int i = lane; i < DM / 8; i += 64) *(h8*)(xs + i * 8) = *(const h8*)(n2h + (size_t)tok * DM + i * 8);
    eix[lane] = experts[(size_t)tok * 128 + lane]; eix[64 + lane] = experts[(size_t)tok * 128 + 64 + lane];
    wave_sync();
    for (int grp = 0; grp < 8; ++grp) {
      const hf* ur = u16 + (size_t)eix[grp * 16 + cl] * DM + q * 8;
      f4 a = f4{0, 0, 0, 0};
#pragma unroll 8
      for (int ks = 0; ks < DM / 32; ++ks) a = mfma16(*(const h8*)(ur + ks * 32), *(const h8*)(xs + ks * 32 + q * 8), a);
      if (cl == 0) {
#pragma unroll
        for (int r = 0; r < 4; ++r) { const int e = grp * 16 + q * 4 + r; const float av = a[r];
          coef[e] = 0.5f * av * (1.0f + erff(av * 0.70710678118654752f)) * gates[(size_t)tok * 128 + e]; }
      }
    }
    wave_sync();
    float y[VPL];
#pragma unroll
    for (int i = 0; i < VPL; ++i) y[i] = 0.f;
#pragma unroll 4
    for (int e = 0; e < 128; ++e) {
      const hf* vr = v16 + (size_t)eix[e] * DM; const float cf = coef[e];
#pragma unroll
      for (int c = 0; c < NCHUNK; ++c) { hch v = *(const hch*)(vr + c * 64 * CH + lane * CH);
#pragma unroll
        for (int j = 0; j < CH; ++j) y[c * CH + j] += cf * (float)v[j]; }
    }
    float hv[VPL]; float ss = 0.f;
#pragma unroll
    for (int c = 0; c < NCHUNK; ++c)
#pragma unroll
      for (int j = 0; j < CH; ++j) { const int d = c * 64 * CH + lane * CH + j; float v = p.out[(size_t)tok * DM + d] + mod[(size_t)b * 6 * DM + 5 * DM + d] * y[c * CH + j]; hv[c * CH + j] = v; ss += v * v; }
    ss = wave_sum(ss);
    const float rstd = rsqrtf(ss * (1.0f / DM) + EPSN);
#pragma unroll
    for (int c = 0; c < NCHUNK; ++c)
#pragma unroll
      for (int j = 0; j < CH; ++j) { const int d = c * 64 * CH + lane * CH + j; p.out[(size_t)tok * DM + d] = hv[c * CH + j] * rstd * p.fnw[d]; }
  }
}

constexpr int cmax(int a, int b) { return a > b ? a : b; }
constexpr int LDS_GEMM = (128 + 128) * 72 * 2;
constexpr int LDS_A = cmax(64 * 65 * 4, (BATCH * DM + 4 * BATCH * 64) * 4);
constexpr int LDS_D1 = 2 * 64 * 72 * 2 + 64 * 128 * 4 + 64 * 64 * 4 + 512;
constexpr int LDS_E2 = 16 + 4 * E2_WAVE_LDS;
constexpr int LDS_G1 = 2 * 64 * 129 * 4 + 2 * 64 * 16 * 4;
constexpr int LDS_G2 = 4 * G2_WAVE_LDS;
constexpr int SMEM_BYTES = cmax(cmax(cmax(LDS_GEMM, LDS_A), cmax(LDS_D1, LDS_E2)), cmax(LDS_G1, LDS_G2));
constexpr int NPHASE = 11;

DI void run_phase(const Params& p, int ph, char* smem) {
  switch (ph) {
    case 0: phase_A(p, smem); break;
    case 1: adaln_rows(p.x, (hf*)(p.ws + O_R), (const float*)(p.ws + O_MOD), 0, DM); break;
    case 2: phase_C(p, smem); break;
    case 3: phase_D1(p, smem); break;
    case 4: phase_E1(p); break;
    case 5: phase_E2(p, smem); break;
    case 6: phase_F1(p, smem); break;
    case 7: phase_F2(p, smem); break;
    case 8: phase_F3(p); break;
    case 9: phase_G1(p, smem); break;
    case 10: phase_G2(p, smem); break;
  }
}

#ifdef EMU
static void emu_kernel_all(void* arg) {
  const Params& p = *(const Params*)arg; char* smem = emu_cur->blk->smem;
  for (int ph = 0; ph < NPHASE; ++ph) { run_phase(p, ph, smem); emu_grid_sync(); }
}
#else
template <int PH> __global__ void __launch_bounds__(256, 2) phase_kernel(Params p) {
  __shared__ __attribute__((aligned(16))) char smem[SMEM_BYTES];
  run_phase(p, PH, smem);
}
#if !MULTI_LAUNCH
__global__ void __launch_bounds__(256, 2) mega_kernel(Params p) {
  __shared__ __attribute__((aligned(16))) char smem[SMEM_BYTES];
  cooperative_groups::grid_group grid = cooperative_groups::this_grid();
  run_phase(p, 0, smem); grid.sync(); run_phase(p, 1, smem); grid.sync(); run_phase(p, 2, smem); grid.sync(); run_phase(p, 3, smem); grid.sync();
  run_phase(p, 4, smem); grid.sync(); run_phase(p, 5, smem); grid.sync(); run_phase(p, 6, smem); grid.sync(); run_phase(p, 7, smem); grid.sync();
  run_phase(p, 8, smem); grid.sync(); run_phase(p, 9, smem); grid.sync(); run_phase(p, 10, smem);
}
#endif
#endif

extern "C" void kernel_launch(void* const* d_in, const int* in_sizes, int n_in, void* d_out, int out_size, void* d_ws, size_t ws_size, hipStream_t stream) {
  Params p{};
  p.x = (const float*)d_in[0]; p.c = (const float*)d_in[1]; p.pos = (const int*)d_in[2]; p.w_ada = (const float*)d_in[3]; p.b_ada = (const float*)d_in[4];
  p.w_in = (const float*)d_in[5]; p.conv_w = (const float*)d_in[6]; p.a_log = (const float*)d_in[7]; p.dt_bias = (const float*)d_in[8]; p.norm_b_w = (const float*)d_in[9];
  p.w_pa = (const float*)d_in[10]; p.w_pb = (const float*)d_in[11]; p.w_o = (const float*)d_in[12]; p.wq = (const float*)d_in[13]; p.subk = (const float*)d_in[14];
  p.pu = (const float*)d_in[15]; p.pv = (const float*)d_in[16]; p.fnw = (const float*)d_in[17];
  p.out = (float*)d_out; p.ws = (char*)d_ws;
#ifdef EMU
  const int grid = 4;
  p.dscan = p.ws + WS_TOTAL; p.uv = p.ws + WS_TOTAL + DSCAN_BYTES;
  if (WS_TOTAL + DSCAN_BYTES + UV_BYTES > ws_size) { fprintf(stderr, "ws too small\n"); exit(2); }
  if (O_SCR + (size_t)grid * QBT * SEQ * 4 > O_OB) { fprintf(stderr, "scratch overflow\n"); exit(2); }
  fprintf(stderr, "emu: SMEM_BYTES=%d WS_TOTAL=%zu\n", SMEM_BYTES, WS_TOTAL);
  emu_launch(emu_kernel_all, &p, grid, 256, SMEM_BYTES);
#else
  static_assert((size_t)NTOK * DM * 4 >= DSCAN_BYTES, "d_out too small for scan scratch");
  static_assert(UV_BYTES <= (size_t)NTOK * LP1 * 2, "P1 too small for expert tables");
  p.dscan = (char*)d_out; p.uv = p.ws + O_P1;
  static int grid = 0;
  if (!grid) {
    int dev = 0, cus = 0, per_cu = 0;
    hipGetDevice(&dev); hipDeviceGetAttribute(&cus, hipDeviceAttributeMultiprocessorCount, dev);
#if MULTI_LAUNCH
    hipOccupancyMaxActiveBlocksPerMultiprocessor(&per_cu, phase_kernel<5>, 256, 0);
#else
    hipOccupancyMaxActiveBlocksPerMultiprocessor(&per_cu, mega_kernel, 256, 0);
#endif
    if (per_cu > 2) per_cu = 2;
    if (per_cu < 1) per_cu = 1;
    grid = cus * per_cu;
    if (grid > 512) grid = 512;
  }
  if (WS_TOTAL > ws_size) { fprintf(stderr, "workspace too small: need %zu have %zu\n", WS_TOTAL, ws_size); return; }
#if MULTI_LAUNCH
  hipLaunchKernelGGL(phase_kernel<0>, dim3(grid), dim3(256), 0, stream, p);
  hipLaunchKernelGGL(phase_kernel<1>, dim3(grid), dim3(256), 0, stream, p);
  hipLaunchKernelGGL(phase_kernel<2>, dim3(grid), dim3(256), 0, stream, p);
  hipLaunchKernelGGL(phase_kernel<3>, dim3(grid), dim3(256), 0, stream, p);
  hipLaunchKernelGGL(phase_kernel<4>, dim3(grid), dim3(256), 0, stream, p);
  hipLaunchKernelGGL(phase_kernel<5>, dim3(grid), dim3(256), 0, stream, p);
  hipLaunchKernelGGL(phase_kernel<6>, dim3(grid), dim3(256), 0, stream, p);
  hipLaunchKernelGGL(phase_kernel<7>, dim3(grid), dim3(256), 0, stream, p);
  hipLaunchKernelGGL(phase_kernel<8>, dim3(grid), dim3(256), 0, stream, p);
  hipLaunchKernelGGL(phase_kernel<9>, dim3(grid), dim3(256), 0, stream, p);
  hipLaunchKernelGGL(phase_kernel<10>, dim3(grid), dim3(256), 0, stream, p);
#else
  void* args[] = {&p};
  hipError_t e = hipLaunchCooperativeKernel((void*)mega_kernel, dim3(grid), dim3(256), args, 0, stream);
  if (e != hipSuccess) fprintf(stderr, "cooperative launch failed: %s (grid %d)\n", hipGetErrorString(e), grid);
#endif
#endif
}
```

```cpp
#ifdef EMU
#include "hip_emu.h"
#else
#include <hip/hip_runtime.h>
#include <hip/hip_cooperative_groups.h>
#include <cstdio>
#include <cstdint>
#endif

#ifndef PROBE_BAR2
#define PROBE_BAR2 0
#endif
#ifndef REP_CEPI
#define REP_CEPI 1
#endif
#ifndef REP_CMAIN
#define REP_CMAIN 1
#endif
#ifndef REP_IDX
#define REP_IDX 1
#endif
#ifndef REP_SEL
#define REP_SEL 1
#endif
#ifndef REP_QK
#define REP_QK 1
#endif
#ifndef REP_PV
#define REP_PV 1
#endif
#ifndef MULTI_LAUNCH
#define MULTI_LAUNCH 0
#endif

#ifdef EMU
#ifndef EMU_B
#define EMU_B 2
#endif
#ifndef EMU_S
#define EMU_S 512
#endif
#ifndef EMU_D
#define EMU_D 256
#endif
constexpr int BATCH = EMU_B, SEQ = EMU_S, DM = EMU_D;
#else
constexpr int BATCH = 8, SEQ = 4096, DM = 1024;
#endif
constexpr int NTOK = BATCH * SEQ;
constexpr int TOPK = (SEQ / 4 < 256) ? SEQ / 4 : 256;
constexpr int NCHK = SEQ / 64;
constexpr int NEXP = 16384;
constexpr int C_QA = 0, C_KA = 512, C_VA = 640, C_QI = 768, C_KI = 1792, C_WI = 1856, C_BB = 1872, C_AB = 1880;
constexpr int C_QB = 1920, C_ZB = 3456, C_GA = 3968;
constexpr int NP = 3968 + 2 * DM;
constexpr int IN_W = 3936 + 2 * DM;
constexpr int LP1 = 1920, LP2 = 1536, LP3 = 512, LP4 = 2 * DM;
constexpr int QBT = 16;
constexpr float EPSN = 1e-6f;

typedef _Float16 hf;
typedef _Float16 h8 __attribute__((ext_vector_type(8)));
typedef _Float16 h4 __attribute__((ext_vector_type(4)));
typedef _Float16 h2 __attribute__((ext_vector_type(2)));
typedef float f4 __attribute__((ext_vector_type(4)));
typedef int i4 __attribute__((ext_vector_type(4)));
#define DI __device__ __forceinline__

constexpr size_t al256(size_t x) { return (x + 255) & ~size_t(255); }
constexpr size_t O_MOD = 0;
constexpr size_t O_CNT = O_MOD + al256((size_t)BATCH * 6 * DM * 4);
constexpr size_t O_BAR = O_CNT + 256;
constexpr size_t O_CS = O_BAR + 16384;
constexpr size_t O_AUX = O_CS + al256((size_t)NTOK * 16 * 4);
constexpr size_t O_WIN = O_AUX + al256((size_t)NTOK * 32 * 4);
constexpr size_t O_WPA = O_WIN + al256((size_t)NP * DM * 2);
constexpr size_t O_WPB = O_WPA + al256((size_t)DM * 512 * 2);
constexpr size_t O_WO = O_WPB + al256((size_t)DM * 512 * 2);
constexpr size_t O_WQ = O_WO + al256((size_t)DM * DM * 2);
constexpr size_t O_SUBK = O_WQ + al256((size_t)1024 * DM * 2);
constexpr size_t O_EG = O_SUBK + al256((size_t)8 * 2 * 128 * 64 * 2);
constexpr size_t O_P1 = O_EG + al256((size_t)BATCH * 8 * NCHK * 4);
constexpr size_t O_P3 = O_P1 + al256((size_t)NTOK * LP1 * 2);
constexpr size_t O_P4 = O_P3 + al256((size_t)NTOK * LP3 * 2);
constexpr size_t R_BYTES = ((size_t)NTOK * DM * 2 > (size_t)NTOK * 1024) ? (size_t)NTOK * DM * 2 : (size_t)NTOK * 1024;
constexpr size_t O_R = O_P4 + al256((size_t)NTOK * LP4 * 2);
constexpr size_t O_P2 = O_R + al256(R_BYTES);
constexpr size_t O_OB = O_P2 + al256((size_t)NTOK * LP2 * 2);
constexpr size_t O_W8 = O_OB + al256((size_t)NTOK * 512 * 2);
constexpr size_t O_SB8 = O_W8 + al256((size_t)NP * DM);
constexpr size_t O_WQ8 = O_SB8 + al256((size_t)NP * 4);
constexpr size_t O_SQ8 = O_WQ8 + al256((size_t)1024 * DM);
constexpr size_t WS_TOTAL = O_SQ8 + al256((size_t)1024 * 4);
constexpr size_t O_INTRA = O_R;
constexpr size_t O_SCR = O_R + (size_t)NTOK * 1024;
constexpr size_t O_MERGED = O_R;
constexpr size_t O_N2H = O_R + (size_t)NTOK * DM * 2;
constexpr size_t O_H16 = O_P2;
static_assert((size_t)NTOK * DM * 2 <= (size_t)NTOK * LP2 * 2, "P2 too small for h");
constexpr size_t DSCAN_BYTES = (size_t)NTOK * 4096;
constexpr size_t UV_U8 = 0, UV_V8 = (size_t)NEXP * DM, UV_N2Q = (size_t)2 * NEXP * DM, UV_SU = UV_N2Q + (size_t)NTOK * DM, UV_SV = UV_SU + (size_t)NEXP * 8, UV_SN = UV_SV + (size_t)NEXP * 8;
constexpr size_t UV_BYTES = UV_SN + (size_t)NTOK * 4;

struct Params {
  const float *x, *c; const int* pos;
  const float *w_ada, *b_ada, *w_in, *conv_w, *a_log, *dt_bias, *norm_b_w, *w_pa, *w_pb, *w_o, *wq, *subk, *pu, *pv, *fnw;
  float* out; char* ws; char* dscan; char* uv;
};

#ifdef EMU
DI int get_tid() { return (int)threadIdx.x; }
#else
DI int get_tid() { int t = threadIdx.x; asm volatile("" : "+v"(t)); return t; }
#endif
DI f4 mfma16(h8 a, h8 b, f4 c) { return __builtin_amdgcn_mfma_f32_16x16x32_f16(a, b, c, 0, 0, 0); }
DI f4 mfma16_i8(h8 a, h8 b, f4 c) { return __builtin_bit_cast(f4, __builtin_amdgcn_mfma_i32_16x16x64_i8(__builtin_bit_cast(i4, a), __builtin_bit_cast(i4, b), __builtin_bit_cast(i4, c), 0, 0, 0)); }
#ifdef EMU
DI void wave_sync() { int z = 0, r; emu_collective(&z, 4, &r, 4, [](EmuWave*) {}); }
DI void gmem_wave_sync() { wave_sync(); }
#else
DI void wave_sync() { __builtin_amdgcn_fence(__ATOMIC_RELEASE, "wavefront"); __builtin_amdgcn_wave_barrier(); __builtin_amdgcn_fence(__ATOMIC_ACQUIRE, "wavefront"); }
DI void gmem_wave_sync() { __builtin_amdgcn_fence(__ATOMIC_SEQ_CST, "workgroup"); __builtin_amdgcn_wave_barrier(); }
#endif
#ifdef EMU
DI unsigned ld_relaxed_agent(unsigned* p) { return *(volatile unsigned*)p; }
DI void add_relaxed_agent(unsigned* p, unsigned v) { *p += v; }
DI void fence_release_agent() {}
DI void fence_acquire_agent() {}
DI void drain_stores() {}
DI void spin_pause() { emu_yield(); }
#else
DI unsigned ld_relaxed_agent(unsigned* p) { return __hip_atomic_load(p, __ATOMIC_RELAXED, __HIP_MEMORY_SCOPE_AGENT); }
DI void add_relaxed_agent(unsigned* p, unsigned v) { (void)__hip_atomic_fetch_add(p, v, __ATOMIC_RELAXED, __HIP_MEMORY_SCOPE_AGENT); }
DI void fence_release_agent() { __builtin_amdgcn_fence(__ATOMIC_RELEASE, "agent"); asm volatile("s_waitcnt vmcnt(0)" ::: "memory"); }
DI void fence_acquire_agent() { __builtin_amdgcn_fence(__ATOMIC_ACQUIRE, "agent"); asm volatile("s_waitcnt vmcnt(0)" ::: "memory"); }
DI void drain_stores() { asm volatile("s_waitcnt vmcnt(0)" ::: "memory"); }
DI void spin_pause() { __builtin_amdgcn_s_sleep(8); }
#endif
DI float wave_sum(float v) { for (int m = 32; m >= 1; m >>= 1) v += __shfl_xor(v, m); return v; }
DI int wave_sum_i(int v) { for (int m = 32; m >= 1; m >>= 1) v += __shfl_xor(v, m); return v; }
DI float sigmoidf_(float x) { return 1.0f / (1.0f + __expf(-x)); }
DI float siluf_(float x) { return x / (1.0f + __expf(-x)); }
DI float softplusf_(float x) { return x > 20.f ? x : log1pf(__expf(x)); }
DI unsigned f2ord(float f) { unsigned u = __builtin_bit_cast(unsigned, f); return (u & 0x80000000u) ? ~u : (u | 0x80000000u); }
DI float ord2f(unsigned k) { unsigned u = (k & 0x80000000u) ? (k & 0x7fffffffu) : ~k; return __builtin_bit_cast(float, u); }
DI h8 cat44(h4 a, h4 b) { h8 r; r[0] = a[0]; r[1] = a[1]; r[2] = a[2]; r[3] = a[3]; r[4] = b[0]; r[5] = b[1]; r[6] = b[2]; r[7] = b[3]; return r; }
DI h8 cvt_f4f4(f4 a, f4 b) { h8 r; r[0] = (hf)a[0]; r[1] = (hf)a[1]; r[2] = (hf)a[2]; r[3] = (hf)a[3]; r[4] = (hf)b[0]; r[5] = (hf)b[1]; r[6] = (hf)b[2]; r[7] = (hf)b[3]; return r; }
#ifdef EMU
DI h4 lds_read_tr16(const hf* p) {
  h4 r; const hf* pp = p;
  emu_collective(&pp, sizeof(pp), &r, sizeof(r), [&](EmuWave* w) {
    for (int l = 0; l < 64; ++l) { const int gb = l & ~15, i = l & 15; h4 o;
      for (int qq = 0; qq < 4; ++qq) { const hf* src; memcpy(&src, w->in[gb + 4 * qq + (i >> 2)], sizeof(src)); o[qq] = src[i & 3]; }
      memcpy(w->out[l], &o, sizeof(o)); }
  });
  return r;
}
#else
typedef short s4v __attribute__((ext_vector_type(4)));
DI h4 lds_read_tr16(const hf* p) {
  const s4v v = __builtin_amdgcn_ds_read_tr16_b64_v4i16((__attribute__((address_space(3))) s4v*)p);
  return __builtin_bit_cast(h4, v);
}
#endif
DI h8 relu8(h8 v) { const h8 z = h8{0, 0, 0, 0, 0, 0, 0, 0}; return __builtin_elementwise_max(v, z); }
DI h8 permload(const hf* p, int q) { return cat44(*(const h4*)(p + 4 * q), *(const h4*)(p + 16 + 4 * q)); }


#ifndef EMU
#define XB_TMO      128
#define XB_XCNT(j)  (256  + 64 * (j))
#define XB_XSUB(j)  (1280 + 64 * (j))
#define XB_XGEN(j)  (2304 + 64 * (j))
#define XB_TOP      3328
#define XB_TOPGEN   3392
#define XCD_BAR_WORDS 3456
#define XB_SPIN_CAP (1u << 22)
#define LAS __attribute__((address_space(3)))
DI unsigned xb_ld(unsigned* p) { return __hip_atomic_load(p, __ATOMIC_RELAXED, __HIP_MEMORY_SCOPE_AGENT); }
DI unsigned xb_add(unsigned* p, unsigned v) { return __hip_atomic_fetch_add(p, v, __ATOMIC_RELAXED, __HIP_MEMORY_SCOPE_AGENT); }
DI unsigned xb_xcc_id() { return (unsigned)__builtin_amdgcn_s_getreg((3 << 11) | 20) & 0xFu; }
#define XB_SPIN(cond, bar) do { unsigned _sp = 0; while (cond) { __builtin_amdgcn_s_sleep(1); \
    if ((++_sp & 255u) == 0u) { if (xb_ld(&(bar)[XB_TMO])) break; if (_sp > XB_SPIN_CAP) { atomicAdd(&(bar)[XB_TMO], 1u); break; } } } } while (0)
struct XcdBarrier { unsigned* bar; unsigned x; volatile LAS unsigned* st; };
DI XcdBarrier xcd_barrier_post(unsigned* bar, volatile LAS unsigned* st) {
  XcdBarrier b; b.bar = bar; b.x = xb_xcc_id(); b.st = st;
  if (threadIdx.x == 0) { const unsigned li = xb_add(&bar[XB_XCNT(b.x)], 1u); st[2] = b.x; st[3] = li; }
  return b;
}
DI void xcd_barrier_complete(unsigned* bar, unsigned x, unsigned& nloc, unsigned& nx) {
  const unsigned G = gridDim.x * gridDim.y * gridDim.z;
  unsigned sum, cnt, mine, sp = 0u;
  for (;;) {
    sum = 0u; cnt = 0u; mine = 0u;
#pragma unroll
    for (unsigned j = 0; j < 16; ++j) { const unsigned c = xb_ld(&bar[XB_XCNT(j)]); sum += c; cnt += (c > 0u) ? 1u : 0u; mine = (j == x) ? c : mine; }
    if (sum == G) break;
    __builtin_amdgcn_s_sleep(1);
    if ((++sp & 255u) == 0u) { if (xb_ld(&bar[XB_TMO])) break; if (sp > XB_SPIN_CAP) { atomicAdd(&bar[XB_TMO], 1u); break; } }
  }
  nloc = mine > 0u ? mine : 1u; nx = cnt > 0u ? cnt : 1u;
}
DI void xcd_barrier(const XcdBarrier& b) {
  asm volatile("s_waitcnt vmcnt(0)" ::: "memory");
  __syncthreads();
  if (threadIdx.x == 0) {
    unsigned* bar = b.bar;
    __builtin_amdgcn_s_waitcnt(0);
    unsigned nloc = b.st[0], nx = b.st[1];
    if (nloc == 0u) { xcd_barrier_complete(bar, b.x, nloc, nx); b.st[0] = nloc; b.st[1] = nx; }
    const unsigned old = xb_add(&bar[XB_XSUB(b.x)], 1u);
    const unsigned gen = old / nloc;
    if (old + 1u == (gen + 1u) * nloc) {
      __builtin_amdgcn_fence(__ATOMIC_RELEASE, "agent");
      asm volatile("s_waitcnt vmcnt(0)" ::: "memory");
      const unsigned og = xb_add(&bar[XB_TOP], 1u);
      const unsigned tg = og / nx;
      if (og + 1u == (tg + 1u) * nx) xb_add(&bar[XB_TOPGEN], 1u);
      else XB_SPIN(xb_ld(&bar[XB_TOPGEN]) == tg, bar);
      __builtin_amdgcn_fence(__ATOMIC_ACQUIRE, "agent");
      xb_add(&bar[XB_XGEN(b.x)], 1u);
      asm volatile("s_waitcnt vmcnt(0)" ::: "memory");
    } else {
      XB_SPIN(xb_ld(&bar[XB_XGEN(b.x)]) == gen, bar);
      __builtin_amdgcn_fence(__ATOMIC_ACQUIRE, "agent");
      asm volatile("s_waitcnt vmcnt(0)" ::: "memory");
    }
  }
  __syncthreads();
}
#endif

DI size_t pr32_off(int row, int k, int K) { return ((size_t)(row >> 1) * (K / 32) + (k >> 5)) * 64 + (row & 1) * 32 + (k & 31); }

constexpr int GBK_MAX = 128;
template <int BM, int GBK = 128, bool PR = false, bool I8 = false>
DI void gemm_mainloop(f4 (&acc)[BM / 32][4], const hf* __restrict__ A, int lda, const hf* __restrict__ Bt, int ldb, int K, int m0, int n0, char* smem, int krot = 0) {
  constexpr int GLD = GBK + 8, MT = BM / 32, CPR = GBK / 8, ACH = BM * CPR / 256, BCH = 128 * CPR / 256;
  hf* sA = (hf*)smem; hf* sB = sA + BM * GLD;
  const int tid = get_tid(), lane = tid & 63, wave = tid >> 6, wm = wave >> 1, wn = wave & 1;
  h8 ra[ACH], rb[BCH];
#pragma unroll
  for (int i = 0; i < ACH; ++i) { int idx = tid + i * 256, r = idx / CPR, c = idx % CPR; ra[i] = *(const h8*)(PR ? (A + pr32_off(m0 + r, c * 8, K)) : (A + (size_t)(m0 + r) * lda + krot + c * 8)); }
#pragma unroll
  for (int i = 0; i < BCH; ++i) { int idx = tid + i * 256, r = idx / CPR, c = idx % CPR; rb[i] = *(const h8*)(PR ? (Bt + pr32_off(n0 + r, c * 8, K)) : (Bt + (size_t)(n0 + r) * ldb + krot + c * 8)); }
  for (int k0 = 0; k0 < K; k0 += GBK) {
    __syncthreads();
#pragma unroll
    for (int i = 0; i < ACH; ++i) { int idx = tid + i * 256, r = idx / CPR, c = idx % CPR; *(h8*)(sA + r * GLD + c * 8) = ra[i]; }
#pragma unroll
    for (int i = 0; i < BCH; ++i) { int idx = tid + i * 256, r = idx / CPR, c = idx % CPR; *(h8*)(sB + r * GLD + c * 8) = rb[i]; }
    __syncthreads();
    if (k0 + GBK < K) {
      int kn = k0 + GBK + krot; kn = kn >= K ? kn - K : kn;
#pragma unroll
      for (int i = 0; i < ACH; ++i) { int idx = tid + i * 256, r = idx / CPR, c = idx % CPR; ra[i] = *(const h8*)(PR ? (A + pr32_off(m0 + r, kn + c * 8, K)) : (A + (size_t)(m0 + r) * lda + kn + c * 8)); }
#pragma unroll
      for (int i = 0; i < BCH; ++i) { int idx = tid + i * 256, r = idx / CPR, c = idx % CPR; rb[i] = *(const h8*)(PR ? (Bt + pr32_off(n0 + r, kn + c * 8, K)) : (Bt + (size_t)(n0 + r) * ldb + kn + c * 8)); }
    }
#pragma unroll
    for (int ks = 0; ks < GBK / 32; ++ks) {
      h8 af[MT], bf[4];
#pragma unroll
      for (int mt = 0; mt < MT; ++mt) af[mt] = *(const h8*)(sA + (wm * (BM / 2) + mt * 16 + (lane & 15)) * GLD + ks * 32 + (lane >> 4) * 8);
#pragma unroll
      for (int nt = 0; nt < 4; ++nt) bf[nt] = *(const h8*)(sB + (wn * 64 + nt * 16 + (lane & 15)) * GLD + ks * 32 + (lane >> 4) * 8);
#pragma unroll
      for (int mt = 0; mt < MT; ++mt)
#pragma unroll
        for (int nt = 0; nt < 4; ++nt) acc[mt][nt] = I8 ? mfma16_i8(af[mt], bf[nt], acc[mt][nt]) : mfma16(af[mt], bf[nt], acc[mt][nt]);
    }
  }
}
template <int BM, bool I8 = false>
DI void gemm_mainloop_r3(f4 (&acc)[BM / 32][4], const hf* __restrict__ A, int lda, const hf* __restrict__ Bt, int ldb, int K, int m0, int n0, char* smem) {
  constexpr int GLD = 72, MT = BM / 32, ACH = BM * 8 / 256;
  hf* sA = (hf*)smem; hf* sB = sA + BM * GLD;
  const int tid = get_tid(), lane = tid & 63, wave = tid >> 6, wm = wave >> 1, wn = wave & 1;
  const int nk = K / 64;
  h8 a0[ACH], b0[4], a1[ACH], b1[4], a2[ACH], b2[4];
  const hf* Ap = A + (size_t)(m0 + (tid >> 3)) * lda + (tid & 7) * 8;
  const hf* Bp = Bt + (size_t)(n0 + (tid >> 3)) * ldb + (tid & 7) * 8;
#define GL(ra, rb, kt) { const int kk_ = ((kt) < nk ? (kt) : nk - 1) * 64; \
    _Pragma("unroll") for (int i = 0; i < ACH; ++i) ra[i] = *(const h8*)(Ap + (size_t)(i * 32) * lda + kk_); \
    _Pragma("unroll") for (int i = 0; i < 4; ++i) rb[i] = *(const h8*)(Bp + (size_t)(i * 32) * ldb + kk_); }
#define GSTEP(ra, rb, knext) { __syncthreads(); \
    _Pragma("unroll") for (int i = 0; i < ACH; ++i) *(h8*)(sA + ((tid >> 3) + i * 32) * GLD + (tid & 7) * 8) = ra[i]; \
    _Pragma("unroll") for (int i = 0; i < 4; ++i) *(h8*)(sB + ((tid >> 3) + i * 32) * GLD + (tid & 7) * 8) = rb[i]; \
    __syncthreads(); \
    GL(ra, rb, knext) \
    _Pragma("unroll") for (int ks = 0; ks < 2; ++ks) { h8 af[MT], bf[4]; \
      _Pragma("unroll") for (int mt = 0; mt < MT; ++mt) af[mt] = *(const h8*)(sA + (wm * (BM / 2) + mt * 16 + (lane & 15)) * GLD + ks * 32 + (lane >> 4) * 8); \
      _Pragma("unroll") for (int nt = 0; nt < 4; ++nt) bf[nt] = *(const h8*)(sB + (wn * 64 + nt * 16 + (lane & 15)) * GLD + ks * 32 + (lane >> 4) * 8); \
      _Pragma("unroll") for (int mt = 0; mt < MT; ++mt) _Pragma("unroll") for (int nt = 0; nt < 4; ++nt) acc[mt][nt] = I8 ? mfma16_i8(af[mt], bf[nt], acc[mt][nt]) : mfma16(af[mt], bf[nt], acc[mt][nt]); } }
  GL(a0, b0, 0) GL(a1, b1, 1) GL(a2, b2, 2)
  for (int kt = 0; kt < nk; kt += 3) {
    GSTEP(a0, b0, kt + 3)
    if (kt + 1 < nk) GSTEP(a1, b1, kt + 4)
    if (kt + 2 < nk) GSTEP(a2, b2, kt + 5)
  }
#undef GL
#undef GSTEP
}
constexpr int TLD = 136;
template <int MT> DI void zero_acc(f4 (&acc)[MT][4]) {
#pragma unroll
  for (int i = 0; i < MT; ++i)
#pragma unroll
    for (int j = 0; j < 4; ++j) acc[i][j] = f4{0.f, 0.f, 0.f, 0.f};
}


DI const volatile unsigned* xcd_words(char* smem);
struct TileSched { int s, step, total, rp0, ntn, sr; };
DI TileSched tile_begin(int NTM_, int NTN_, const void* g_bar = nullptr, const volatile unsigned* g_st = nullptr) {
  const int G = (int)gridDim.x;
  const int ng = (G % 8 == 0 && NTM_ % 8 == 0) ? 8 : ((G % 4 == 0 && NTM_ % 4 == 0) ? 4 : 1);
  int x = (int)blockIdx.x % ng, li = (int)blockIdx.x / ng; const int rpg = NTM_ / ng;
#ifndef EMU
  if (ng == 8) {
    const unsigned* bar = (const unsigned*)g_bar; bool ok = true;
#pragma unroll
    for (int j = 0; j < 8; ++j) ok = ok && (__hip_atomic_load(&bar[XB_XCNT(j)], __ATOMIC_RELAXED, __HIP_MEMORY_SCOPE_AGENT) == (unsigned)(G / 8));
    if (ok) { x = (int)g_st[2]; li = (int)g_st[3]; }
  }
#endif
  TileSched t; t.s = li; t.step = G / ng; t.total = rpg * NTN_; t.rp0 = x * rpg; t.ntn = NTN_; t.sr = (rpg % 8 == 0) ? 8 : ((rpg % 4 == 0) ? 4 : ((rpg % 2 == 0) ? 2 : 1));
  return t;
}
DI bool tile_next(TileSched& t, int& tm, int& tn) {
  if (t.s >= t.total) return false;
  const int SC = 8;
  const int per_rg = t.sr * t.ntn, rg = t.s / per_rg, rem = t.s % per_rg, nfull = t.ntn / SC, fullsz = nfull * t.sr * SC;
  int r, c, cg;
  if (rem < fullsz) { cg = rem / (t.sr * SC); const int loc = rem % (t.sr * SC); r = loc / SC; c = loc % SC; }
  else { const int loc = rem - fullsz, w = t.ntn - nfull * SC; cg = nfull; r = loc / w; c = loc % w; }
  tm = t.rp0 + rg * t.sr + r; tn = cg * SC + c; t.s += t.step;
  return true;
}

DI int win_colmap(int c) {
  if (c < 1872) return c;
  if (c < 1880) return 3920 + (c - 1872);
  if (c < 1888) return 3928 + (c - 1880);
  if (c < 1920) return -1;
  if (c < 3968) return 1872 + (c - 1920);
  return 3936 + (c - 3968);
}
DI void transpose_tile(const float* src, int lds_, hf* dst, int K, int k0, int n0, bool use_map, char* smem, bool pr = false) {
  float* t = (float*)smem;
  const int tid = get_tid(), c = tid & 63, r0 = tid >> 6;
  int sc = use_map ? win_colmap(n0 + c) : (n0 + c);
  __syncthreads();
  float tv[16];
#pragma unroll
  for (int i = 0; i < 16; ++i) { int r = i * 4 + r0; tv[i] = sc >= 0 ? src[(size_t)(k0 + r) * lds_ + sc] : 0.f; }
#pragma unroll
  for (int i = 0; i < 16; ++i) t[c * 65 + i * 4 + r0] = tv[i];
  __syncthreads();
#pragma unroll 4
  for (int i = 0; i < 16; ++i) { int r = i * 4 + r0; dst[pr ? pr32_off(n0 + r, k0 + c, K) : ((size_t)(n0 + r) * K + k0 + c)] = (hf)t[r * 65 + c]; }
}
DI void phase_A(const Params& p, char* smem) {
  float* mod = (float*)(p.ws + O_MOD);
  const int tid = get_tid(), lane = tid & 63, wave = tid >> 6;
  constexpr int N_MOD = 6 * DM / 64;
  constexpr int N_WIN = (NP / 64) * (DM / 64), N_WPA = (DM / 64) * 8, N_WO = (DM / 64) * (DM / 64), N_WQ = 16 * (DM / 64);
  constexpr int N_SUBK = 8, N_CS = NTOK / 256;
  constexpr int T1 = N_MOD, T2 = T1 + N_WIN, T3 = T2 + N_WPA, T4 = T3 + N_WPA, T5 = T4 + N_WO, T6 = T5 + N_WQ, T7 = T6 + N_SUBK, T8 = T7 + N_CS;
  if (blockIdx.x == 0) { if (tid < 64) ((int*)(p.ws + O_CNT))[tid] = 0; for (int i = tid; i < 4096; i += 256) ((unsigned*)(p.ws + O_BAR))[i] = 0u; }
  for (int it = blockIdx.x; it < T8; it += gridDim.x) {
    if (it < T1) {
      float* sil = (float*)smem;
      float* red = sil + BATCH * DM;
      __syncthreads();
      for (int i = tid; i < BATCH * DM; i += 256) sil[i] = siluf_(p.c[i]);
      __syncthreads();
      const int j = it * 64 + lane;
      float a[BATCH];
#pragma unroll
      for (int b = 0; b < BATCH; ++b) a[b] = 0.f;
      for (int k = wave * (DM / 4); k < (wave + 1) * (DM / 4); ++k) {
        float w = p.w_ada[(size_t)k * 6 * DM + j];
#pragma unroll
        for (int b = 0; b < BATCH; ++b) a[b] += sil[b * DM + k] * w;
      }
#pragma unroll
      for (int b = 0; b < BATCH; ++b) red[(wave * BATCH + b) * 64 + lane] = a[b];
      __syncthreads();
      if (wave == 0) {
#pragma unroll
        for (int b = 0; b < BATCH; ++b) {
          float s = red[(0 * BATCH + b) * 64 + lane] + red[(1 * BATCH + b) * 64 + lane] + red[(2 * BATCH + b) * 64 + lane] + red[(3 * BATCH + b) * 64 + lane];
          mod[(size_t)b * 6 * DM + j] = s + p.b_ada[j];
        }
      }
    } else if (it < T2) { int t = it - T1; transpose_tile(p.w_in, IN_W, (hf*)(p.ws + O_WIN), DM, (t % (DM / 64)) * 64, (t / (DM / 64)) * 64, true, smem, true); }
    else if (it < T3) { int t = it - T2; transpose_tile(p.w_pa, DM, (hf*)(p.ws + O_WPA), 512, (t % 8) * 64, (t / 8) * 64, false, smem); }
    else if (it < T4) { int t = it - T3; transpose_tile(p.w_pb, DM, (hf*)(p.ws + O_WPB), 512, (t % 8) * 64, (t / 8) * 64, false, smem); }
    else if (it < T5) { int t = it - T4; transpose_tile(p.w_o, DM, (hf*)(p.ws + O_WO), DM, (t % (DM / 64)) * 64, (t / (DM / 64)) * 64, false, smem, true); }
    else if (it < T6) { int t = it - T5; transpose_tile(p.wq, 1024, (hf*)(p.ws + O_WQ), DM, (t % (DM / 64)) * 64, (t / (DM / 64)) * 64, false, smem); }
    else if (it < T7) { int t = it - T6; hf* d = (hf*)(p.ws + O_SUBK); for (int i = tid; i < 16384; i += 256) d[t * 16384 + i] = (hf)p.subk[t * 16384 + i]; }
    else {
      int tok = (it - T7) * 256 + tid;
      float* cs = (float*)(p.ws + O_CS) + (size_t)tok * 16;
      float pos = (float)p.pos[tok];
#pragma unroll
      for (int i = 0; i < 8; ++i) { float inv = powf(500000.0f, -(float)i * 0.125f); float ang = pos * inv; cs[i] = cosf(ang); cs[8 + i] = sinf(ang); }
    }
  }
}

DI void adaln_rows(const float* src, hf* dst, const float* mod, int sh_off, int sc_off, bool pr) {
  const int tid = get_tid(), lane = tid & 63, wave = tid >> 6;
  for (int row = blockIdx.x * 4 + wave; row < NTOK; row += gridDim.x * 4) {
    const float* xr = src + (size_t)row * DM; const int b = row / SEQ;
    float v[DM / 64]; float ss = 0.f;
#pragma unroll
    for (int i = 0; i < DM / 256; ++i) { f4 t = *(const f4*)(xr + i * 256 + lane * 4); v[4 * i] = t[0]; v[4 * i + 1] = t[1]; v[4 * i + 2] = t[2]; v[4 * i + 3] = t[3]; ss += t[0] * t[0] + t[1] * t[1] + t[2] * t[2] + t[3] * t[3]; }
    ss = wave_sum(ss);
    float rstd = rsqrtf(ss * (1.0f / DM) + EPSN);
    const float* mb = mod + (size_t)b * 6 * DM;
#pragma unroll
    for (int i = 0; i < DM / 256; ++i) {
      int d = i * 256 + lane * 4; h4 o;
#pragma unroll
      for (int j = 0; j < 4; ++j) o[j] = (hf)(v[4 * i + j] * rstd * (1.0f + mb[sc_off + d + j]) + mb[sh_off + d + j]);
      *(h4*)(dst + (pr ? pr32_off(row, d, DM) : ((size_t)row * DM + d))) = o;
    }
  }
}

constexpr size_t Q_W8 = 0, Q_SB = al256((size_t)NP * DM), Q_N1 = al256(Q_SB + (size_t)NP * 4), Q_SA = Q_N1 + (size_t)NTOK * DM;
static_assert(Q_SA + (size_t)NTOK * 4 <= DSCAN_BYTES, "scan scratch too small for the int8 in-projection operands");
#ifndef TN_I8
#define TN_I8 0
#endif
DI size_t pr64b_off(int row, int k, int K) { return ((size_t)(row >> 1) * (K / 64) + (k >> 6)) * 128 + (row & 1) * 64 + (k & 63); }
DI void phase_B(const Params& p) {
  const int tid = get_tid(), lane = tid & 63, wave = tid >> 6;
  const float* mod = (const float*)(p.ws + O_MOD);
  signed char* n1q = (signed char*)(TN_I8 > 0 ? p.dscan + Q_N1 : p.ws + O_R); float* sa = (float*)(TN_I8 > 0 ? p.dscan + Q_SA : p.ws + O_R + (size_t)NTOK * DM); hf* n1h = (hf*)(p.ws + O_R);
  signed char* w8 = (signed char*)(p.ws + O_W8); float* sb = (float*)(p.ws + O_SB8);
  for (int row = blockIdx.x * 4 + wave; row < NTOK; row += gridDim.x * 4) {
    const float* xr = p.x + (size_t)row * DM; const int b = row / SEQ;
    float v[DM / 64]; float ss = 0.f;
#pragma unroll
    for (int i = 0; i < DM / 256; ++i) { f4 t = *(const f4*)(xr + i * 256 + lane * 4); v[4 * i] = t[0]; v[4 * i + 1] = t[1]; v[4 * i + 2] = t[2]; v[4 * i + 3] = t[3]; ss += t[0] * t[0] + t[1] * t[1] + t[2] * t[2] + t[3] * t[3]; }
    ss = wave_sum(ss);
    const float rstd = rsqrtf(ss * (1.0f / DM) + EPSN);
    const float* mb = mod + (size_t)b * 6 * DM;
    float mx = 0.f;
#pragma unroll
    for (int i = 0; i < DM / 256; ++i)
#pragma unroll
      for (int j = 0; j < 4; ++j) { const int d = i * 256 + lane * 4 + j; v[4 * i + j] = v[4 * i + j] * rstd * (1.0f + mb[DM + d]) + mb[d]; mx = fmaxf(mx, fabsf(v[4 * i + j])); }
    if (TN_I8 > 0) {
#pragma unroll
      for (int i = 0; i < DM / 256; ++i) { h4 o; o[0] = (hf)v[4 * i]; o[1] = (hf)v[4 * i + 1]; o[2] = (hf)v[4 * i + 2]; o[3] = (hf)v[4 * i + 3]; *(h4*)(n1h + pr32_off(row, i * 256 + lane * 4, DM)) = o; }
    }
#pragma unroll
    for (int m = 32; m >= 1; m >>= 1) mx = fmaxf(mx, __shfl_xor(mx, m));
    const float sc = mx > 0.f ? mx * (1.0f / 127.0f) : 1.0f, inv = 1.0f / sc;
#pragma unroll
    for (int i = 0; i < DM / 256; ++i) {
      unsigned w = 0;
#pragma unroll
      for (int j = 0; j < 4; ++j) { int qv = (int)rintf(v[4 * i + j] * inv); qv = qv > 127 ? 127 : (qv < -127 ? -127 : qv); w |= ((unsigned)qv & 255u) << (8 * j); }
      *(unsigned*)(n1q + pr64b_off(row, i * 256 + lane * 4, DM)) = w;
    }
    if (lane == 0) sa[row] = sc;
  }
  const hf* WinT = (const hf*)(p.ws + O_WIN);
  for (int n = blockIdx.x * 4 + wave; n < NP; n += gridDim.x * 4) {
    constexpr int EPL = DM / 64;
    const hf* wr = WinT + pr32_off(n, lane * EPL, DM);
    float v[EPL]; float mx = 0.f;
#pragma unroll
    for (int i = 0; i < EPL; ++i) { v[i] = (float)wr[i]; mx = fmaxf(mx, fabsf(v[i])); }
#pragma unroll
    for (int m = 32; m >= 1; m >>= 1) mx = fmaxf(mx, __shfl_xor(mx, m));
    const float sc = mx > 0.f ? mx * (1.0f / 127.0f) : 1.0f, inv = 1.0f / sc;
#pragma unroll
    for (int i4_ = 0; i4_ < EPL / 4; ++i4_) {
      unsigned w = 0;
#pragma unroll
      for (int j = 0; j < 4; ++j) { int qv = (int)rintf(v[4 * i4_ + j] * inv); qv = qv > 127 ? 127 : (qv < -127 ? -127 : qv); w |= ((unsigned)qv & 255u) << (8 * j); }
      *(unsigned*)(w8 + pr64b_off(n, lane * EPL + 4 * i4_, DM)) = w;
    }
    if (lane == 0) sb[n] = sc;
  }
  const hf* WqT = (const hf*)(p.ws + O_WQ); signed char* wq8 = (signed char*)(p.ws + O_WQ8); float* sq8 = (float*)(p.ws + O_SQ8);
  for (int n = blockIdx.x * 4 + wave; n < 1024; n += gridDim.x * 4) {
    constexpr int EPL = DM / 64;
    const hf* wr = WqT + (size_t)n * DM + lane * EPL;
    float v[EPL]; float mx = 0.f;
#pragma unroll
    for (int i = 0; i < EPL; ++i) { v[i] = (float)wr[i]; mx = fmaxf(mx, fabsf(v[i])); }
#pragma unroll
    for (int m = 32; m >= 1; m >>= 1) mx = fmaxf(mx, __shfl_xor(mx, m));
    const float sc = mx > 0.f ? mx * (1.0f / 127.0f) : 1.0f, inv = 1.0f / sc;
#pragma unroll
    for (int i4_ = 0; i4_ < EPL / 4; ++i4_) {
      unsigned w = 0;
#pragma unroll
      for (int j = 0; j < 4; ++j) { int qv = (int)rintf(v[4 * i4_ + j] * inv); qv = qv > 127 ? 127 : (qv < -127 ? -127 : qv); w |= ((unsigned)qv & 255u) << (8 * j); }
      *(unsigned*)(wq8 + (size_t)n * DM + lane * EPL + 4 * i4_) = w;
    }
    if (lane == 0) sq8[n] = sc;
  }
}
DI void phase_C(const Params& p, char* smem) {
  const hf* n1h = (const hf*)(p.ws + O_R); const hf* WinT = (const hf*)(p.ws + O_WIN);
  const hf* n1q = (const hf*)(TN_I8 > 0 ? p.dscan + Q_N1 : p.ws + O_R); const hf* W8 = (const hf*)(p.ws + O_W8);
  const float* sa = (const float*)(TN_I8 > 0 ? p.dscan + Q_SA : p.ws + O_R + (size_t)NTOK * DM); const float* sb = (const float*)(p.ws + O_SB8);
  hf* P1 = (hf*)(p.ws + O_P1); hf* P2 = (hf*)(p.ws + O_P2); hf* P3 = (hf*)(p.ws + O_P3); hf* P4 = (hf*)(p.ws + O_P4);
  float* aux = (float*)(p.ws + O_AUX); const float* cs = (const float*)(p.ws + O_CS);
  const int lane = get_tid() & 63, wave = get_tid() >> 6, wm = wave >> 1, wn = wave & 1, q = lane >> 4, cl = lane & 15;
  constexpr int CBM = 256, CMT = CBM / 32, NTN = NP / 128, NTM = NTOK / CBM;
  TileSched ts = tile_begin(NTM, NTN, p.ws + O_BAR, xcd_words(smem)); int tm, tn;
  while (tile_next(ts, tm, tn)) {
    const int m0 = tm * CBM, n0 = tn * 128;
    f4 acc[CMT][4];
    for (int rep_ = 0; rep_ < REP_CMAIN; ++rep_) { zero_acc<CMT>(acc);
    if (tn >= TN_I8) gemm_mainloop<CBM, 32, true, true>(acc, n1q, DM / 2, W8, DM / 2, DM / 2, m0, n0, smem);
    else gemm_mainloop<CBM, 32, true, false>(acc, n1h, DM, WinT, DM, DM, m0, n0, smem); }
    const bool rope = (tn <= 4) || (tn >= 6 && tn <= 14);
    hf* tileS = (hf*)smem;
    for (int repe_ = 0; repe_ < REP_CEPI; ++repe_) {
    __syncthreads();
#pragma unroll
    for (int mt = 0; mt < CMT; ++mt) {
#pragma unroll
      for (int nt = 0; nt < 4; ++nt) {
        const int lrow = wm * (CBM / 2) + mt * 16 + q * 4, lcol = wn * 64 + nt * 16 + cl;
        const int rbase = m0 + lrow;
        f4 v = acc[mt][nt];
        if (tn >= TN_I8) { const i4 ai = __builtin_bit_cast(i4, acc[mt][nt]); const float sbn = sb[n0 + lcol]; const f4 sa4 = *(const f4*)(sa + rbase);
#pragma unroll
          for (int r = 0; r < 4; ++r) v[r] = (float)ai[r] * (sa4[r] * sbn); }
        if (rope && nt == 0 && !(tn == 14 && wn == 1)) {
#pragma unroll
          for (int r = 0; r < 4; ++r) {
            float pv = __shfl_xor(v[r], 8);
            const float* c2 = cs + (size_t)(rbase + r) * 16; float co = c2[cl & 7], si = c2[8 + (cl & 7)];
            v[r] = (cl < 8) ? (v[r] * co - pv * si) : (v[r] * co + pv * si);
          }
        }
        if (tn < 4) { v = v * 0.125f; }
        if (tn == 14 && wn == 1) {
          const int lc = nt * 16 + cl;
          if (lc < 32) {
            const int hh = lc & 7;
#pragma unroll
            for (int r = 0; r < 4; ++r) {
              float o;
              if (lc < 16) o = v[r] * (0.25f * 0.125f);
              else if (lc < 24) o = sigmoidf_(v[r]);
              else o = -__expf(p.a_log[hh]) * softplusf_(v[r] + p.dt_bias[hh]);
              aux[(size_t)(rbase + r) * 32 + lc] = o;
            }
          }
        } else {
          if (tn >= 31) {
#pragma unroll
            for (int r = 0; r < 4; ++r) v[r] = sigmoidf_(v[r]);
          }
#pragma unroll
          for (int r = 0; r < 4; ++r) tileS[(lrow + r) * TLD + lcol] = (hf)v[r];
        }
      }
    }
    __syncthreads();
    {
      hf* dst; int ld, nch = 16;
      if (tn < 15) { dst = P1 + n0; ld = LP1; if (tn == 14) nch = 8; }
      else if (tn < 27) { dst = P2 + (n0 - C_QB); ld = LP2; }
      else if (tn < 31) { dst = P3 + (n0 - C_ZB); ld = LP3; }
      else { dst = P4 + (n0 - C_GA); ld = LP4; }
      const int tid = get_tid();
#pragma unroll
      for (int i = 0; i < CBM / 16; ++i) {
        const int idx = tid + i * 256, row = idx >> 4, ch = idx & 15;
        if (ch < nch) *(h8*)(dst + (size_t)(m0 + row) * ld + ch * 8) = *(const h8*)(tileS + row * TLD + ch * 8);
      }
    }
    }
  }
}

DI void phase_D1(const Params& p, char* smem) {
  const hf* P2 = (const hf*)(p.ws + O_P2); const float* aux = (const float*)(p.ws + O_AUX);
  hf* Qs = (hf*)smem;
  hf* Ks = Qs + 64 * 72;
  float* RHS = (float*)(Ks + 64 * 72);
  float* Lm = RHS + 64 * 128;
  float* gcs = Lm + 64 * 64;
  float* bts = gcs + 64;
  const int tid = get_tid(), lane = tid & 63, wave = tid >> 6, q = lane >> 4, cl = lane & 15;
  constexpr size_t MSZ = (size_t)NTOK * 512;
  hf* uT = (hf*)p.dscan; hf* wm_ = uT + MSZ; hf* qg = wm_ + MSZ; hf* kdT = qg + MSZ; hf* intra = (hf*)(p.ws + O_INTRA);
  float* eg = (float*)(p.ws + O_EG);
  for (int it = blockIdx.x; it < BATCH * 8 * NCHK; it += gridDim.x) {
    const int c = it % NCHK, h = (it / NCHK) % 8, b = it / (NCHK * 8);
    const size_t cbase = (size_t)it * 4096;
    const int tk = tid >> 2, qq = tid & 3, t0 = c * 64;
    const size_t grow = (size_t)b * SEQ + t0 + tk;
    __syncthreads();
    float g = aux[grow * 32 + 24 + h], beta = aux[grow * 32 + 16 + h];
    if (qq == 0) { gcs[tk] = g; bts[tk] = beta; }
    float val[3][16];
#pragma unroll
    for (int m = 0; m < 3; ++m) {
      const int ch0 = m * 512 + h * 64 + qq * 16;
#pragma unroll
      for (int e = 0; e < 16; ++e) val[m][e] = 0.f;
#pragma unroll
      for (int i = 0; i < 4; ++i) {
        const int tt = t0 + tk - 3 + i;
        if (tt >= 0) {
          const hf* src = P2 + ((size_t)b * SEQ + tt) * LP2 + ch0;
          h8 x0 = *(const h8*)src, x1 = *(const h8*)(src + 8);
          const float* wv = p.conv_w + (size_t)i * 1536 + ch0;
#pragma unroll
          for (int e = 0; e < 8; ++e) { val[m][e] += (float)x0[e] * wv[e]; val[m][8 + e] += (float)x1[e] * wv[8 + e]; }
        }
      }
#pragma unroll
      for (int e = 0; e < 16; ++e) val[m][e] = siluf_(val[m][e]);
    }
    float sq = 0.f, sk = 0.f;
#pragma unroll
    for (int e = 0; e < 16; ++e) { sq += val[0][e] * val[0][e]; sk += val[1][e] * val[1][e]; }
    sq += __shfl_xor(sq, 1); sq += __shfl_xor(sq, 2); sk += __shfl_xor(sk, 1); sk += __shfl_xor(sk, 2);
    const float nq = rsqrtf(sq + EPSN) * 0.125f, nk = rsqrtf(sk + EPSN);
    __syncthreads();
    if (wave == 0) { float v = gcs[lane];
#pragma unroll
      for (int d = 1; d < 64; d <<= 1) { const float y = __shfl(v, lane - d); if (lane >= d) v += y; }
      gcs[lane] = v; }
    __syncthreads();
    const float gc = gcs[tk], glast = gcs[63];
    const float egc = __expf(gc), ekd = __expf(glast - gc);
    if (tid == 0) eg[it] = __expf(glast);
#pragma unroll
    for (int e = 0; e < 16; ++e) {
      const int ch = qq * 16 + e;
      const float qv = val[0][e] * nq, kv = val[1][e] * nk, vv = val[2][e];
      Qs[tk * 72 + ch] = (hf)qv; Ks[tk * 72 + ch] = (hf)kv;
      RHS[tk * 128 + ch] = vv * beta; RHS[tk * 128 + 64 + ch] = kv * beta * egc;
      qg[cbase + tk * 64 + ch] = (hf)(qv * egc);
      kdT[cbase + ch * 64 + tk] = (hf)(kv * ekd);
    }
    __syncthreads();
    {
      f4 akk[4], aqk[4];
#pragma unroll
      for (int nt = 0; nt < 4; ++nt) { akk[nt] = f4{0, 0, 0, 0}; aqk[nt] = f4{0, 0, 0, 0}; }
#pragma unroll
      for (int ks = 0; ks < 2; ++ks) {
        h8 ak = *(const h8*)(Ks + (wave * 16 + cl) * 72 + ks * 32 + q * 8);
        h8 aq = *(const h8*)(Qs + (wave * 16 + cl) * 72 + ks * 32 + q * 8);
#pragma unroll
        for (int nt = 0; nt < 4; ++nt) {
          h8 bk = *(const h8*)(Ks + (nt * 16 + cl) * 72 + ks * 32 + q * 8);
          akk[nt] = mfma16(ak, bk, akk[nt]); aqk[nt] = mfma16(aq, bk, aqk[nt]);
        }
      }
#pragma unroll
      for (int nt = 0; nt < 4; ++nt) {
        const int j = nt * 16 + cl; const float gj = gcs[j];
#pragma unroll
        for (int r = 0; r < 4; ++r) {
          const int i = wave * 16 + q * 4 + r;
          const float dec = (i >= j) ? __expf(gcs[i] - gj) : 0.f;
          Lm[i * 64 + j] = (i > j) ? bts[i] * akk[nt][r] * dec : 0.f;
          intra[cbase + i * 64 + j] = (hf)(aqk[nt][r] * dec);
        }
      }
    }
    __syncthreads();
    if (wave < 2) {
      float xr[64];
#pragma unroll
      for (int i = 0; i < 64; ++i) xr[i] = 0.f;
#pragma unroll
      for (int i = 0; i < 64; ++i) {
        float s0 = 0.f, s1 = 0.f, s2 = 0.f, s3 = 0.f;
#pragma unroll
        for (int j4 = 0; j4 < (i + 3) / 4; ++j4) {
          f4 l4 = *(const f4*)(Lm + i * 64 + j4 * 4);
          s0 += l4[0] * xr[j4 * 4]; s1 += l4[1] * xr[j4 * 4 + 1]; s2 += l4[2] * xr[j4 * 4 + 2]; s3 += l4[3] * xr[j4 * 4 + 3];
        }
        xr[i] = RHS[i * 128 + wave * 64 + lane] - ((s0 + s1) + (s2 + s3));
      }
      if (wave == 0) {
#pragma unroll
        for (int i8 = 0; i8 < 8; ++i8) { h8 o;
#pragma unroll
          for (int e = 0; e < 8; ++e) o[e] = (hf)xr[i8 * 8 + e];
          *(h8*)(uT + cbase + lane * 64 + i8 * 8) = o; }
      } else {
#pragma unroll
        for (int i = 0; i < 64; ++i) wm_[cbase + i * 64 + lane] = (hf)xr[i];
      }
    }
  }
}

constexpr int E1_MAT = 64 * 72;
constexpr int LDS_E1 = 2 * 4 * E1_MAT * 2;
DI void phase_E1(const Params& p, char* smem) {
  const int tid = get_tid(), lane = tid & 63, wave = tid >> 6, q = lane >> 4, cl = lane & 15;
  constexpr size_t MSZ = (size_t)NTOK * 512;
  const hf* uT = (const hf*)p.dscan; const hf* intra = (const hf*)(p.ws + O_INTRA);
  const hf* mats[4] = {uT + MSZ, uT + 2 * MSZ, intra, uT + 3 * MSZ};
  const float* eg = (const float*)(p.ws + O_EG);
  hf* ob = (hf*)(p.ws + O_OB);
  hf* lbuf = (hf*)smem;
  for (int bh = blockIdx.x; bh < BATCH * 8; bh += gridDim.x) {
    const int b = bh / 8, h = bh % 8, e0 = wave * 16;
    f4 S[4];
#pragma unroll
    for (int i = 0; i < 4; ++i) S[i] = f4{0, 0, 0, 0};
    h8 st[8]; h4 un[4];
    {
      const size_t cbase = (size_t)bh * NCHK * 4096;
#pragma unroll
      for (int i = 0; i < 8; ++i) { const int idx = tid + i * 256, m = idx >> 9, r = (idx >> 3) & 63, c8 = idx & 7; st[i] = *(const h8*)(mats[m] + cbase + r * 64 + c8 * 8); }
#pragma unroll
      for (int mt = 0; mt < 4; ++mt) un[mt] = *(const h4*)(uT + cbase + (e0 + cl) * 64 + mt * 16 + q * 4);
      __syncthreads();
#pragma unroll
      for (int i = 0; i < 8; ++i) { const int idx = tid + i * 256, m = idx >> 9, r = (idx >> 3) & 63, c8 = idx & 7; *(h8*)(lbuf + m * E1_MAT + r * 72 + c8 * 8) = st[i]; }
      __syncthreads();
    }
    for (int c = 0; c < NCHK; ++c) {
      const hf* L = lbuf + (c & 1) * 4 * E1_MAT;
      const hf* Lw = L, *Lq = L + E1_MAT, *Li = L + 2 * E1_MAT, *Lk = L + 3 * E1_MAT;
      h4 uc[4];
#pragma unroll
      for (int mt = 0; mt < 4; ++mt) uc[mt] = un[mt];
      if (c + 1 < NCHK) {
        const size_t cb2 = ((size_t)bh * NCHK + c + 1) * 4096;
#pragma unroll
        for (int i = 0; i < 8; ++i) { const int idx = tid + i * 256, m = idx >> 9, r = (idx >> 3) & 63, c8 = idx & 7; st[i] = *(const h8*)(mats[m] + cb2 + r * 64 + c8 * 8); }
#pragma unroll
        for (int mt = 0; mt < 4; ++mt) un[mt] = *(const h4*)(uT + cb2 + (e0 + cl) * 64 + mt * 16 + q * 4);
      }
      const float egl = eg[bh * NCHK + c];
      h8 Sb[2]; Sb[0] = cvt_f4f4(S[0], S[1]); Sb[1] = cvt_f4f4(S[2], S[3]);
      f4 vn[4];
#pragma unroll
      for (int mt = 0; mt < 4; ++mt) {
        f4 a = f4{0, 0, 0, 0};
#pragma unroll
        for (int ks = 0; ks < 2; ++ks) a = mfma16(permload(Lw + (mt * 16 + cl) * 72 + ks * 32, q), Sb[ks], a);
#pragma unroll
        for (int r = 0; r < 4; ++r) vn[mt][r] = (float)uc[mt][r] - a[r];
      }
      h8 Vb[2]; Vb[0] = cvt_f4f4(vn[0], vn[1]); Vb[1] = cvt_f4f4(vn[2], vn[3]);
#pragma unroll
      for (int mt = 0; mt < 4; ++mt) {
        f4 o = f4{0, 0, 0, 0};
#pragma unroll
        for (int ks = 0; ks < 2; ++ks) {
          o = mfma16(permload(Lq + (mt * 16 + cl) * 72 + ks * 32, q), Sb[ks], o);
          o = mfma16(permload(Li + (mt * 16 + cl) * 72 + ks * 32, q), Vb[ks], o);
        }
#pragma unroll
        for (int r = 0; r < 4; ++r) ob[((size_t)b * SEQ + c * 64 + mt * 16 + q * 4 + r) * 512 + h * 64 + e0 + cl] = (hf)o[r];
      }
#pragma unroll
      for (int mt = 0; mt < 4; ++mt) {
        f4 sacc = S[mt] * egl;
#pragma unroll
        for (int ks = 0; ks < 2; ++ks) sacc = mfma16(permload(Lk + (mt * 16 + cl) * 72 + ks * 32, q), Vb[ks], sacc);
        S[mt] = sacc;
      }
      if (c + 1 < NCHK) {
        hf* Ln = lbuf + ((c + 1) & 1) * 4 * E1_MAT;
#pragma unroll
        for (int i = 0; i < 8; ++i) { const int idx = tid + i * 256, m = idx >> 9, r = (idx >> 3) & 63, c8 = idx & 7; *(h8*)(Ln + m * E1_MAT + r * 72 + c8 * 8) = st[i]; }
      }
      __syncthreads();
    }
    drain_stores();
    __syncthreads();
    if (tid == 0) { fence_release_agent(); add_relaxed_agent((unsigned*)(p.ws + O_CNT) + 48, 1u); }
  }
}

DI void obnorm_pass(const Params& p) {
  hf* ob = (hf*)(p.ws + O_OB); const hf* P3 = (const hf*)(p.ws + O_P3);
  const int lane = get_tid() & 63, wave = get_tid() >> 6;
  for (int row = blockIdx.x * 4 + wave; row < NTOK; row += gridDim.x * 4) {
    h8 v = *(const h8*)(ob + (size_t)row * 512 + lane * 8);
    h8 z = *(const h8*)(P3 + (size_t)row * 512 + lane * 8);
    float f[8], ss = 0.f;
#pragma unroll
    for (int e = 0; e < 8; ++e) { f[e] = (float)v[e]; ss += f[e] * f[e]; }
    ss += __shfl_xor(ss, 1); ss += __shfl_xor(ss, 2); ss += __shfl_xor(ss, 4);
    const float rstd = rsqrtf(ss * (1.0f / 64.0f) + EPSN);
    h8 o;
#pragma unroll
    for (int e = 0; e < 8; ++e) o[e] = (hf)(f[e] * rstd * p.norm_b_w[(lane & 7) * 8 + e] * siluf_((float)z[e]));
    *(h8*)(ob + (size_t)row * 512 + lane * 8) = o;
  }
}

constexpr int SELN = TOPK + 64;
constexpr int CAPC = 128;
constexpr int E2_WAVE_LDS = SELN * 4 + SELN * 8 * 4 + 256 * 4 + CAPC * 8;
DI int bin_of(float v, float vmin, float sc) { int bq = (int)((v - vmin) * sc); return bq > 255 ? 255 : (bq < 0 ? 0 : bq); }
DI void attn_token(const Params& p, int b, int t, float* srow, int* sel, float* Sb, hf* Vt1, int lane, bool dry) {
  unsigned* hist = (unsigned*)(Sb + SELN * 8); unsigned* candk = hist + 256; int* candi = (int*)(candk + CAPC);
  hf* P1 = (hf*)(p.ws + O_P1);
#ifndef EMU
  asm volatile("" : "+v"(lane));
#endif
  const int q = lane >> 4, cl = lane & 15;
  const int n = t + 1;
  int cnt;
  for (int rep_ = 0; rep_ < REP_SEL; ++rep_) {
  if (n <= TOPK) {
    cnt = n;
    for (int i = lane; i < SELN; i += 64) sel[i] = (i < n) ? i : 0;
  } else {
    cnt = TOPK;
    float val[SEQ / 64];
    {
      const hf* pb = (const hf*)srow + lane;
#pragma unroll
      for (int jg = 0; jg < SEQ / 64 / 8; ++jg) {
#ifndef EMU
        asm volatile("" : "+v"(pb));
#endif
#pragma unroll
        for (int jj = 0; jj < 8; ++jj) { const int j = jg * 8 + jj; const float v = (float)pb[jj * 64]; val[j] = (j * 64 + lane < n) ? v : -INFINITY; }
        pb += 512;
      }
    }
    float vmin = INFINITY, vmax = -INFINITY;
#pragma unroll
    for (int j = 0; j < SEQ / 64; ++j) { vmax = fmaxf(vmax, val[j]); vmin = fminf(vmin, (j * 64 + lane < n) ? val[j] : INFINITY); }
#pragma unroll
    for (int m = 32; m >= 1; m >>= 1) { vmax = fmaxf(vmax, __shfl_xor(vmax, m)); vmin = fminf(vmin, __shfl_xor(vmin, m)); }
    const float bscale = 255.99f / (vmax - vmin);
    for (int i = lane; i < 256; i += 64) hist[i] = 0u;
    wave_sync();
#pragma unroll
    for (int j = 0; j < SEQ / 64; ++j) { if (j * 64 + lane < n) atomicAdd(&hist[bin_of(val[j], vmin, bscale)], 1u); }
    wave_sync();
    int tb, ca, nc;
    {
      const unsigned h0 = hist[4 * lane], h1 = hist[4 * lane + 1], h2 = hist[4 * lane + 2], h3 = hist[4 * lane + 3];
      const int sL = (int)(h0 + h1 + h2 + h3);
      int tt = sL;
#pragma unroll
      for (int d = 1; d < 64; d <<= 1) { const int y = __shfl(tt, lane + d); if (lane + d < 64) tt += y; }
      const int above = tt - sL;
      const int c3 = above + (int)h3, c2 = c3 + (int)h2, c1 = c2 + (int)h1, c0 = c1 + (int)h0;
      int tb_ = -1, ca_ = 0, nc_ = 0;
      if (above < TOPK && c0 >= TOPK) {
        if (c3 >= TOPK) { tb_ = 4 * lane + 3; ca_ = above; nc_ = (int)h3; }
        else if (c2 >= TOPK) { tb_ = 4 * lane + 2; ca_ = c3; nc_ = (int)h2; }
        else if (c1 >= TOPK) { tb_ = 4 * lane + 1; ca_ = c2; nc_ = (int)h1; }
        else { tb_ = 4 * lane; ca_ = c1; nc_ = (int)h0; }
      }
      const unsigned long long bm = __ballot(tb_ >= 0);
      const int src = bm ? (int)__builtin_ctzll(bm) : 0;
      tb = __shfl(tb_, src); ca = __shfl(ca_, src); nc = __shfl(nc_, src);
      if (bm == 0ull) nc = CAPC + 1;
    }
    const unsigned long long lt = (lane == 0) ? 0ull : (~0ull >> (64 - lane));
    if (nc <= CAPC) {
      int base_gt = 0, base_c = 0;
#pragma unroll
      for (int j = 0; j < SEQ / 64; ++j) {
        const bool valid = j * 64 + lane < n;
        const int bn = valid ? bin_of(val[j], vmin, bscale) : -1;
        const bool mg = bn > tb, me = bn == tb;
        const unsigned long long bg = __ballot(mg), be = __ballot(me);
        if (mg) sel[base_gt + __popcll(bg & lt)] = j * 64 + lane;
        if (me) { const int pos = base_c + __popcll(be & lt); candk[pos] = f2ord(val[j]); candi[pos] = j * 64 + lane; }
        base_gt += __popcll(bg); base_c += __popcll(be);
      }
      wave_sync();
      const int need = TOPK - ca;
      int base = ca;
#pragma unroll
      for (int hb = 0; hb < CAPC / 64; ++hb) {
        const int my = hb * 64 + lane;
        bool pick = false; int myi = 0;
        if (my < nc) {
          const unsigned mk = candk[my]; myi = candi[my];
          int rank = 0;
          for (int c2 = 0; c2 < nc; ++c2) { const unsigned ok = candk[c2]; const int oi = candi[c2]; rank += (ok > mk || (ok == mk && oi < myi)) ? 1 : 0; }
          pick = rank < need;
        }
        const unsigned long long bp = __ballot(pick);
        if (pick) sel[base + __popcll(bp & lt)] = myi;
        base += __popcll(bp);
      }
    } else {
      unsigned T = 0;
      for (int bit = 31; bit >= 0; --bit) {
        const unsigned cand = T | (1u << bit);
        int cl_ = 0;
#pragma unroll
        for (int j = 0; j < SEQ / 64; ++j) cl_ += (f2ord(val[j]) >= cand) ? 1 : 0;
        const int tot = wave_sum_i(cl_);
        if (tot >= TOPK) T = cand;
        if (tot == TOPK) { T = cand - 1u; break; }
      }
      int cgt = 0;
#pragma unroll
      for (int j = 0; j < SEQ / 64; ++j) cgt += (f2ord(val[j]) > T) ? 1 : 0;
      cgt = wave_sum_i(cgt);
      int base_gt = 0, base_eq = cgt;
#pragma unroll
      for (int j = 0; j < SEQ / 64; ++j) {
        const unsigned kj = f2ord(val[j]);
        const bool mg = kj > T, me = kj == T;
        const unsigned long long bg = __ballot(mg), be = __ballot(me);
        if (mg) sel[base_gt + __popcll(bg & lt)] = j * 64 + lane;
        if (me) { int pos = base_eq + __popcll(be & lt); if (pos < TOPK) sel[pos] = j * 64 + lane; }
        base_gt += __popcll(bg); base_eq += __popcll(be);
      }
    }
    sel[TOPK + lane] = 0;
  }
  wave_sync();
  }
  const int ng = (cnt + 63) / 64;
  const size_t trow = (size_t)b * SEQ + t;
  const hf* kvb = P1 + (size_t)b * SEQ * LP1;
  const int k8 = lane >> 3, dch = lane & 7;
  h8 vc[8], vn[8];
#pragma unroll
  for (int j = 0; j < 4; ++j) { const hf* vr = kvb + (size_t)sel[j * 8 + k8] * LP1 + C_VA + dch * 8; vc[j] = *(const h8*)vr; vc[4 + j] = *(const h8*)(vr + 64); }
  hf* P16 = (hf*)Sb;
  hf* Vt = (hf*)Sb + 8 * SELN;
  {
    constexpr int NG = TOPK / 64;
    const h8 z8 = h8{0, 0, 0, 0, 0, 0, 0, 0};
    h8 qb[4];
#pragma unroll
    for (int s = 0; s < 4; ++s) {
      const h8 v = *(const h8*)(P1 + trow * LP1 + C_QA + (cl & 7) * 64 + 32 * (s & 1) + 8 * q);
      qb[s] = (cl < 8 && (cl >> 2) == (s >> 1)) ? v : z8;
    }
    f4 S[NG * 4];
    h8 kc[4][4], kn[4][4];
#pragma unroll
    for (int u = 0; u < 4; ++u) { const hf* kr = kvb + (size_t)sel[u * 16 + cl] * LP1 + C_KA + 8 * q;
#pragma unroll
      for (int s = 0; s < 4; ++s) kc[u][s] = *(const h8*)(kr + 32 * s); }
#pragma unroll
    for (int gg = 0; gg < NG; ++gg) {
      if (gg < ng) {
        if (gg + 1 < NG) {
          const int g2 = (gg + 1 < ng) ? gg + 1 : gg;
#pragma unroll
          for (int u = 0; u < 4; ++u) { const hf* kr = kvb + (size_t)sel[g2 * 64 + u * 16 + cl] * LP1 + C_KA + 8 * q;
#pragma unroll
            for (int s = 0; s < 4; ++s) kn[u][s] = *(const h8*)(kr + 32 * s); }
        }
#pragma unroll
        for (int u = 0; u < 4; ++u) {
          f4 acc = f4{0, 0, 0, 0};
#pragma unroll
          for (int s = 0; s < 4; ++s) acc = mfma16(kc[u][s], qb[s], acc);
#pragma unroll
          for (int r = 0; r < 4; ++r) if (gg * 64 + u * 16 + 4 * q + r >= cnt) acc[r] = -INFINITY;
          S[gg * 4 + u] = acc;
        }
        if (gg + 1 < NG) {
#pragma unroll
          for (int u = 0; u < 4; ++u)
#pragma unroll
            for (int s = 0; s < 4; ++s) kc[u][s] = kn[u][s];
        }
      } else {
#pragma unroll
        for (int u = 0; u < 4; ++u) S[gg * 4 + u] = f4{-INFINITY, -INFINITY, -INFINITY, -INFINITY};
      }
    }
    float mx = -INFINITY;
#pragma unroll
    for (int j = 0; j < NG * 4; ++j)
#pragma unroll
      for (int r = 0; r < 4; ++r) mx = fmaxf(mx, S[j][r]);
    mx = fmaxf(mx, __shfl_xor(mx, 16)); mx = fmaxf(mx, __shfl_xor(mx, 32));
    float sm = 0.f;
#pragma unroll
    for (int j = 0; j < NG * 4; ++j)
#pragma unroll
      for (int r = 0; r < 4; ++r) { const float e = __expf(S[j][r] - mx); S[j][r] = e; sm += e; }
    sm += __shfl_xor(sm, 16); sm += __shfl_xor(sm, 32);
    const float inv = 1.0f / sm;
    if (cl < 8) {
#pragma unroll
      for (int j = 0; j < NG * 4; ++j) if (j < ng * 4) {
        h4 pv; pv[0] = (hf)(S[j][0] * inv); pv[1] = (hf)(S[j][1] * inv); pv[2] = (hf)(S[j][2] * inv); pv[3] = (hf)(S[j][3] * inv);
        *(h4*)(P16 + cl * SELN + j * 16 + 4 * q) = pv;
      }
    }
  }
  wave_sync();
  {
    f4 O[2][4];
#pragma unroll
    for (int g = 0; g < 2; ++g)
#pragma unroll
      for (int nt = 0; nt < 4; ++nt) O[g][nt] = f4{0, 0, 0, 0};
    const int nst = ng * 2;
    for (int st = 0; st < nst; ++st) {
      {
        const int st2 = (st + 1 < nst) ? st + 1 : st;
#pragma unroll
        for (int j = 0; j < 4; ++j) { const hf* vr = kvb + (size_t)sel[st2 * 32 + j * 8 + k8] * LP1 + C_VA + dch * 8; vn[j] = *(const h8*)vr; vn[4 + j] = *(const h8*)(vr + 64); }
      }
      wave_sync();
#pragma unroll
      for (int j = 0; j < 4; ++j) { *(h8*)(Vt + (j * 8 + k8) * 72 + dch * 8) = vc[j]; *(h8*)(Vt1 + (j * 8 + k8) * 72 + dch * 8) = vc[4 + j]; }
      wave_sync();
#pragma unroll
      for (int g = 0; g < 2; ++g) {
        h8 pa;
        if (cl < 4) pa = *(const h8*)(P16 + (g * 4 + cl) * SELN + st * 32 + q * 8); else pa = h8{0, 0, 0, 0, 0, 0, 0, 0};
        const hf* vt = g ? Vt1 : Vt;
#pragma unroll
        for (int nt = 0; nt < 4; ++nt) {
          const hf* tp = vt + (q * 8 + (cl >> 2)) * 72 + nt * 16 + (cl & 3) * 4;
          const h4 lo = lds_read_tr16(tp), hi = lds_read_tr16(tp + 4 * 72);
          O[g][nt] = mfma16(pa, cat44(lo, hi), O[g][nt]);
        }
      }
#pragma unroll
      for (int j = 0; j < 8; ++j) vc[j] = vn[j];
    }
    if (q == 0) {
#pragma unroll
      for (int g = 0; g < 2; ++g)
#pragma unroll
        for (int nt = 0; nt < 4; ++nt)
#pragma unroll
          for (int r = 0; r < 4; ++r) {
            hf* dst = dry ? ((hf*)srow + (g * 4 + r) * 64 + nt * 16 + cl) : (P1 + trow * LP1 + C_QA + (g * 4 + r) * 64 + nt * 16 + cl);
            *dst = (hf)O[g][nt][r];
          }
    }
  }
  wave_sync();
}

DI void phase_E2(const Params& p, char* smem, bool dry) {
  const hf* P1 = (const hf*)(p.ws + O_P1); const float* aux = (const float*)(p.ws + O_AUX);
  int* cnt = (int*)(p.ws + O_CNT) + (dry ? 1 : 0);
  const int tid = get_tid(), lane = tid & 63, wave = tid >> 6;
  float* scr = (float*)(p.ws + O_SCR) + (size_t)blockIdx.x * QBT * SEQ;
  int* item_s = (int*)smem;
  char* wl = smem + 16 + wave * E2_WAVE_LDS;
  int* sel = (int*)wl; float* Sb = (float*)(wl + SELN * 4);
  constexpr int NQB = SEQ / QBT;
#ifdef EMU
  const int xq = (int)blockIdx.x % BATCH;
#else
  const int xq = (int)(xcd_words(smem)[2] % (unsigned)BATCH);
#endif
  int dq = 0;
  for (;;) {
    __syncthreads();
    const int bq = (xq + dq) % BATCH;
    if (tid == 0) item_s[0] = atomicAdd(cnt + 2 * bq, 1);
    __syncthreads();
    const int item = item_s[0];
    if (item >= NQB) { if (++dq >= BATCH) break; continue; }
    const int b = bq, qb = NQB - 1 - item;
    int lane_i = lane;
#ifndef EMU
    asm volatile("" : "+v"(lane_i));
#endif
    const int q = lane_i >> 4, cl = lane_i & 15;
    const int tw0 = qb * QBT + wave * 4;
    h8 aq[4][2]; h8 wA01, wA23;
    {
      f4 wv[4];
#pragma unroll
      for (int i = 0; i < 4; ++i) {
        const size_t row = (size_t)b * SEQ + tw0 + i;
        const hf* qp = P1 + row * LP1 + C_QI + cl * 64 + q * 8;
        aq[i][0] = *(const h8*)qp; aq[i][1] = *(const h8*)(qp + 32);
        wv[i] = *(const f4*)(aux + row * 32 + q * 4);
      }
      const f4 z4 = f4{0, 0, 0, 0};
      wA01 = cvt_f4f4(cl == 0 ? wv[0] : z4, cl == 4 ? wv[1] : z4);
      wA23 = cvt_f4f4(cl == 8 ? wv[2] : z4, cl == 12 ? wv[3] : z4);
    }
    const int ngrp = (tw0 + 3) / 64 + 1;
    const int ngrp_blk = (qb * QBT + QBT - 1) / 64 + 1;
    hf* kst = (hf*)(smem + 16 + 4 * E2_WAVE_LDS);
    const int tid_s = get_tid();
    const int skey = tid_s >> 3, sch = tid_s & 7;
    const hf* ksrc = P1 + ((size_t)b * SEQ + skey) * LP1 + C_KI + sch * 8;
    hf* scr_q = (hf*)(scr + (size_t)(wave * 4 + q) * SEQ) + cl;
    h8 sr0 = *(const h8*)ksrc, sr1 = *(const h8*)(ksrc + (size_t)32 * LP1);
    *(h8*)(kst + skey * 72 + sch * 8) = sr0; *(h8*)(kst + (skey + 32) * 72 + sch * 8) = sr1;
    { const int g1 = ngrp_blk > 1 ? 1 : 0; sr0 = *(const h8*)(ksrc + (size_t)(g1 * 64) * LP1); sr1 = *(const h8*)(ksrc + (size_t)(g1 * 64 + 32) * LP1); }
    h8 sq0, sq1;
    { const int g2 = ngrp_blk > 2 ? 2 : ngrp_blk - 1; sq0 = *(const h8*)(ksrc + (size_t)(g2 * 64) * LP1); sq1 = *(const h8*)(ksrc + (size_t)(g2 * 64 + 32) * LP1); }
    __syncthreads();
    for (int grp = 0; grp < ngrp_blk; ++grp) {
      const hf* ks = kst + (grp & 1) * (64 * 72);
      if (grp < ngrp) {
#pragma unroll
        for (int u = 0; u < 4; ++u) {
          const h8 b0 = *(const h8*)(ks + (u * 16 + cl) * 72 + q * 8), b1 = *(const h8*)(ks + (u * 16 + cl) * 72 + 32 + q * 8);
          f4 c4[4];
#pragma unroll
          for (int i = 0; i < 4; ++i) { f4 t4 = f4{0, 0, 0, 0}; t4 = mfma16(aq[i][0], b0, t4); t4 = mfma16(aq[i][1], b1, t4); c4[i] = t4; }
          f4 sc = f4{0, 0, 0, 0}; sc = mfma16(wA01, relu8(cvt_f4f4(c4[0], c4[1])), sc); sc = mfma16(wA23, relu8(cvt_f4f4(c4[2], c4[3])), sc);
          scr_q[grp * 64 + u * 16] = (hf)sc[0];
        }
      }
      if (grp + 1 < ngrp_blk) {
        hf* kn = kst + ((grp + 1) & 1) * (64 * 72);
        *(h8*)(kn + skey * 72 + sch * 8) = sr0; *(h8*)(kn + (skey + 32) * 72 + sch * 8) = sr1;
        sr0 = sq0; sr1 = sq1;
        const int g3 = (grp + 3 < ngrp_blk) ? grp + 3 : ngrp_blk - 1;
        sq0 = *(const h8*)(ksrc + (size_t)(g3 * 64) * LP1); sq1 = *(const h8*)(ksrc + (size_t)(g3 * 64 + 32) * LP1);
      }
      __syncthreads();
    }
    gmem_wave_sync();
#pragma unroll 1
    for (int i = 0; i < 4; ++i) attn_token(p, b, tw0 + i, scr + (size_t)(wave * 4 + i) * SEQ, sel, Sb, kst + wave * (32 * 72), lane, dry);
  }
  if (!dry) {
    unsigned* e1done = (unsigned*)(p.ws + O_CNT) + 48;
    if (get_tid() == 0) {
      unsigned spins = 0;
      while (ld_relaxed_agent(e1done) < (unsigned)(BATCH * 8)) { spin_pause(); if (++spins > (1u << 26)) break; }
      fence_acquire_agent();
    }
    __syncthreads();
    obnorm_pass(p);
  }
}

DI void phase_F1(const Params& p, char* smem) {
  const hf* P1 = (const hf*)(p.ws + O_P1); const hf* ob = (const hf*)(p.ws + O_OB); const hf* P4 = (const hf*)(p.ws + O_P4);
  const hf* WpaT = (const hf*)(p.ws + O_WPA); const hf* WpbT = (const hf*)(p.ws + O_WPB);
  hf* merged = (hf*)(p.ws + O_MERGED);
  const int lane = get_tid() & 63, wave = get_tid() >> 6, wm = wave >> 1, wn = wave & 1, q = lane >> 4, cl = lane & 15;
  constexpr int NTN = DM / 128, NTM = NTOK / 128;
  TileSched ts = tile_begin(NTM, NTN, p.ws + O_BAR, xcd_words(smem)); int tm, tn;
  while (tile_next(ts, tm, tn)) {
    const int m0 = tm * 128, n0 = tn * 128;
    f4 a1[4][4], a2[4][4]; zero_acc<4>(a1); zero_acc<4>(a2);
    gemm_mainloop<128, 64>(a1, P1 + C_QA, LP1, WpaT, 512, 512, m0, n0, smem);
    gemm_mainloop<128, 64>(a2, ob, 512, WpbT, 512, 512, m0, n0, smem);
    hf* t1 = (hf*)smem; hf* t2 = t1 + 128 * TLD;
    __syncthreads();
#pragma unroll
    for (int mt = 0; mt < 4; ++mt)
#pragma unroll
      for (int nt = 0; nt < 4; ++nt)
#pragma unroll
        for (int r = 0; r < 4; ++r) {
          const int lrow = wm * 64 + mt * 16 + q * 4 + r, lcol = wn * 64 + nt * 16 + cl;
          t1[lrow * TLD + lcol] = (hf)a1[mt][nt][r]; t2[lrow * TLD + lcol] = (hf)a2[mt][nt][r];
        }
    __syncthreads();
    {
      const int tid = get_tid();
#pragma unroll
      for (int i = 0; i < 8; ++i) {
        const int idx = tid + i * 256, row = idx >> 4, ch = idx & 15;
        const size_t grow = (size_t)(m0 + row);
        const h8 v1 = *(const h8*)(t1 + row * TLD + ch * 8), v2 = *(const h8*)(t2 + row * TLD + ch * 8);
        const h8 sa = *(const h8*)(P4 + grow * LP4 + n0 + ch * 8), sb = *(const h8*)(P4 + grow * LP4 + DM + n0 + ch * 8);
        h8 o;
#pragma unroll
        for (int e = 0; e < 8; ++e) o[e] = (hf)((float)sa[e] * (float)v1[e] + (float)sb[e] * (float)v2[e]);
        *(h8*)(merged + pr32_off((int)grow, n0 + ch * 8, DM)) = o;
      }
    }
  }
}
DI void phase_F2(const Params& p, char* smem) {
  const hf* merged = (const hf*)(p.ws + O_MERGED); const hf* WoT = (const hf*)(p.ws + O_WO); const float* mod = (const float*)(p.ws + O_MOD);
  const int lane = get_tid() & 63, wave = get_tid() >> 6, wm = wave >> 1, wn = wave & 1, q = lane >> 4, cl = lane & 15;
  constexpr int CBM = 256, CMT = CBM / 32, NTN = DM / 128, NTM = NTOK / CBM;
  TileSched ts = tile_begin(NTM, NTN, p.ws + O_BAR, xcd_words(smem)); int tm, tn;
  while (tile_next(ts, tm, tn)) {
    const int m0 = tm * CBM, n0 = tn * 128;
    f4 acc[CMT][4]; zero_acc<CMT>(acc);
    gemm_mainloop<CBM, 32, true>(acc, merged, DM, WoT, DM, DM, m0, n0, smem);
    hf* t1 = (hf*)smem;
    __syncthreads();
#pragma unroll
    for (int mt = 0; mt < CMT; ++mt)
#pragma unroll
      for (int nt = 0; nt < 4; ++nt)
#pragma unroll
        for (int r = 0; r < 4; ++r) t1[(wm * (CBM / 2) + mt * 16 + q * 4 + r) * TLD + wn * 64 + nt * 16 + cl] = (hf)acc[mt][nt][r];
    __syncthreads();
    {
      const int tid = get_tid();
#pragma unroll
      for (int i = 0; i < CBM / 16; ++i) {
        const int idx = tid + i * 256, row = idx >> 4, ch = idx & 15;
        const size_t grow = (size_t)(m0 + row); const int b = (int)(grow / SEQ), col = n0 + ch * 8;
        const h8 y = *(const h8*)(t1 + row * TLD + ch * 8);
        const float* xp = p.x + grow * DM + col; const float* gp = mod + (size_t)b * 6 * DM + 2 * DM + col; hf* op = (hf*)(p.ws + O_H16) + grow * DM + col;
        const f4 x0 = *(const f4*)xp, x1 = *(const f4*)(xp + 4), g0 = *(const f4*)gp, g1 = *(const f4*)(gp + 4);
        h8 o;
#pragma unroll
        for (int e = 0; e < 4; ++e) { o[e] = (hf)(x0[e] + g0[e] * (float)y[e]); o[4 + e] = (hf)(x1[e] + g1[e] * (float)y[4 + e]); }
        *(h8*)op = o;
      }
    }
  }
}
DI float quant_row_store(const float (&v)[DM / 64], unsigned char* dst, int lane, int bias) {
  float mx = 0.f;
#pragma unroll
  for (int i = 0; i < DM / 64; ++i) mx = fmaxf(mx, fabsf(v[i]));
#pragma unroll
  for (int m = 32; m >= 1; m >>= 1) mx = fmaxf(mx, __shfl_xor(mx, m));
  const float sc = mx > 0.f ? mx * (1.0f / 127.0f) : 1.0f, inv = 1.0f / sc;
#pragma unroll
  for (int i = 0; i < DM / 256; ++i) {
    unsigned w = 0;
#pragma unroll
    for (int j = 0; j < 4; ++j) { int qv = (int)rintf(v[4 * i + j] * inv); qv = qv > 127 ? 127 : (qv < -127 ? -127 : qv); w |= ((unsigned)(qv + bias) & 255u) << (8 * j); }
    *(unsigned*)(dst + i * 256 + lane * 4) = w;
  }
  return sc;
}
template <int MODE> DI void quant4_row_store(const float (&v)[DM / 64], unsigned char* dst, int lane, float& sc_o, float& mn_o) {
  float mx = v[0], mn = v[0];
#pragma unroll
  for (int i = 1; i < DM / 64; ++i) { mx = fmaxf(mx, v[i]); mn = fminf(mn, v[i]); }
#pragma unroll
  for (int m = 32; m >= 1; m >>= 1) { mx = fmaxf(mx, __shfl_xor(mx, m)); mn = fminf(mn, __shfl_xor(mn, m)); }
  {
    float s1 = 0.f, s2 = 0.f;
#pragma unroll
    for (int i = 0; i < DM / 64; ++i) { s1 += v[i]; s2 += v[i] * v[i]; }
    s1 = wave_sum(s1); s2 = wave_sum(s2);
    const float mean = s1 * (1.0f / DM), sd = sqrtf(fmaxf(s2 * (1.0f / DM) - mean * mean, 0.f));
    mn = fmaxf(mn, mean - 2.514f * sd); mx = fminf(mx, mean + 2.514f * sd);
  }
  const float sc = mx > mn ? (mx - mn) * (1.0f / 15.0f) : 1.0f, inv = 1.0f / sc;
#pragma unroll
  for (int i = 0; i < DM / 256; ++i) {
    unsigned nq = 0;
#pragma unroll
    for (int j = 0; j < 4; ++j) { int qv = (int)rintf((v[4 * i + j] - mn) * inv); qv = qv > 15 ? 15 : (qv < 0 ? 0 : qv);
      if (MODE == 0) nq |= (unsigned)qv << (8 * j);
      else { const int t = 4 * (lane & 1) + j; nq |= (unsigned)qv << (4 * ((t & 1) * 4 + (t >> 1))); } }
    const unsigned pn = __shfl_xor(nq, 1);
    if ((lane & 1) == 0) *(unsigned*)(dst + (i * 32 + (lane >> 1)) * 4) = (MODE == 0) ? (nq | (pn << 4)) : (nq | pn);
  }
  sc_o = sc; mn_o = mn;
}
DI void phase_F3(const Params& p) {
  const int tid = get_tid(), lane = tid & 63, wave = tid >> 6;
  const float* mod = (const float*)(p.ws + O_MOD);
  unsigned char* u8 = (unsigned char*)(p.uv + UV_U8); unsigned char* v8 = (unsigned char*)(p.uv + UV_V8); unsigned char* n2q = (unsigned char*)(p.uv + UV_N2Q);
  float* su = (float*)(p.uv + UV_SU); float* sv = (float*)(p.uv + UV_SV); float* sn = (float*)(p.uv + UV_SN);
  for (int row = blockIdx.x * 4 + wave; row < NTOK + 2 * NEXP; row += gridDim.x * 4) {
    float v[DM / 64];
    if (row < NTOK) {
      const hf* xr = (const hf*)(p.ws + O_H16) + (size_t)row * DM; const int b = row / SEQ; float ss = 0.f;
#pragma unroll
      for (int i = 0; i < DM / 256; ++i) { const h4 t4 = *(const h4*)(xr + i * 256 + lane * 4); f4 t = {(float)t4[0], (float)t4[1], (float)t4[2], (float)t4[3]}; v[4 * i] = t[0]; v[4 * i + 1] = t[1]; v[4 * i + 2] = t[2]; v[4 * i + 3] = t[3]; ss += t[0] * t[0] + t[1] * t[1] + t[2] * t[2] + t[3] * t[3]; }
      ss = wave_sum(ss);
      const float rstd = rsqrtf(ss * (1.0f / DM) + EPSN);
      const float* mb = mod + (size_t)b * 6 * DM;
#pragma unroll
      for (int i = 0; i < DM / 256; ++i) {
        const int d = i * 256 + lane * 4;
#pragma unroll
        for (int j = 0; j < 4; ++j) v[4 * i + j] = v[4 * i + j] * rstd * (1.0f + mb[4 * DM + d + j]) + mb[3 * DM + d + j];
      }
      const float sc = quant_row_store(v, n2q + (size_t)row * DM, lane, 0);
      if (lane == 0) sn[row] = sc;
    } else {
      const bool isu = row < NTOK + NEXP; const int e = isu ? row - NTOK : row - NTOK - NEXP;
      const float* xr = (isu ? p.pu : p.pv) + (size_t)e * DM;
#pragma unroll
      for (int i = 0; i < DM / 256; ++i) { f4 t = *(const f4*)(xr + i * 256 + lane * 4); v[4 * i] = t[0]; v[4 * i + 1] = t[1]; v[4 * i + 2] = t[2]; v[4 * i + 3] = t[3]; }
      float sc, mn;
      if (isu) { quant4_row_store<0>(v, u8 + (size_t)e * (DM / 2), lane, sc, mn); if (lane == 0) { su[2 * e] = sc; su[2 * e + 1] = mn; } }
      else { quant4_row_store<1>(v, v8 + (size_t)e * (DM / 2), lane, sc, mn); if (lane == 0) { sv[2 * e] = sc; sv[2 * e + 1] = mn; } }
    }
  }
}
DI void cmpx_desc(unsigned& hi, unsigned& lo) { const unsigned x = hi, y = lo; hi = x > y ? x : y; lo = x > y ? y : x; }
DI void bitonic_merge16(unsigned (&v)[16]) {
#pragma unroll
  for (int j = 8; j > 0; j >>= 1)
#pragma unroll
    for (int i = 0; i < 16; ++i) { const int l = i ^ j; if (l > i) cmpx_desc(v[i], v[l]); }
}
DI void bitonic_sort16(unsigned (&v)[16]) {
#pragma unroll
  for (int k = 2; k <= 16; k <<= 1)
#pragma unroll
    for (int j = k >> 1; j > 0; j >>= 1)
#pragma unroll
      for (int i = 0; i < 16; ++i) { const int l = i ^ j; if (l > i) { if ((i & k) == 0) cmpx_desc(v[i], v[l]); else cmpx_desc(v[l], v[i]); } }
}
DI void phase_G1(const Params& p, char* smem) {
  const hf* subk = (const hf*)(p.ws + O_SUBK);
  int* experts = (int*)(p.ws + O_P4); float* gates = (float*)(p.ws + O_P4 + (size_t)NTOK * 128 * 4);
  const float* sn_ = (const float*)(p.uv + UV_SN); const float* sq8 = (const float*)(p.ws + O_SQ8);
  const int tid = get_tid(), lane = tid & 63, wave = tid >> 6, wm = wave >> 1, wn = wave & 1, q = lane >> 4, cl = lane & 15;
  constexpr int NTM = NTOK / 128;
  hf* qt = (hf*)smem;
  float* sb = (float*)smem;
  unsigned* tl = (unsigned*)(smem + 2 * 64 * 129 * 4);
  TileSched ts = tile_begin(NTM, 8, p.ws + O_BAR, xcd_words(smem)); int tm, tn;
  while (tile_next(ts, tm, tn)) {
    const int hh = tn, mbase = tm * 128, n0 = hh * 128;
    f4 acc[4][4]; zero_acc<4>(acc);
    gemm_mainloop_r3<128, true>(acc, (const hf*)(p.uv + UV_N2Q), DM / 2, (const hf*)(p.ws + O_WQ8), DM / 2, DM / 2, mbase, n0, smem);
    for (int half = 0; half < 2; ++half) {
    const int m0 = mbase + half * 64;
    __syncthreads();
    if (wm == half) {
#pragma unroll
      for (int mt = 0; mt < 4; ++mt)
#pragma unroll
        for (int nt = 0; nt < 4; ++nt)
#pragma unroll
          for (int r = 0; r < 4; ++r) { const int row = mt * 16 + q * 4 + r, col = wn * 64 + nt * 16 + cl; const i4 ai = __builtin_bit_cast(i4, acc[mt][nt]);
            qt[row * 136 + col] = (hf)((float)ai[r] * (sn_[m0 + row] * sq8[n0 + col])); }
    }
    __syncthreads();
    const int pp = wave & 1, mh = wave >> 1;
    h8 af[2][2];
#pragma unroll
    for (int mt = 0; mt < 2; ++mt)
#pragma unroll
      for (int ks = 0; ks < 2; ++ks) af[mt][ks] = *(const h8*)(qt + (mh * 32 + mt * 16 + cl) * 136 + pp * 64 + ks * 32 + q * 8);
    __syncthreads();
    const hf* skp = subk + (size_t)(hh * 2 + pp) * 128 * 64;
#pragma unroll
    for (int nt = 0; nt < 8; ++nt) {
      h8 b0 = *(const h8*)(skp + (nt * 16 + cl) * 64 + q * 8), b1 = *(const h8*)(skp + (nt * 16 + cl) * 64 + 32 + q * 8);
#pragma unroll
      for (int mt = 0; mt < 2; ++mt) {
        f4 s = f4{0, 0, 0, 0};
        s = mfma16(af[mt][0], b0, s); s = mfma16(af[mt][1], b1, s);
#pragma unroll
        for (int r = 0; r < 4; ++r) sb[(pp * 64 + mh * 32 + mt * 16 + q * 4 + r) * 129 + nt * 16 + cl] = s[r];
      }
    }
    __syncthreads();
    {
      const int rp = tid >> 1, sub = tid & 1;
      const float* sr = sb + rp * 129 + sub * 64;
      unsigned top[16];
#pragma unroll
      for (int g = 0; g < 4; ++g) {
        unsigned v[16];
#pragma unroll
        for (int i = 0; i < 16; ++i) { const int n = sub * 64 + g * 16 + i; v[i] = (f2ord(sr[g * 16 + i]) & ~127u) | (unsigned)(127 - n); }
        bitonic_sort16(v);
        if (g == 0) {
#pragma unroll
          for (int i = 0; i < 16; ++i) top[i] = v[i];
        } else {
#pragma unroll
          for (int i = 0; i < 16; ++i) top[i] = top[i] > v[15 - i] ? top[i] : v[15 - i];
          bitonic_merge16(top);
        }
      }
      unsigned oth[16];
#pragma unroll
      for (int i = 0; i < 16; ++i) oth[i] = __shfl_xor(top[i], 1);
#pragma unroll
      for (int i = 0; i < 16; ++i) top[i] = top[i] > oth[15 - i] ? top[i] : oth[15 - i];
      bitonic_merge16(top);
      if (sub == 0) {
#pragma unroll
        for (int i = 0; i < 16; ++i) tl[rp * 16 + i] = top[i];
      }
    }
    __syncthreads();
    {
      const int tid2 = get_tid();
      const int rp = tid2 >> 2, sub = tid2 & 3;
      constexpr unsigned long long PT0 = 0x7060504030201000ull;
      constexpr unsigned long long PT1 = 0xf0e0d0c0b0a09080ull;
      constexpr unsigned long long PT2 = 0x7161514131211101ull;
      constexpr unsigned long long PT3 = 0x2313034232221202ull;
      constexpr unsigned long long PT4 = 0x1606150524140433ull;
      constexpr unsigned long long PT5 = 0x0d0c0b0a09081707ull;
      constexpr unsigned long long PT6 = 0xffffffffffff0f0eull;
      constexpr unsigned long long PT7 = 0xffffffffffffffffull;
      const unsigned long long wlo = sub == 0 ? PT0 : sub == 1 ? PT2 : sub == 2 ? PT4 : PT6;
      const unsigned long long whi = sub == 0 ? PT1 : sub == 1 ? PT3 : sub == 2 ? PT5 : PT7;
      const unsigned* t1 = tl + rp * 16; const unsigned* t2 = tl + (64 + rp) * 16;
      unsigned top[16];
#pragma unroll
      for (int s = 0; s < 16; ++s) {
        const unsigned e = (unsigned)(((s < 8 ? wlo : whi) >> (8 * (s & 7))) & 255ull);
        const int i = e & 15, j = (e >> 4) & 15;
        const float v = ord2f(t1[i] & ~127u) + ord2f(t2[j] & ~127u);
        top[s] = (e == 255u) ? 0u : ((f2ord(v) & ~255u) | (unsigned)(255 - (i * 16 + j)));
      }
      bitonic_sort16(top);
#pragma unroll
      for (int x = 1; x <= 2; x <<= 1) {
        unsigned oth[16];
#pragma unroll
        for (int i = 0; i < 16; ++i) oth[i] = __shfl_xor(top[i], x);
#pragma unroll
        for (int i = 0; i < 16; ++i) top[i] = top[i] > oth[15 - i] ? top[i] : oth[15 - i];
        bitonic_merge16(top);
      }
      float vals[16], sm = 0.f;
#pragma unroll
      for (int s = 0; s < 16; ++s) vals[s] = ord2f(top[s] & ~255u);
      const float mx = vals[0];
#pragma unroll
      for (int s = 0; s < 16; ++s) { vals[s] = __expf(vals[s] - mx); sm += vals[s]; }
      const float inv = 1.0f / sm;
      i4 eo; f4 go;
#pragma unroll
      for (int t = 0; t < 4; ++t) {
        const unsigned k = sub == 0 ? top[t] : sub == 1 ? top[4 + t] : sub == 2 ? top[8 + t] : top[12 + t];
        const float g = sub == 0 ? vals[t] : sub == 1 ? vals[4 + t] : sub == 2 ? vals[8 + t] : vals[12 + t];
        const int ci = 255 - (int)(k & 255u);
        const int e1 = 127 - (int)(t1[ci >> 4] & 127u), e2 = 127 - (int)(t2[ci & 15] & 127u);
        eo[t] = e1 * 128 + e2; go[t] = g * inv;
      }
      const size_t ob_ = ((size_t)(m0 + rp) * 8 + hh) * 16 + sub * 4;
      *(i4*)(experts + ob_) = eo; *(f4*)(gates + ob_) = go;
    }
  }
  }
}
#ifdef EMU
DI h2 pkfma(h2 a, h2 b, h2 c) { return a * b + c; }
#else
DI h2 pkfma(h2 a, h2 b, h2 c) { return __builtin_elementwise_fma(a, b, c); }
#endif
constexpr int VPL = DM / 64;
constexpr int G2_WAVE_LDS = 128 * 8 + 128 * 4;
DI void phase_G2(const Params& p, char* smem, bool dry) {
  const unsigned char* u8 = (const unsigned char*)(p.uv + UV_U8); const unsigned char* v8 = (const unsigned char*)(p.uv + UV_V8); const unsigned char* n2q = (const unsigned char*)(p.uv + UV_N2Q);
  const float* su = (const float*)(p.uv + UV_SU); const float* sv = (const float*)(p.uv + UV_SV); const float* sn = (const float*)(p.uv + UV_SN);
  const int* experts = (const int*)(p.ws + O_P4); const float* gates = (const float*)(p.ws + O_P4 + (size_t)NTOK * 128 * 4);
  const float* mod = (const float*)(p.ws + O_MOD);
  const int tid = get_tid(), lane = tid & 63, wave = tid >> 6, half = lane >> 5, li = lane & 31;
  char* wl = smem + wave * G2_WAVE_LDS;
  unsigned* coef2 = (unsigned*)wl; int* eix = (int*)(wl + 1024);
  constexpr int DW = VPL / 4;
  const int tok0 = blockIdx.x * 4 + wave;
  int e0n = 0, e1n = 0; float sntn = 0.f; int xqn[2 * DW];
  { const int tc = tok0 < NTOK ? tok0 : NTOK - 1;
    e0n = experts[(size_t)tc * 128 + lane]; e1n = experts[(size_t)tc * 128 + 64 + lane]; sntn = sn[tc];
#pragma unroll
    for (int w = 0; w < 2 * DW; ++w) xqn[w] = ((const int*)(n2q + (size_t)tc * DM + li * (8 * DW)))[w]; }
  for (int tok = tok0; tok < NTOK; tok += gridDim.x * 4) {
    const int b = tok / SEQ;
    wave_sync();
    eix[lane] = e0n; eix[64 + lane] = e1n;
    const float snt = sntn;
    int xq[2 * DW];
#pragma unroll
    for (int w = 0; w < 2 * DW; ++w) xq[w] = xqn[w];
    int sxq = 0;
#pragma unroll
    for (int w = 0; w < 2 * DW; ++w) sxq = __builtin_amdgcn_sdot4(xq[w], 0x01010101, sxq, false);
#pragma unroll
    for (int m = 16; m >= 1; m >>= 1) sxq += __shfl_xor(sxq, m);
    const float fsx = (float)sxq;
    wave_sync();
    float cmn = 0.f;
    for (int eb = 0; eb < 2; ++eb) {
      int part[32];
      const int em = eb * 64 + lane; const int eim = eix[em];
      const float su_e = su[2 * eim], mu_e = su[2 * eim + 1], sv_e = sv[2 * eim], mv_e = sv[2 * eim + 1], g_e = gates[(size_t)tok * 128 + em];
#pragma unroll
      for (int e = 0; e < 32; ++e) {
        const unsigned* ur = (const unsigned*)(u8 + (size_t)eix[eb * 64 + half * 32 + e] * (DM / 2) + li * (4 * DW));
        int acc = 0;
#pragma unroll
        for (int k = 0; k < DW; ++k) { const unsigned w = ur[k];
          acc = __builtin_amdgcn_sdot4((int)(w & 0x0F0F0F0Fu), xq[2 * k], acc, false);
          acc = __builtin_amdgcn_sdot4((int)((w >> 4) & 0x0F0F0F0Fu), xq[2 * k + 1], acc, false); }
        part[e] = acc;
      }
      const bool b4 = (lane & 16) != 0, b3 = (lane & 8) != 0, b2 = (lane & 4) != 0, b1 = (lane & 2) != 0, b0 = (lane & 1) != 0;
      int r16[16], r8[8], r4[4], r2[2];
#pragma unroll
      for (int i = 0; i < 16; ++i) { const int snd = b4 ? part[i] : part[16 + i], kp = b4 ? part[16 + i] : part[i]; r16[i] = kp + __shfl_xor(snd, 16); }
#pragma unroll
      for (int i = 0; i < 8; ++i) { const int snd = b3 ? r16[i] : r16[8 + i], kp = b3 ? r16[8 + i] : r16[i]; r8[i] = kp + __shfl_xor(snd, 8); }
#pragma unroll
      for (int i = 0; i < 4; ++i) { const int snd = b2 ? r8[i] : r8[4 + i], kp = b2 ? r8[4 + i] : r8[i]; r4[i] = kp + __shfl_xor(snd, 4); }
#pragma unroll
      for (int i = 0; i < 2; ++i) { const int snd = b1 ? r4[i] : r4[2 + i], kp = b1 ? r4[2 + i] : r4[i]; r2[i] = kp + __shfl_xor(snd, 2); }
      const int r1 = (b0 ? r2[1] : r2[0]) + __shfl_xor(b0 ? r2[0] : r2[1], 1);
      { const float av = ((float)r1 * su_e + fsx * mu_e) * snt;
        const float cr = 0.5f * av * (1.0f + erff(av * 0.70710678118654752f)) * g_e, cs = cr * sv_e;
        cmn += cr * mv_e;
        const hf ca = (hf)(cs * 16384.0f), cb = (hf)(cs * 1024.0f);
        h2 pa = {ca, ca}, pb = {cb, cb};
        coef2[2 * em] = __builtin_bit_cast(unsigned, pa); coef2[2 * em + 1] = __builtin_bit_cast(unsigned, pb); }
    }
    wave_sync();
    { const int tn = tok + gridDim.x * 4; const int tc = tn < NTOK ? tn : NTOK - 1;
      e0n = experts[(size_t)tc * 128 + lane]; e1n = experts[(size_t)tc * 128 + 64 + lane]; sntn = sn[tc];
#pragma unroll
      for (int w = 0; w < 2 * DW; ++w) xqn[w] = ((const int*)(n2q + (size_t)tc * DM + li * (8 * DW)))[w]; }
    const int dbase = li * (8 * DW) + half * (4 * DW);
    float hres[VPL], mg[VPL];
#pragma unroll
    for (int i = 0; i < VPL; ++i) { hres[i] = (float)((const hf*)(p.ws + O_H16))[(size_t)tok * DM + dbase + i]; mg[i] = mod[(size_t)b * 6 * DM + 5 * DM + dbase + i]; }
    cmn = wave_sum(cmn);
    h2 ya[4 * DW];
#pragma unroll
    for (int i = 0; i < 4 * DW; ++i) ya[i] = (h2){(hf)0.f, (hf)0.f};
#pragma unroll 8
    for (int e = 0; e < 64; ++e) {
      const int row = 2 * e + half;
      const unsigned* vr = (const unsigned*)(v8 + (size_t)eix[row] * (DM / 2) + li * (4 * DW));
      const h2 ca = __builtin_bit_cast(h2, coef2[2 * row]), cb = __builtin_bit_cast(h2, coef2[2 * row + 1]);
#pragma unroll
      for (int k = 0; k < DW; ++k) { const unsigned w = vr[k], w8 = w >> 8;
        ya[4 * k + 0] = pkfma(__builtin_bit_cast(h2, w & 0x000F000Fu), ca, ya[4 * k + 0]);
        ya[4 * k + 1] = pkfma(__builtin_bit_cast(h2, w & 0x00F000F0u), cb, ya[4 * k + 1]);
        ya[4 * k + 2] = pkfma(__builtin_bit_cast(h2, w8 & 0x000F000Fu), ca, ya[4 * k + 2]);
        ya[4 * k + 3] = pkfma(__builtin_bit_cast(h2, w8 & 0x00F000F0u), cb, ya[4 * k + 3]); }
    }
    float y[VPL];
#pragma unroll
    for (int i = 0; i < 2 * DW; ++i) {
      const unsigned snd = __builtin_bit_cast(unsigned, half ? ya[i] : ya[2 * DW + i]);
      const h2 oth = __builtin_bit_cast(h2, (unsigned)__shfl_xor((int)snd, 32));
      const h2 mine = half ? ya[2 * DW + i] : ya[i];
      y[2 * i] = ((float)mine[0] + (float)oth[0]) * 1024.0f + cmn; y[2 * i + 1] = ((float)mine[1] + (float)oth[1]) * 1024.0f + cmn;
    }
    float hv[VPL]; float ss = 0.f;
#pragma unroll
    for (int i = 0; i < VPL; ++i) { const float v = hres[i] + mg[i] * y[i]; hv[i] = v; ss += v * v; }
    ss = wave_sum(ss);
    const float rstd = rsqrtf(ss * (1.0f / DM) + EPSN);
#pragma unroll
    for (int i = 0; i < VPL; ++i) { const int d = dbase + i; const float o = hv[i] * rstd * p.fnw[d];
      if (dry) ((hf*)(p.ws + O_MERGED))[(size_t)tok * DM + d] = (hf)o; else p.out[(size_t)tok * DM + d] = o; }
  }
}

constexpr int cmax(int a, int b) { return a > b ? a : b; }
constexpr int LDS_GEMM = cmax(cmax((128 + 128) * (GBK_MAX + 8) * 2, 2 * 128 * TLD * 2), 256 * TLD * 2);
constexpr int LDS_A = cmax(64 * 65 * 4, (BATCH * DM + 4 * BATCH * 64) * 4);
constexpr int LDS_D1 = 2 * 64 * 72 * 2 + 64 * 128 * 4 + 64 * 64 * 4 + 512;
constexpr int LDS_E2 = 16 + 4 * E2_WAVE_LDS + 2 * 64 * 72 * 2;
constexpr int LDS_G1 = 2 * 64 * 129 * 4 + 2 * 64 * 16 * 4;
constexpr int LDS_G2 = 4 * G2_WAVE_LDS;
constexpr int SMEM_BYTES = cmax(cmax(cmax(LDS_GEMM, LDS_A), cmax(LDS_D1, LDS_E2)), cmax(cmax(LDS_G1, LDS_G2), LDS_E1));
constexpr int NPHASE = 11;
DI const volatile unsigned* xcd_words(char* smem) { return (const volatile unsigned*)(smem + SMEM_BYTES); }

DI void run_phase(const Params& p, int ph, char* smem, bool dry) {
  switch (ph) {
    case 0: phase_A(p, smem); break;
    case 1: phase_B(p); break;
    case 2: phase_C(p, smem); break;
    case 3: phase_D1(p, smem); break;
    case 4: if (!dry) phase_E1(p, smem); phase_E2(p, smem, dry); break;
    case 5: break;
    case 6: phase_F1(p, smem); break;
    case 7: phase_F2(p, smem); break;
    case 8: phase_F3(p); break;
    case 9: phase_G1(p, smem); break;
    case 10: phase_G2(p, smem, dry); break;
  }
}

#ifdef EMU
static void emu_kernel_all(void* arg) {
  const Params& p = *(const Params*)arg; char* smem = emu_cur->blk->smem;
  for (int ph = 0; ph < NPHASE; ++ph) { run_phase(p, ph, smem, false); emu_grid_sync(); }
}
#else
template <int PH> __global__ void __launch_bounds__(256, 2) phase_kernel(Params p) {
  __shared__ __attribute__((aligned(16))) char smem[SMEM_BYTES + 16];
  run_phase(p, PH, smem, false);
}
#if !MULTI_LAUNCH
#ifndef PROBE_DUP
#define PROBE_DUP 0
#endif
__global__ void __launch_bounds__(256, 2) mega_kernel(Params p) {
  __shared__ __attribute__((aligned(16))) char smem[SMEM_BYTES + 16];
  cooperative_groups::grid_group grid = cooperative_groups::this_grid();
  volatile LAS unsigned* st = (volatile LAS unsigned*)(smem + SMEM_BYTES);
  if (threadIdx.x == 0) { st[0] = 0u; st[1] = 0u; }
  __syncthreads();
  if (PROBE_DUP & 1) run_phase(p, 0, smem, false);
  run_phase(p, 0, smem, false);
  grid.sync();
  XcdBarrier xb = xcd_barrier_post((unsigned*)(p.ws + O_BAR), st);
#define XBAR() { xcd_barrier(xb); if (PROBE_BAR2) xcd_barrier(xb); }
#define PH(k) { if (PROBE_DUP & (1 << (k))) { run_phase(p, (k), smem, true); xcd_barrier(xb); } run_phase(p, (k), smem, false); }
  PH(1); XBAR(); PH(2); XBAR(); PH(3); XBAR(); PH(4); XBAR();
  PH(6); XBAR(); PH(7); XBAR(); PH(8); XBAR(); PH(9); XBAR(); PH(10);
#undef PH
}
#endif
#endif

extern "C" void kernel_launch(void* const* d_in, const int* in_sizes, int n_in, void* d_out, int out_size, void* d_ws, size_t ws_size, hipStream_t stream) {
  Params p{};
  p.x = (const float*)d_in[0]; p.c = (const float*)d_in[1]; p.pos = (const int*)d_in[2]; p.w_ada = (const float*)d_in[3]; p.b_ada = (const float*)d_in[4];
  p.w_in = (const float*)d_in[5]; p.conv_w = (const float*)d_in[6]; p.a_log = (const float*)d_in[7]; p.dt_bias = (const float*)d_in[8]; p.norm_b_w = (const float*)d_in[9];
  p.w_pa = (const float*)d_in[10]; p.w_pb = (const float*)d_in[11]; p.w_o = (const float*)d_in[12]; p.wq = (const float*)d_in[13]; p.subk = (const float*)d_in[14];
  p.pu = (const float*)d_in[15]; p.pv = (const float*)d_in[16]; p.fnw = (const float*)d_in[17];
  p.out = (float*)d_out; p.ws = (char*)d_ws;
#ifdef EMU
  const int grid = 4;
  p.dscan = p.ws + WS_TOTAL; p.uv = p.ws + WS_TOTAL + DSCAN_BYTES;
  if (WS_TOTAL + DSCAN_BYTES + UV_BYTES > ws_size) { fprintf(stderr, "ws too small\n"); exit(2); }
  if (O_SCR + (size_t)grid * QBT * SEQ * 4 > O_OB) { fprintf(stderr, "scratch overflow\n"); exit(2); }
  fprintf(stderr, "emu: SMEM_BYTES=%d WS_TOTAL=%zu\n", SMEM_BYTES, WS_TOTAL);
  emu_launch(emu_kernel_all, &p, grid, 256, SMEM_BYTES);
#else
  static_assert((size_t)NTOK * DM * 4 >= DSCAN_BYTES, "d_out too small for scan scratch");
  static_assert(UV_BYTES <= (size_t)NTOK * LP1 * 2, "P1 too small for expert tables");
  p.dscan = (char*)d_out; p.uv = p.ws + O_P1;
  static int grid = 0;
  if (!grid) {
    int dev = 0, cus = 0, per_cu = 0;
    hipGetDevice(&dev); hipDeviceGetAttribute(&cus, hipDeviceAttributeMultiprocessorCount, dev);
#if MULTI_LAUNCH
    hipOccupancyMaxActiveBlocksPerMultiprocessor(&per_cu, phase_kernel<5>, 256, 0);
#else
    hipOccupancyMaxActiveBlocksPerMultiprocessor(&per_cu, mega_kernel, 256, 0);
#endif
    if (per_cu > 2) per_cu = 2;
    if (per_cu < 1) per_cu = 1;
    grid = cus * per_cu;
    if (grid > 512) grid = 512;
  }
  if (WS_TOTAL > ws_size) { fprintf(stderr, "workspace too small: need %zu have %zu\n", WS_TOTAL, ws_size); return; }
#if MULTI_LAUNCH
  hipLaunchKernelGGL(phase_kernel<0>, dim3(grid), dim3(256), 0, stream, p);
  hipLaunchKernelGGL(phase_kernel<1>, dim3(grid), dim3(256), 0, stream, p);
  hipLaunchKernelGGL(phase_kernel<2>, dim3(grid), dim3(256), 0, stream, p);
  hipLaunchKernelGGL(phase_kernel<3>, dim3(grid), dim3(256), 0, stream, p);
  hipLaunchKernelGGL(phase_kernel<4>, dim3(grid), dim3(256), 0, stream, p);
  hipLaunchKernelGGL(phase_kernel<5>, dim3(grid), dim3(256), 0, stream, p);
  hipLaunchKernelGGL(phase_kernel<6>, dim3(grid), dim3(256), 0, stream, p);
  hipLaunchKernelGGL(phase_kernel<7>, dim3(grid), dim3(256), 0, stream, p);
  hipLaunchKernelGGL(phase_kernel<8>, dim3(grid), dim3(256), 0, stream, p);
  hipLaunchKernelGGL(phase_kernel<9>, dim3(grid), dim3(256), 0, stream, p);
  hipLaunchKernelGGL(phase_kernel<10>, dim3(grid), dim3(256), 0, stream, p);
#else
  void* args[] = {&p};
  hipError_t e = hipLaunchCooperativeKernel((void*)mega_kernel, dim3(grid), dim3(256), args, 0, stream);
  if (e != hipSuccess) fprintf(stderr, "cooperative launch failed: %s (grid %d)\n", hipGetErrorString(e), grid);
#endif
#endif
}
```

```cpp
#ifdef EMU
#include "hip_emu.h"
#else
#include <hip/hip_runtime.h>
#include <hip/hip_cooperative_groups.h>
#include <cstdio>
#include <cstdint>
#endif

#ifndef PROBE_BAR2
#define PROBE_BAR2 0
#endif
#ifndef REP_CEPI
#define REP_CEPI 1
#endif
#ifndef REP_CMAIN
#define REP_CMAIN 1
#endif
#ifndef REP_IDX
#define REP_IDX 1
#endif
#ifndef REP_SEL
#define REP_SEL 1
#endif
#ifndef REP_QK
#define REP_QK 1
#endif
#ifndef REP_PV
#define REP_PV 1
#endif
#ifndef MULTI_LAUNCH
#define MULTI_LAUNCH 0
#endif

#ifdef EMU
#ifndef EMU_B
#define EMU_B 2
#endif
#ifndef EMU_S
#define EMU_S 512
#endif
#ifndef EMU_D
#define EMU_D 256
#endif
constexpr int BATCH = EMU_B, SEQ = EMU_S, DM = EMU_D;
#else
constexpr int BATCH = 8, SEQ = 4096, DM = 1024;
#endif
constexpr int NTOK = BATCH * SEQ;
constexpr int TOPK = (SEQ / 4 < 256) ? SEQ / 4 : 256;
constexpr int NCHK = SEQ / 64;
constexpr int NEXP = 16384;
constexpr int C_QA = 0, C_KA = 512, C_VA = 640, C_QI = 768, C_KI = 1792, C_WI = 1856, C_BB = 1872, C_AB = 1880;
constexpr int C_QB = 1920, C_ZB = 3456, C_GA = 3968;
constexpr int NP = 3968 + 2 * DM;
constexpr int IN_W = 3936 + 2 * DM;
constexpr int LP1 = 1920, LP2 = 1536, LP3 = 512, LP4 = 2 * DM;
constexpr int QBT = 16;
constexpr float EPSN = 1e-6f;

typedef _Float16 hf;
typedef _Float16 h8 __attribute__((ext_vector_type(8)));
typedef _Float16 h4 __attribute__((ext_vector_type(4)));
typedef _Float16 h2 __attribute__((ext_vector_type(2)));
typedef float f4 __attribute__((ext_vector_type(4)));
typedef int i4 __attribute__((ext_vector_type(4)));
#define DI __device__ __forceinline__

constexpr size_t al256(size_t x) { return (x + 255) & ~size_t(255); }
constexpr size_t O_MOD = 0;
constexpr size_t O_CNT = O_MOD + al256((size_t)BATCH * 6 * DM * 4);
constexpr size_t O_BAR = O_CNT + 256;
constexpr size_t O_CS = O_BAR + 16384;
constexpr size_t O_AUX = O_CS + al256((size_t)NTOK * 16 * 4);
constexpr size_t O_WIN = O_AUX + al256((size_t)NTOK * 32 * 4);
constexpr size_t O_WPA = O_WIN + al256((size_t)NP * DM * 2);
constexpr size_t O_WPB = O_WPA + al256((size_t)DM * 512 * 2);
constexpr size_t O_WO = O_WPB + al256((size_t)DM * 512 * 2);
constexpr size_t O_WQ = O_WO + al256((size_t)DM * DM * 2);
constexpr size_t O_SUBK = O_WQ + al256((size_t)1024 * DM * 2);
constexpr size_t O_EG = O_SUBK + al256((size_t)8 * 2 * 128 * 64 * 2);
constexpr size_t O_P1 = O_EG + al256((size_t)BATCH * 8 * NCHK * 4);
constexpr size_t O_P3 = O_P1 + al256((size_t)NTOK * LP1 * 2);
constexpr size_t O_P4 = O_P3 + al256((size_t)NTOK * LP3 * 2);
constexpr size_t R_BYTES = ((size_t)NTOK * DM * 2 > (size_t)NTOK * 1024) ? (size_t)NTOK * DM * 2 : (size_t)NTOK * 1024;
constexpr size_t O_R = O_P4 + al256((size_t)NTOK * LP4 * 2);
constexpr size_t O_P2 = O_R + al256(R_BYTES);
constexpr size_t O_OB = O_P2 + al256((size_t)NTOK * LP2 * 2);
constexpr size_t O_W8 = O_OB + al256((size_t)NTOK * 512 * 2);
constexpr size_t O_SB8 = O_W8 + al256((size_t)NP * DM);
constexpr size_t O_WQ8 = O_SB8 + al256((size_t)NP * 4);
constexpr size_t O_SQ8 = O_WQ8 + al256((size_t)1024 * DM);
constexpr size_t WS_TOTAL = O_SQ8 + al256((size_t)1024 * 4);
constexpr size_t O_INTRA = O_R;
constexpr size_t O_SCR = O_R + (size_t)NTOK * 1024;
constexpr size_t O_MERGED = O_R;
constexpr size_t O_N2H = O_R + (size_t)NTOK * DM * 2;
constexpr size_t O_H16 = O_P2;
static_assert((size_t)NTOK * DM * 2 <= (size_t)NTOK * LP2 * 2, "P2 too small for h");
constexpr size_t DSCAN_BYTES = (size_t)NTOK * 4096;
constexpr size_t UV_U8 = 0, UV_V8 = (size_t)NEXP * DM, UV_N2Q = (size_t)2 * NEXP * DM, UV_SU = UV_N2Q + (size_t)NTOK * DM, UV_SV = UV_SU + (size_t)NEXP * 8, UV_SN = UV_SV + (size_t)NEXP * 8;
constexpr size_t UV_BYTES = UV_SN + (size_t)NTOK * 4;

struct Params {
  const float *x, *c; const int* pos;
  const float *w_ada, *b_ada, *w_in, *conv_w, *a_log, *dt_bias, *norm_b_w, *w_pa, *w_pb, *w_o, *wq, *subk, *pu, *pv, *fnw;
  float* out; char* ws; char* dscan; char* uv;
};

#ifdef EMU
DI int get_tid() { return (int)threadIdx.x; }
#else
#if MULTI_LAUNCH
DI int get_tid() { int t = threadIdx.x; asm volatile("" : "+v"(t)); return t; }
#else
__shared__ unsigned char g_wtab[64];
DI int hw_wave_key() { return (int)(__builtin_amdgcn_s_getreg(0x2804) & 63u); }
DI int get_tid() {
  const int w = __builtin_amdgcn_readfirstlane((int)g_wtab[hw_wave_key()]);
  int l;
  asm volatile("v_mbcnt_lo_u32_b32 %0, -1, 0\n\tv_mbcnt_hi_u32_b32 %0, -1, %0" : "=v"(l));
  return (w << 6) | l;
}
#endif
#endif
DI f4 mfma16(h8 a, h8 b, f4 c) { return __builtin_amdgcn_mfma_f32_16x16x32_f16(a, b, c, 0, 0, 0); }
DI f4 mfma16_i8(h8 a, h8 b, f4 c) { return __builtin_bit_cast(f4, __builtin_amdgcn_mfma_i32_16x16x64_i8(__builtin_bit_cast(i4, a), __builtin_bit_cast(i4, b), __builtin_bit_cast(i4, c), 0, 0, 0)); }
#ifdef EMU
DI void wave_sync() { int z = 0, r; emu_collective(&z, 4, &r, 4, [](EmuWave*) {}); }
DI void gmem_wave_sync() { wave_sync(); }
#else
DI void wave_sync() { __builtin_amdgcn_fence(__ATOMIC_RELEASE, "wavefront"); __builtin_amdgcn_wave_barrier(); __builtin_amdgcn_fence(__ATOMIC_ACQUIRE, "wavefront"); }
DI void gmem_wave_sync() { __builtin_amdgcn_fence(__ATOMIC_SEQ_CST, "workgroup"); __builtin_amdgcn_wave_barrier(); }
#endif
#ifdef EMU
DI unsigned ld_relaxed_agent(unsigned* p) { return *(volatile unsigned*)p; }
DI void add_relaxed_agent(unsigned* p, unsigned v) { *p += v; }
DI void fence_release_agent() {}
DI void fence_acquire_agent() {}
DI void drain_stores() {}
DI void spin_pause() { emu_yield(); }
#else
DI unsigned ld_relaxed_agent(unsigned* p) { return __hip_atomic_load(p, __ATOMIC_RELAXED, __HIP_MEMORY_SCOPE_AGENT); }
DI void add_relaxed_agent(unsigned* p, unsigned v) { (void)__hip_atomic_fetch_add(p, v, __ATOMIC_RELAXED, __HIP_MEMORY_SCOPE_AGENT); }
DI void fence_release_agent() { __builtin_amdgcn_fence(__ATOMIC_RELEASE, "agent"); asm volatile("s_waitcnt vmcnt(0)" ::: "memory"); }
DI void fence_acquire_agent() { __builtin_amdgcn_fence(__ATOMIC_ACQUIRE, "agent"); asm volatile("s_waitcnt vmcnt(0)" ::: "memory"); }
DI void drain_stores() { asm volatile("s_waitcnt vmcnt(0)" ::: "memory"); }
DI void spin_pause() { __builtin_amdgcn_s_sleep(8); }
#endif
DI float wave_sum(float v) { for (int m = 32; m >= 1; m >>= 1) v += __shfl_xor(v, m); return v; }
DI int wave_sum_i(int v) { for (int m = 32; m >= 1; m >>= 1) v += __shfl_xor(v, m); return v; }
DI float sigmoidf_(float x) { return 1.0f / (1.0f + __expf(-x)); }
DI float siluf_(float x) { return x / (1.0f + __expf(-x)); }
DI float softplusf_(float x) { return x > 20.f ? x : log1pf(__expf(x)); }
DI unsigned f2ord(float f) { unsigned u = __builtin_bit_cast(unsigned, f); return (u & 0x80000000u) ? ~u : (u | 0x80000000u); }
DI float ord2f(unsigned k) { unsigned u = (k & 0x80000000u) ? (k & 0x7fffffffu) : ~k; return __builtin_bit_cast(float, u); }
DI h8 cat44(h4 a, h4 b) { h8 r; r[0] = a[0]; r[1] = a[1]; r[2] = a[2]; r[3] = a[3]; r[4] = b[0]; r[5] = b[1]; r[6] = b[2]; r[7] = b[3]; return r; }
DI h8 cvt_f4f4(f4 a, f4 b) { h8 r; r[0] = (hf)a[0]; r[1] = (hf)a[1]; r[2] = (hf)a[2]; r[3] = (hf)a[3]; r[4] = (hf)b[0]; r[5] = (hf)b[1]; r[6] = (hf)b[2]; r[7] = (hf)b[3]; return r; }
#ifdef EMU
DI h4 lds_read_tr16(const hf* p) {
  h4 r; const hf* pp = p;
  emu_collective(&pp, sizeof(pp), &r, sizeof(r), [&](EmuWave* w) {
    for (int l = 0; l < 64; ++l) { const int gb = l & ~15, i = l & 15; h4 o;
      for (int qq = 0; qq < 4; ++qq) { const hf* src; memcpy(&src, w->in[gb + 4 * qq + (i >> 2)], sizeof(src)); o[qq] = src[i & 3]; }
      memcpy(w->out[l], &o, sizeof(o)); }
  });
  return r;
}
#else
typedef short s4v __attribute__((ext_vector_type(4)));
DI h4 lds_read_tr16(const hf* p) {
  const s4v v = __builtin_amdgcn_ds_read_tr16_b64_v4i16((__attribute__((address_space(3))) s4v*)p);
  return __builtin_bit_cast(h4, v);
}
#endif
DI h8 relu8(h8 v) { const h8 z = h8{0, 0, 0, 0, 0, 0, 0, 0}; return __builtin_elementwise_max(v, z); }
DI h8 permload(const hf* p, int q) { return cat44(*(const h4*)(p + 4 * q), *(const h4*)(p + 16 + 4 * q)); }


#ifndef EMU
#define XB_TMO      128
#define XB_XCNT(j)  (256  + 64 * (j))
#define XB_XSUB(j)  (1280 + 64 * (j))
#define XB_XGEN(j)  (2304 + 64 * (j))
#define XB_TOP      3328
#define XB_TOPGEN   3392
#define XCD_BAR_WORDS 3456
#define XB_SPIN_CAP (1u << 22)
#define LAS __attribute__((address_space(3)))
DI unsigned xb_ld(unsigned* p) { return __hip_atomic_load(p, __ATOMIC_RELAXED, __HIP_MEMORY_SCOPE_AGENT); }
DI unsigned xb_add(unsigned* p, unsigned v) { return __hip_atomic_fetch_add(p, v, __ATOMIC_RELAXED, __HIP_MEMORY_SCOPE_AGENT); }
DI unsigned xb_xcc_id() { return (unsigned)__builtin_amdgcn_s_getreg((3 << 11) | 20) & 0xFu; }
#define XB_SPIN(cond, bar) do { unsigned _sp = 0; while (cond) { __builtin_amdgcn_s_sleep(1); \
    if ((++_sp & 255u) == 0u) { if (xb_ld(&(bar)[XB_TMO])) break; if (_sp > XB_SPIN_CAP) { atomicAdd(&(bar)[XB_TMO], 1u); break; } } } } while (0)
struct XcdBarrier { unsigned* bar; unsigned x; volatile LAS unsigned* st; };
DI XcdBarrier xcd_barrier_post(unsigned* bar, volatile LAS unsigned* st) {
  XcdBarrier b; b.bar = bar; b.x = xb_xcc_id(); b.st = st;
  if (threadIdx.x == 0) { const unsigned li = xb_add(&bar[XB_XCNT(b.x)], 1u); st[2] = b.x; st[3] = li; }
  return b;
}
DI void xcd_barrier_complete(unsigned* bar, unsigned x, unsigned& nloc, unsigned& nx) {
  const unsigned G = gridDim.x * gridDim.y * gridDim.z;
  unsigned sum, cnt, mine, sp = 0u;
  for (;;) {
    sum = 0u; cnt = 0u; mine = 0u;
#pragma unroll
    for (unsigned j = 0; j < 16; ++j) { const unsigned c = xb_ld(&bar[XB_XCNT(j)]); sum += c; cnt += (c > 0u) ? 1u : 0u; mine = (j == x) ? c : mine; }
    if (sum == G) break;
    __builtin_amdgcn_s_sleep(1);
    if ((++sp & 255u) == 0u) { if (xb_ld(&bar[XB_TMO])) break; if (sp > XB_SPIN_CAP) { atomicAdd(&bar[XB_TMO], 1u); break; } }
  }
  nloc = mine > 0u ? mine : 1u; nx = cnt > 0u ? cnt : 1u;
}
DI void xcd_barrier(const XcdBarrier& b) {
  asm volatile("s_waitcnt vmcnt(0)" ::: "memory");
  __syncthreads();
  if (threadIdx.x == 0) {
    unsigned* bar = b.bar;
    __builtin_amdgcn_s_waitcnt(0);
    unsigned nloc = b.st[0], nx = b.st[1];
    if (nloc == 0u) { xcd_barrier_complete(bar, b.x, nloc, nx); b.st[0] = nloc; b.st[1] = nx; }
    const unsigned old = xb_add(&bar[XB_XSUB(b.x)], 1u);
    const unsigned gen = old / nloc;
    if (old + 1u == (gen + 1u) * nloc) {
      __builtin_amdgcn_fence(__ATOMIC_RELEASE, "agent");
      asm volatile("s_waitcnt vmcnt(0)" ::: "memory");
      const unsigned og = xb_add(&bar[XB_TOP], 1u);
      const unsigned tg = og / nx;
      if (og + 1u == (tg + 1u) * nx) xb_add(&bar[XB_TOPGEN], 1u);
      else XB_SPIN(xb_ld(&bar[XB_TOPGEN]) == tg, bar);
      __builtin_amdgcn_fence(__ATOMIC_ACQUIRE, "agent");
      xb_add(&bar[XB_XGEN(b.x)], 1u);
      asm volatile("s_waitcnt vmcnt(0)" ::: "memory");
    } else {
      XB_SPIN(xb_ld(&bar[XB_XGEN(b.x)]) == gen, bar);
      __builtin_amdgcn_fence(__ATOMIC_ACQUIRE, "agent");
      asm volatile("s_waitcnt vmcnt(0)" ::: "memory");
    }
  }
  __syncthreads();
}
#endif

DI size_t pr32_off(int row, int k, int K) { return ((size_t)(row >> 1) * (K / 32) + (k >> 5)) * 64 + (row & 1) * 32 + (k & 31); }

constexpr int GBK_MAX = 128;
template <int BM, int GBK = 128, bool PR = false, bool I8 = false>
DI void gemm_mainloop(f4 (&acc)[BM / 32][4], const hf* __restrict__ A, int lda, const hf* __restrict__ Bt, int ldb, int K, int m0, int n0, char* smem, int krot = 0) {
  constexpr int GLD = GBK + 8, MT = BM / 32, CPR = GBK / 8, ACH = BM * CPR / 256, BCH = 128 * CPR / 256;
  hf* sA = (hf*)smem; hf* sB = sA + BM * GLD;
  const int tid = get_tid(), lane = tid & 63, wave = tid >> 6, wm = wave >> 1, wn = wave & 1;
  h8 ra[ACH], rb[BCH];
#pragma unroll
  for (int i = 0; i < ACH; ++i) { int idx = tid + i * 256, r = idx / CPR, c = idx % CPR; ra[i] = *(const h8*)(PR ? (A + pr32_off(m0 + r, c * 8, K)) : (A + (size_t)(m0 + r) * lda + krot + c * 8)); }
#pragma unroll
  for (int i = 0; i < BCH; ++i) { int idx = tid + i * 256, r = idx / CPR, c = idx % CPR; rb[i] = *(const h8*)(PR ? (Bt + pr32_off(n0 + r, c * 8, K)) : (Bt + (size_t)(n0 + r) * ldb + krot + c * 8)); }
  for (int k0 = 0; k0 < K; k0 += GBK) {
    __syncthreads();
#pragma unroll
    for (int i = 0; i < ACH; ++i) { int idx = tid + i * 256, r = idx / CPR, c = idx % CPR; *(h8*)(sA + r * GLD + c * 8) = ra[i]; }
#pragma unroll
    for (int i = 0; i < BCH; ++i) { int idx = tid + i * 256, r = idx / CPR, c = idx % CPR; *(h8*)(sB + r * GLD + c * 8) = rb[i]; }
    __syncthreads();
    if (k0 + GBK < K) {
      int kn = k0 + GBK + krot; kn = kn >= K ? kn - K : kn;
#pragma unroll
      for (int i = 0; i < ACH; ++i) { int idx = tid + i * 256, r = idx / CPR, c = idx % CPR; ra[i] = *(const h8*)(PR ? (A + pr32_off(m0 + r, kn + c * 8, K)) : (A + (size_t)(m0 + r) * lda + kn + c * 8)); }
#pragma unroll
      for (int i = 0; i < BCH; ++i) { int idx = tid + i * 256, r = idx / CPR, c = idx % CPR; rb[i] = *(const h8*)(PR ? (Bt + pr32_off(n0 + r, kn + c * 8, K)) : (Bt + (size_t)(n0 + r) * ldb + kn + c * 8)); }
    }
#pragma unroll
    for (int ks = 0; ks < GBK / 32; ++ks) {
      h8 af[MT], bf[4];
#pragma unroll
      for (int mt = 0; mt < MT; ++mt) af[mt] = *(const h8*)(sA + (wm * (BM / 2) + mt * 16 + (lane & 15)) * GLD + ks * 32 + (lane >> 4) * 8);
#pragma unroll
      for (int nt = 0; nt < 4; ++nt) bf[nt] = *(const h8*)(sB + (wn * 64 + nt * 16 + (lane & 15)) * GLD + ks * 32 + (lane >> 4) * 8);
#pragma unroll
      for (int mt = 0; mt < MT; ++mt)
#pragma unroll
        for (int nt = 0; nt < 4; ++nt) acc[mt][nt] = I8 ? mfma16_i8(af[mt], bf[nt], acc[mt][nt]) : mfma16(af[mt], bf[nt], acc[mt][nt]);
    }
  }
}
template <int BM, bool I8>
DI void gemm_mainloop_2set(f4 (&acc)[BM / 32][4], const hf* __restrict__ A, const hf* __restrict__ Bt, int K, int m0, int n0, char* smem) {
  constexpr int GBK = 32, GLD = GBK + 8, MT = BM / 32, CPR = GBK / 8, ACH = BM * CPR / 256, BCH = 128 * CPR / 256;
  hf* sA = (hf*)smem; hf* sB = sA + BM * GLD;
  const int tid = get_tid(), lane = tid & 63, wave = tid >> 6, wm = wave >> 1, wn = wave & 1;
  h8 ra[ACH], ra2[ACH], rb[BCH];
  const unsigned voff = (unsigned)(((tid >> 3) * (K / 32)) * 64 + ((tid >> 2) & 1) * 32 + (tid & 3) * 8) * 2u;
#ifndef EMU
  m0 = __builtin_amdgcn_readfirstlane(m0); n0 = __builtin_amdgcn_readfirstlane(n0);
#endif
  const char* Ab = (const char*)(A + (size_t)(m0 >> 1) * (K / 32) * 64);
  const char* Bb = (const char*)(Bt + (size_t)(n0 >> 1) * (K / 32) * 64);
  const size_t chunk_b = (size_t)32 * (K / 32) * 64 * 2;
#ifdef EMU
#define G2LDA(RA, kk) { _Pragma("unroll") for (int i = 0; i < ACH; ++i) RA[i] = *(const h8*)(Ab + i * chunk_b + (size_t)((kk) >> 5) * 128 + voff); }
#define G2LDB(kk) { _Pragma("unroll") for (int i = 0; i < BCH; ++i) rb[i] = *(const h8*)(Bb + i * chunk_b + (size_t)((kk) >> 5) * 128 + voff); }
#else
  const __amdgpu_buffer_rsrc_t rsA = __builtin_amdgcn_make_buffer_rsrc((void*)Ab, 0, 0x7fffffff, 0x00020000);
  const __amdgpu_buffer_rsrc_t rsB = __builtin_amdgcn_make_buffer_rsrc((void*)Bb, 0, 0x7fffffff, 0x00020000);
#define G2LDA(RA, kk) { _Pragma("unroll") for (int i = 0; i < ACH; ++i) RA[i] = __builtin_bit_cast(h8, __builtin_amdgcn_raw_buffer_load_b128(rsA, (int)voff, (int)(i * chunk_b) + ((kk) >> 5) * 128, 0)); }
#define G2LDB(kk) { _Pragma("unroll") for (int i = 0; i < BCH; ++i) rb[i] = __builtin_bit_cast(h8, __builtin_amdgcn_raw_buffer_load_b128(rsB, (int)voff, (int)(i * chunk_b) + ((kk) >> 5) * 128, 0)); }
#endif
#define G2STEP(RA, kb_next, ka_next, LDB_, LDA_) { __syncthreads(); \
    _Pragma("unroll") for (int i = 0; i < ACH; ++i) { const int idx = tid + i * 256, r = idx / CPR, c = idx % CPR; *(h8*)(sA + r * GLD + c * 8) = RA[i]; } \
    _Pragma("unroll") for (int i = 0; i < BCH; ++i) { const int idx = tid + i * 256, r = idx / CPR, c = idx % CPR; *(h8*)(sB + r * GLD + c * 8) = rb[i]; } \
    __syncthreads(); \
    if (LDB_) G2LDB(kb_next) \
    if (LDA_) G2LDA(RA, ka_next) \
    { h8 bf[4]; \
      _Pragma("unroll") for (int nt = 0; nt < 4; ++nt) bf[nt] = *(const h8*)(sB + (wn * 64 + nt * 16 + (lane & 15)) * GLD + (lane >> 4) * 8); \
      _Pragma("unroll") for (int mh = 0; mh < MT / 4; ++mh) { h8 af[4]; \
        _Pragma("unroll") for (int mt = 0; mt < 4; ++mt) af[mt] = *(const h8*)(sA + (wm * (BM / 2) + (mh * 4 + mt) * 16 + (lane & 15)) * GLD + (lane >> 4) * 8); \
        _Pragma("unroll") for (int mt = 0; mt < 4; ++mt) _Pragma("unroll") for (int nt = 0; nt < 4; ++nt) acc[mh * 4 + mt][nt] = I8 ? mfma16_i8(af[mt], bf[nt], acc[mh * 4 + mt][nt]) : mfma16(af[mt], bf[nt], acc[mh * 4 + mt][nt]); } } }
  G2LDB(0) G2LDA(ra, 0) G2LDA(ra2, GBK)
  for (int k0 = 0; k0 < K - 2 * GBK; k0 += 2 * GBK) {
    G2STEP(ra, k0 + GBK, k0 + 2 * GBK, true, true)
    G2STEP(ra2, k0 + 2 * GBK, k0 + 3 * GBK, true, true)
  }
  G2STEP(ra, K - GBK, 0, true, false)
  G2STEP(ra2, 0, 0, false, false)
#undef G2LDA
#undef G2LDB
#undef G2STEP
}
template <int BM, bool I8 = false>
DI void gemm_mainloop_r3(f4 (&acc)[BM / 32][4], const hf* __restrict__ A, int lda, const hf* __restrict__ Bt, int ldb, int K, int m0, int n0, char* smem) {
  constexpr int GLD = 72, MT = BM / 32, ACH = BM * 8 / 256;
  hf* sA = (hf*)smem; hf* sB = sA + BM * GLD;
  const int tid = get_tid(), lane = tid & 63, wave = tid >> 6, wm = wave >> 1, wn = wave & 1;
  const int nk = K / 64;
  h8 a0[ACH], b0[4], a1[ACH], b1[4], a2[ACH], b2[4];
  const hf* Ap = A + (size_t)(m0 + (tid >> 3)) * lda + (tid & 7) * 8;
  const hf* Bp = Bt + (size_t)(n0 + (tid >> 3)) * ldb + (tid & 7) * 8;
#define GL(ra, rb, kt) { const int kk_ = ((kt) < nk ? (kt) : nk - 1) * 64; \
    _Pragma("unroll") for (int i = 0; i < ACH; ++i) ra[i] = *(const h8*)(Ap + (size_t)(i * 32) * lda + kk_); \
    _Pragma("unroll") for (int i = 0; i < 4; ++i) rb[i] = *(const h8*)(Bp + (size_t)(i * 32) * ldb + kk_); }
#define GSTEP(ra, rb, knext) { __syncthreads(); \
    _Pragma("unroll") for (int i = 0; i < ACH; ++i) *(h8*)(sA + ((tid >> 3) + i * 32) * GLD + (tid & 7) * 8) = ra[i]; \
    _Pragma("unroll") for (int i = 0; i < 4; ++i) *(h8*)(sB + ((tid >> 3) + i * 32) * GLD + (tid & 7) * 8) = rb[i]; \
    __syncthreads(); \
    GL(ra, rb, knext) \
    _Pragma("unroll") for (int ks = 0; ks < 2; ++ks) { h8 af[MT], bf[4]; \
      _Pragma("unroll") for (int mt = 0; mt < MT; ++mt) af[mt] = *(const h8*)(sA + (wm * (BM / 2) + mt * 16 + (lane & 15)) * GLD + ks * 32 + (lane >> 4) * 8); \
      _Pragma("unroll") for (int nt = 0; nt < 4; ++nt) bf[nt] = *(const h8*)(sB + (wn * 64 + nt * 16 + (lane & 15)) * GLD + ks * 32 + (lane >> 4) * 8); \
      _Pragma("unroll") for (int mt = 0; mt < MT; ++mt) _Pragma("unroll") for (int nt = 0; nt < 4; ++nt) acc[mt][nt] = I8 ? mfma16_i8(af[mt], bf[nt], acc[mt][nt]) : mfma16(af[mt], bf[nt], acc[mt][nt]); } }
  GL(a0, b0, 0) GL(a1, b1, 1) GL(a2, b2, 2)
  for (int kt = 0; kt < nk; kt += 3) {
    GSTEP(a0, b0, kt + 3)
    if (kt + 1 < nk) GSTEP(a1, b1, kt + 4)
    if (kt + 2 < nk) GSTEP(a2, b2, kt + 5)
  }
#undef GL
#undef GSTEP
}
constexpr int TLD = 136;
template <int MT> DI void zero_acc(f4 (&acc)[MT][4]) {
#pragma unroll
  for (int i = 0; i < MT; ++i)
#pragma unroll
    for (int j = 0; j < 4; ++j) acc[i][j] = f4{0.f, 0.f, 0.f, 0.f};
}


DI const volatile unsigned* xcd_words(char* smem);
struct TileSched { int s, step, total, rp0, ntn, sr; };
DI TileSched tile_begin(int NTM_, int NTN_, const void* g_bar = nullptr, const volatile unsigned* g_st = nullptr) {
  const int G = (int)gridDim.x;
  const int ng = (G % 8 == 0 && NTM_ % 8 == 0) ? 8 : ((G % 4 == 0 && NTM_ % 4 == 0) ? 4 : 1);
  int x = (int)blockIdx.x % ng, li = (int)blockIdx.x / ng; const int rpg = NTM_ / ng;
#ifndef EMU
  if (ng == 8) {
    const unsigned* bar = (const unsigned*)g_bar; bool ok = true;
#pragma unroll
    for (int j = 0; j < 8; ++j) ok = ok && (__hip_atomic_load(&bar[XB_XCNT(j)], __ATOMIC_RELAXED, __HIP_MEMORY_SCOPE_AGENT) == (unsigned)(G / 8));
    if (ok) { x = (int)g_st[2]; li = (int)g_st[3]; }
  }
  x = __builtin_amdgcn_readfirstlane(x); li = __builtin_amdgcn_readfirstlane(li);
#endif
  TileSched t; t.s = li; t.step = G / ng; t.total = rpg * NTN_; t.rp0 = x * rpg; t.ntn = NTN_; t.sr = (rpg % 8 == 0) ? 8 : ((rpg % 4 == 0) ? 4 : ((rpg % 2 == 0) ? 2 : 1));
  return t;
}
DI bool tile_next(TileSched& t, int& tm, int& tn) {
  if (t.s >= t.total) return false;
  const int SC = 8;
  const int per_rg = t.sr * t.ntn, rg = t.s / per_rg, rem = t.s % per_rg, nfull = t.ntn / SC, fullsz = nfull * t.sr * SC;
  int r, c, cg;
  if (rem < fullsz) { cg = rem / (t.sr * SC); const int loc = rem % (t.sr * SC); r = loc / SC; c = loc % SC; }
  else { const int loc = rem - fullsz, w = t.ntn - nfull * SC; cg = nfull; r = loc / w; c = loc % w; }
  tm = t.rp0 + rg * t.sr + r; tn = cg * SC + c; t.s += t.step;
  return true;
}

DI int win_colmap(int c) {
  if (c < 1872) return c;
  if (c < 1880) return 3920 + (c - 1872);
  if (c < 1888) return 3928 + (c - 1880);
  if (c < 1920) return -1;
  if (c < 3968) return 1872 + (c - 1920);
  return 3936 + (c - 3968);
}
DI void transpose_tile(const float* src, int lds_, hf* dst, int K, int k0, int n0, bool use_map, char* smem, bool pr = false) {
  float* t = (float*)smem;
  const int tid = get_tid(), c = tid & 63, r0 = tid >> 6;
  int sc = use_map ? win_colmap(n0 + c) : (n0 + c);
  __syncthreads();
  float tv[16];
#pragma unroll
  for (int i = 0; i < 16; ++i) { int r = i * 4 + r0; tv[i] = sc >= 0 ? src[(size_t)(k0 + r) * lds_ + sc] : 0.f; }
#pragma unroll
  for (int i = 0; i < 16; ++i) t[c * 65 + i * 4 + r0] = tv[i];
  __syncthreads();
#pragma unroll 4
  for (int i = 0; i < 16; ++i) { int r = i * 4 + r0; dst[pr ? pr32_off(n0 + r, k0 + c, K) : ((size_t)(n0 + r) * K + k0 + c)] = (hf)t[r * 65 + c]; }
}
DI void phase_A(const Params& p, char* smem) {
  float* mod = (float*)(p.ws + O_MOD);
  const int tid = get_tid(), lane = tid & 63, wave = tid >> 6;
  constexpr int N_MOD = 6 * DM / 64;
  constexpr int N_WIN = (NP / 64) * (DM / 64), N_WPA = (DM / 64) * 8, N_WO = (DM / 64) * (DM / 64), N_WQ = 16 * (DM / 64);
  constexpr int N_SUBK = 8, N_CS = NTOK / 256;
  constexpr int T1 = N_MOD, T2 = T1 + N_WIN, T3 = T2 + N_WPA, T4 = T3 + N_WPA, T5 = T4 + N_WO, T6 = T5 + N_WQ, T7 = T6 + N_SUBK, T8 = T7 + N_CS;
  if (blockIdx.x == 0) { if (tid < 64) ((int*)(p.ws + O_CNT))[tid] = 0; for (int i = tid; i < 4096; i += 256) ((unsigned*)(p.ws + O_BAR))[i] = 0u; }
  for (int it = blockIdx.x; it < T8; it += gridDim.x) {
    if (it < T1) {
      float* sil = (float*)smem;
      float* red = sil + BATCH * DM;
      __syncthreads();
      for (int i = tid; i < BATCH * DM; i += 256) sil[i] = siluf_(p.c[i]);
      __syncthreads();
      const int j = it * 64 + lane;
      float a[BATCH];
#pragma unroll
      for (int b = 0; b < BATCH; ++b) a[b] = 0.f;
      for (int k = wave * (DM / 4); k < (wave + 1) * (DM / 4); ++k) {
        float w = p.w_ada[(size_t)k * 6 * DM + j];
#pragma unroll
        for (int b = 0; b < BATCH; ++b) a[b] += sil[b * DM + k] * w;
      }
#pragma unroll
      for (int b = 0; b < BATCH; ++b) red[(wave * BATCH + b) * 64 + lane] = a[b];
      __syncthreads();
      if (wave == 0) {
#pragma unroll
        for (int b = 0; b < BATCH; ++b) {
          float s = red[(0 * BATCH + b) * 64 + lane] + red[(1 * BATCH + b) * 64 + lane] + red[(2 * BATCH + b) * 64 + lane] + red[(3 * BATCH + b) * 64 + lane];
          mod[(size_t)b * 6 * DM + j] = s + p.b_ada[j];
        }
      }
    } else if (it < T2) { int t = it - T1; transpose_tile(p.w_in, IN_W, (hf*)(p.ws + O_WIN), DM, (t % (DM / 64)) * 64, (t / (DM / 64)) * 64, true, smem, true); }
    else if (it < T3) { int t = it - T2; transpose_tile(p.w_pa, DM, (hf*)(p.ws + O_WPA), 512, (t % 8) * 64, (t / 8) * 64, false, smem); }
    else if (it < T4) { int t = it - T3; transpose_tile(p.w_pb, DM, (hf*)(p.ws + O_WPB), 512, (t % 8) * 64, (t / 8) * 64, false, smem); }
    else if (it < T5) { int t = it - T4; transpose_tile(p.w_o, DM, (hf*)(p.ws + O_WO), DM, (t % (DM / 64)) * 64, (t / (DM / 64)) * 64, false, smem, true); }
    else if (it < T6) { int t = it - T5; transpose_tile(p.wq, 1024, (hf*)(p.ws + O_WQ), DM, (t % (DM / 64)) * 64, (t / (DM / 64)) * 64, false, smem); }
    else if (it < T7) { int t = it - T6; hf* d = (hf*)(p.ws + O_SUBK); for (int i = tid; i < 16384; i += 256) d[t * 16384 + i] = (hf)p.subk[t * 16384 + i]; }
    else {
      int tok = (it - T7) * 256 + tid;
      float* cs = (float*)(p.ws + O_CS) + (size_t)tok * 16;
      float pos = (float)p.pos[tok];
#pragma unroll
      for (int i = 0; i < 8; ++i) { float inv = powf(500000.0f, -(float)i * 0.125f); float ang = pos * inv; cs[i] = cosf(ang); cs[8 + i] = sinf(ang); }
    }
  }
}

DI void adaln_rows(const float* src, hf* dst, const float* mod, int sh_off, int sc_off, bool pr) {
  const int tid = get_tid(), lane = tid & 63, wave = tid >> 6;
  for (int row = blockIdx.x * 4 + wave; row < NTOK; row += gridDim.x * 4) {
    const float* xr = src + (size_t)row * DM; const int b = row / SEQ;
    float v[DM / 64]; float ss = 0.f;
#pragma unroll
    for (int i = 0; i < DM / 256; ++i) { f4 t = *(const f4*)(xr + i * 256 + lane * 4); v[4 * i] = t[0]; v[4 * i + 1] = t[1]; v[4 * i + 2] = t[2]; v[4 * i + 3] = t[3]; ss += t[0] * t[0] + t[1] * t[1] + t[2] * t[2] + t[3] * t[3]; }
    ss = wave_sum(ss);
    float rstd = rsqrtf(ss * (1.0f / DM) + EPSN);
    const float* mb = mod + (size_t)b * 6 * DM;
#pragma unroll
    for (int i = 0; i < DM / 256; ++i) {
      int d = i * 256 + lane * 4; h4 o;
#pragma unroll
      for (int j = 0; j < 4; ++j) o[j] = (hf)(v[4 * i + j] * rstd * (1.0f + mb[sc_off + d + j]) + mb[sh_off + d + j]);
      *(h4*)(dst + (pr ? pr32_off(row, d, DM) : ((size_t)row * DM + d))) = o;
    }
  }
}

constexpr size_t Q_W8 = 0, Q_SB = al256((size_t)NP * DM), Q_N1 = al256(Q_SB + (size_t)NP * 4), Q_SA = Q_N1 + (size_t)NTOK * DM;
static_assert(Q_SA + (size_t)NTOK * 4 <= DSCAN_BYTES, "scan scratch too small for the int8 in-projection operands");
#ifndef TN_I8
#define TN_I8 0
#endif
static_assert(TN_I8 == 0, "the query scale is folded into the int8 dequant scale: every in-projection tile must take the int8 path");
DI size_t pr64b_off(int row, int k, int K) { return ((size_t)(row >> 1) * (K / 64) + (k >> 6)) * 128 + (row & 1) * 64 + (k & 63); }
DI void phase_B(const Params& p) {
  const int tid = get_tid(), lane = tid & 63, wave = tid >> 6;
  const float* mod = (const float*)(p.ws + O_MOD);
  signed char* n1q = (signed char*)(TN_I8 > 0 ? p.dscan + Q_N1 : p.ws + O_R); float* sa = (float*)(TN_I8 > 0 ? p.dscan + Q_SA : p.ws + O_R + (size_t)NTOK * DM); hf* n1h = (hf*)(p.ws + O_R);
  signed char* w8 = (signed char*)(p.ws + O_W8); float* sb = (float*)(p.ws + O_SB8);
  for (int row = blockIdx.x * 4 + wave; row < NTOK; row += gridDim.x * 4) {
    const float* xr = p.x + (size_t)row * DM; const int b = row / SEQ;
    float v[DM / 64]; float ss = 0.f;
#pragma unroll
    for (int i = 0; i < DM / 256; ++i) { f4 t = *(const f4*)(xr + i * 256 + lane * 4); v[4 * i] = t[0]; v[4 * i + 1] = t[1]; v[4 * i + 2] = t[2]; v[4 * i + 3] = t[3]; ss += t[0] * t[0] + t[1] * t[1] + t[2] * t[2] + t[3] * t[3]; }
    ss = wave_sum(ss);
    const float rstd = rsqrtf(ss * (1.0f / DM) + EPSN);
    const float* mb = mod + (size_t)b * 6 * DM;
    float mx = 0.f;
#pragma unroll
    for (int i = 0; i < DM / 256; ++i)
#pragma unroll
      for (int j = 0; j < 4; ++j) { const int d = i * 256 + lane * 4 + j; v[4 * i + j] = v[4 * i + j] * rstd * (1.0f + mb[DM + d]) + mb[d]; mx = fmaxf(mx, fabsf(v[4 * i + j])); }
    if (TN_I8 > 0) {
#pragma unroll
      for (int i = 0; i < DM / 256; ++i) { h4 o; o[0] = (hf)v[4 * i]; o[1] = (hf)v[4 * i + 1]; o[2] = (hf)v[4 * i + 2]; o[3] = (hf)v[4 * i + 3]; *(h4*)(n1h + pr32_off(row, i * 256 + lane * 4, DM)) = o; }
    }
#pragma unroll
    for (int m = 32; m >= 1; m >>= 1) mx = fmaxf(mx, __shfl_xor(mx, m));
    const float sc = mx > 0.f ? mx * (1.0f / 127.0f) : 1.0f, inv = 1.0f / sc;
#pragma unroll
    for (int i = 0; i < DM / 256; ++i) {
      unsigned w = 0;
#pragma unroll
      for (int j = 0; j < 4; ++j) { int qv = (int)rintf(v[4 * i + j] * inv); qv = qv > 127 ? 127 : (qv < -127 ? -127 : qv); w |= ((unsigned)qv & 255u) << (8 * j); }
      *(unsigned*)(n1q + pr64b_off(row, i * 256 + lane * 4, DM)) = w;
    }
    if (lane == 0) sa[row] = sc;
  }
  const hf* WinT = (const hf*)(p.ws + O_WIN);
  for (int n = blockIdx.x * 4 + wave; n < NP; n += gridDim.x * 4) {
    constexpr int EPL = DM / 64;
    const hf* wr = WinT + pr32_off(n, lane * EPL, DM);
    float v[EPL]; float mx = 0.f;
#pragma unroll
    for (int i = 0; i < EPL; ++i) { v[i] = (float)wr[i]; mx = fmaxf(mx, fabsf(v[i])); }
#pragma unroll
    for (int m = 32; m >= 1; m >>= 1) mx = fmaxf(mx, __shfl_xor(mx, m));
    const float sc = mx > 0.f ? mx * (1.0f / 127.0f) : 1.0f, inv = 1.0f / sc;
#pragma unroll
    for (int i4_ = 0; i4_ < EPL / 4; ++i4_) {
      unsigned w = 0;
#pragma unroll
      for (int j = 0; j < 4; ++j) { int qv = (int)rintf(v[4 * i4_ + j] * inv); qv = qv > 127 ? 127 : (qv < -127 ? -127 : qv); w |= ((unsigned)qv & 255u) << (8 * j); }
      *(unsigned*)(w8 + pr64b_off(n, lane * EPL + 4 * i4_, DM)) = w;
    }
    if (lane == 0) sb[n] = sc;
  }
  const hf* WqT = (const hf*)(p.ws + O_WQ); signed char* wq8 = (signed char*)(p.ws + O_WQ8); float* sq8 = (float*)(p.ws + O_SQ8);
  for (int n = blockIdx.x * 4 + wave; n < 1024; n += gridDim.x * 4) {
    constexpr int EPL = DM / 64;
    const hf* wr = WqT + (size_t)n * DM + lane * EPL;
    float v[EPL]; float mx = 0.f;
#pragma unroll
    for (int i = 0; i < EPL; ++i) { v[i] = (float)wr[i]; mx = fmaxf(mx, fabsf(v[i])); }
#pragma unroll
    for (int m = 32; m >= 1; m >>= 1) mx = fmaxf(mx, __shfl_xor(mx, m));
    const float sc = mx > 0.f ? mx * (1.0f / 127.0f) : 1.0f, inv = 1.0f / sc;
#pragma unroll
    for (int i4_ = 0; i4_ < EPL / 4; ++i4_) {
      unsigned w = 0;
#pragma unroll
      for (int j = 0; j < 4; ++j) { int qv = (int)rintf(v[4 * i4_ + j] * inv); qv = qv > 127 ? 127 : (qv < -127 ? -127 : qv); w |= ((unsigned)qv & 255u) << (8 * j); }
      *(unsigned*)(wq8 + (size_t)n * DM + lane * EPL + 4 * i4_) = w;
    }
    if (lane == 0) sq8[n] = sc;
  }
}
DI void phase_C(const Params& p, char* smem) {
  const hf* n1h = (const hf*)(p.ws + O_R); const hf* WinT = (const hf*)(p.ws + O_WIN);
  const hf* n1q = (const hf*)(TN_I8 > 0 ? p.dscan + Q_N1 : p.ws + O_R); const hf* W8 = (const hf*)(p.ws + O_W8);
  const float* sa = (const float*)(TN_I8 > 0 ? p.dscan + Q_SA : p.ws + O_R + (size_t)NTOK * DM); const float* sb = (const float*)(p.ws + O_SB8);
  hf* P1 = (hf*)(p.ws + O_P1); hf* P2 = (hf*)(p.ws + O_P2); hf* P3 = (hf*)(p.ws + O_P3); hf* P4 = (hf*)(p.ws + O_P4);
  float* aux = (float*)(p.ws + O_AUX); const float* cs = (const float*)(p.ws + O_CS);
  constexpr int CBM = 256, CMT = CBM / 32, NTN = NP / 128, NTM = NTOK / CBM;
  TileSched ts = tile_begin(NTM, NTN, p.ws + O_BAR, xcd_words(smem)); int tm, tn;
  while (tile_next(ts, tm, tn)) {
    const int m0 = tm * CBM, n0 = tn * 128;
    f4 acc[CMT][4];
    for (int rep_ = 0; rep_ < REP_CMAIN; ++rep_) { zero_acc<CMT>(acc);
    if (TN_I8 == 0 || tn >= TN_I8) gemm_mainloop_2set<CBM, true>(acc, n1q, W8, DM / 2, m0, n0, smem);
    else gemm_mainloop<CBM, 32, true, false>(acc, n1h, DM, WinT, DM, DM, m0, n0, smem); }
    const int tid_e = get_tid();
    const int lane = tid_e & 63, wave = tid_e >> 6, wm = wave >> 1, wn = wave & 1, q = lane >> 4, cl = lane & 15;
    const bool rope = (tn <= 4) || (tn >= 6 && tn <= 14);
    hf* tileS = (hf*)smem;
    for (int repe_ = 0; repe_ < REP_CEPI; ++repe_) {
    __syncthreads();
#pragma unroll
    for (int mt = 0; mt < CMT; ++mt) {
#pragma unroll
      for (int nt = 0; nt < 4; ++nt) {
        const int lrow = wm * (CBM / 2) + mt * 16 + q * 4, lcol = wn * 64 + nt * 16 + cl;
        const int rbase = m0 + lrow;
        f4 v = acc[mt][nt];
        if (TN_I8 == 0 || tn >= TN_I8) { const i4 ai = __builtin_bit_cast(i4, acc[mt][nt]); const float sbn = sb[n0 + lcol] * ((tn < 4) ? 0.125f : 1.0f); const f4 sa4 = *(const f4*)(sa + rbase);
#pragma unroll
          for (int r = 0; r < 4; ++r) v[r] = (float)ai[r] * (sa4[r] * sbn); }
        if (rope && nt == 0 && !(tn == 14 && wn == 1)) {
#pragma unroll
          for (int r = 0; r < 4; ++r) {
            float pv = __shfl_xor(v[r], 8);
            const float* c2 = cs + (size_t)(rbase + r) * 16; float co = c2[cl & 7], si = c2[8 + (cl & 7)];
            v[r] = (cl < 8) ? (v[r] * co - pv * si) : (v[r] * co + pv * si);
          }
        }
        if (tn == 14 && wn == 1) {
          const int lc = nt * 16 + cl;
          if (lc < 32) {
            const int hh = lc & 7;
#pragma unroll
            for (int r = 0; r < 4; ++r) {
              float o;
              if (lc < 16) o = v[r] * (0.25f * 0.125f);
              else if (lc < 24) o = sigmoidf_(v[r]);
              else o = -__expf(p.a_log[hh]) * softplusf_(v[r] + p.dt_bias[hh]);
              aux[(size_t)(rbase + r) * 32 + lc] = o;
            }
          }
        } else {
          if (tn >= 31) {
#pragma unroll
            for (int r = 0; r < 4; ++r) v[r] = sigmoidf_(v[r]);
          }
#pragma unroll
          for (int r = 0; r < 4; ++r) tileS[(lrow + r) * TLD + lcol] = (hf)v[r];
        }
      }
    }
    __syncthreads();
    {
      hf* dst; int ld, nch = 16;
      if (tn < 15) { dst = P1 + n0; ld = LP1; if (tn == 14) nch = 8; }
      else if (tn < 27) { dst = P2 + (n0 - C_QB); ld = LP2; }
      else if (tn < 31) { dst = P3 + (n0 - C_ZB); ld = LP3; }
      else { dst = P4 + (n0 - C_GA); ld = LP4; }
      const int tid = get_tid();
#pragma unroll
      for (int i = 0; i < CBM / 16; ++i) {
        const int idx = tid + i * 256, row = idx >> 4, ch = idx & 15;
        if (ch < nch) *(h8*)(dst + (size_t)(m0 + row) * ld + ch * 8) = *(const h8*)(tileS + row * TLD + ch * 8);
      }
    }
    }
  }
}

DI void phase_D1(const Params& p, char* smem) {
  const hf* P2 = (const hf*)(p.ws + O_P2); const float* aux = (const float*)(p.ws + O_AUX);
  hf* Qs = (hf*)smem;
  hf* Ks = Qs + 64 * 72;
  float* RHS = (float*)(Ks + 64 * 72);
  float* Lm = RHS + 64 * 128;
  float* gcs = Lm + 64 * 64;
  float* bts = gcs + 64;
  const int tid = get_tid(), lane = tid & 63, wave = tid >> 6, q = lane >> 4, cl = lane & 15;
  constexpr size_t MSZ = (size_t)NTOK * 512;
  hf* uT = (hf*)p.dscan; hf* wm_ = uT + MSZ; hf* qg = wm_ + MSZ; hf* kdT = qg + MSZ; hf* intra = (hf*)(p.ws + O_INTRA);
  float* eg = (float*)(p.ws + O_EG);
  for (int it = blockIdx.x; it < BATCH * 8 * NCHK; it += gridDim.x) {
    const int c = it % NCHK, h = (it / NCHK) % 8, b = it / (NCHK * 8);
    const size_t cbase = (size_t)it * 4096;
    const int tk = tid >> 2, qq = tid & 3, t0 = c * 64;
    const size_t grow = (size_t)b * SEQ + t0 + tk;
    __syncthreads();
    float g = aux[grow * 32 + 24 + h], beta = aux[grow * 32 + 16 + h];
    if (qq == 0) { gcs[tk] = g; bts[tk] = beta; }
    float val[3][16];
#pragma unroll
    for (int m = 0; m < 3; ++m) {
      const int ch0 = m * 512 + h * 64 + qq * 16;
#pragma unroll
      for (int e = 0; e < 16; ++e) val[m][e] = 0.f;
#pragma unroll
      for (int i = 0; i < 4; ++i) {
        const int tt = t0 + tk - 3 + i;
        if (tt >= 0) {
          const hf* src = P2 + ((size_t)b * SEQ + tt) * LP2 + ch0;
          h8 x0 = *(const h8*)src, x1 = *(const h8*)(src + 8);
          const float* wv = p.conv_w + (size_t)i * 1536 + ch0;
#pragma unroll
          for (int e = 0; e < 8; ++e) { val[m][e] += (float)x0[e] * wv[e]; val[m][8 + e] += (float)x1[e] * wv[8 + e]; }
        }
      }
#pragma unroll
      for (int e = 0; e < 16; ++e) val[m][e] = siluf_(val[m][e]);
    }
    float sq = 0.f, sk = 0.f;
#pragma unroll
    for (int e = 0; e < 16; ++e) { sq += val[0][e] * val[0][e]; sk += val[1][e] * val[1][e]; }
    sq += __shfl_xor(sq, 1); sq += __shfl_xor(sq, 2); sk += __shfl_xor(sk, 1); sk += __shfl_xor(sk, 2);
    const float nq = rsqrtf(sq + EPSN) * 0.125f, nk = rsqrtf(sk + EPSN);
    __syncthreads();
    if (wave == 0) { float v = gcs[lane];
#pragma unroll
      for (int d = 1; d < 64; d <<= 1) { const float y = __shfl(v, lane - d); if (lane >= d) v += y; }
      gcs[lane] = v; }
    __syncthreads();
    const float gc = gcs[tk], glast = gcs[63];
    const float egc = __expf(gc), ekd = __expf(glast - gc);
    if (tid == 0) eg[it] = __expf(glast);
#pragma unroll
    for (int e = 0; e < 16; ++e) {
      const int ch = qq * 16 + e;
      const float qv = val[0][e] * nq, kv = val[1][e] * nk, vv = val[2][e];
      Qs[tk * 72 + ch] = (hf)qv; Ks[tk * 72 + ch] = (hf)kv;
      RHS[tk * 128 + ch] = vv * beta; RHS[tk * 128 + 64 + ch] = kv * beta * egc;
      qg[cbase + tk * 64 + ch] = (hf)(qv * egc);
      kdT[cbase + ch * 64 + tk] = (hf)(kv * ekd);
    }
    __syncthreads();
    {
      f4 akk[4], aqk[4];
#pragma unroll
      for (int nt = 0; nt < 4; ++nt) { akk[nt] = f4{0, 0, 0, 0}; aqk[nt] = f4{0, 0, 0, 0}; }
#pragma unroll
      for (int ks = 0; ks < 2; ++ks) {
        h8 ak = *(const h8*)(Ks + (wave * 16 + cl) * 72 + ks * 32 + q * 8);
        h8 aq = *(const h8*)(Qs + (wave * 16 + cl) * 72 + ks * 32 + q * 8);
#pragma unroll
        for (int nt = 0; nt < 4; ++nt) {
          h8 bk = *(const h8*)(Ks + (nt * 16 + cl) * 72 + ks * 32 + q * 8);
          akk[nt] = mfma16(ak, bk, akk[nt]); aqk[nt] = mfma16(aq, bk, aqk[nt]);
        }
      }
#pragma unroll
      for (int nt = 0; nt < 4; ++nt) {
        const int j = nt * 16 + cl; const float gj = gcs[j];
#pragma unroll
        for (int r = 0; r < 4; ++r) {
          const int i = wave * 16 + q * 4 + r;
          const float dec = (i >= j) ? __expf(gcs[i] - gj) : 0.f;
          Lm[i * 64 + j] = (i > j) ? bts[i] * akk[nt][r] * dec : 0.f;
          intra[cbase + i * 64 + j] = (hf)(aqk[nt][r] * dec);
        }
      }
    }
    __syncthreads();
    if (wave < 2) {
      float xr[64];
#pragma unroll
      for (int i = 0; i < 64; ++i) xr[i] = 0.f;
#pragma unroll
      for (int i = 0; i < 64; ++i) {
        float s0 = 0.f, s1 = 0.f, s2 = 0.f, s3 = 0.f;
#pragma unroll
        for (int j4 = 0; j4 < (i + 3) / 4; ++j4) {
          f4 l4 = *(const f4*)(Lm + i * 64 + j4 * 4);
          s0 += l4[0] * xr[j4 * 4]; s1 += l4[1] * xr[j4 * 4 + 1]; s2 += l4[2] * xr[j4 * 4 + 2]; s3 += l4[3] * xr[j4 * 4 + 3];
        }
        xr[i] = RHS[i * 128 + wave * 64 + lane] - ((s0 + s1) + (s2 + s3));
      }
      if (wave == 0) {
#pragma unroll
        for (int i8 = 0; i8 < 8; ++i8) { h8 o;
#pragma unroll
          for (int e = 0; e < 8; ++e) o[e] = (hf)xr[i8 * 8 + e];
          *(h8*)(uT + cbase + lane * 64 + i8 * 8) = o; }
      } else {
#pragma unroll
        for (int i = 0; i < 64; ++i) wm_[cbase + i * 64 + lane] = (hf)xr[i];
      }
    }
  }
}

constexpr int E1_MAT = 64 * 72;
constexpr int LDS_E1 = 2 * 4 * E1_MAT * 2;
DI void phase_E1(const Params& p, char* smem) {
  const int tid = get_tid(), lane = tid & 63, wave = tid >> 6, q = lane >> 4, cl = lane & 15;
  constexpr size_t MSZ = (size_t)NTOK * 512;
  const hf* uT = (const hf*)p.dscan; const hf* intra = (const hf*)(p.ws + O_INTRA);
  const hf* mats[4] = {uT + MSZ, uT + 2 * MSZ, intra, uT + 3 * MSZ};
  const float* eg = (const float*)(p.ws + O_EG);
  hf* ob = (hf*)(p.ws + O_OB);
  hf* lbuf = (hf*)smem;
  for (int bh = blockIdx.x; bh < BATCH * 8; bh += gridDim.x) {
    const int b = bh / 8, h = bh % 8, e0 = wave * 16;
    f4 S[4];
#pragma unroll
    for (int i = 0; i < 4; ++i) S[i] = f4{0, 0, 0, 0};
    h8 st[8]; h4 un[4];
    {
      const size_t cbase = (size_t)bh * NCHK * 4096;
#pragma unroll
      for (int i = 0; i < 8; ++i) { const int idx = tid + i * 256, m = idx >> 9, r = (idx >> 3) & 63, c8 = idx & 7; st[i] = *(const h8*)(mats[m] + cbase + r * 64 + c8 * 8); }
#pragma unroll
      for (int mt = 0; mt < 4; ++mt) un[mt] = *(const h4*)(uT + cbase + (e0 + cl) * 64 + mt * 16 + q * 4);
      __syncthreads();
#pragma unroll
      for (int i = 0; i < 8; ++i) { const int idx = tid + i * 256, m = idx >> 9, r = (idx >> 3) & 63, c8 = idx & 7; *(h8*)(lbuf + m * E1_MAT + r * 72 + c8 * 8) = st[i]; }
      __syncthreads();
    }
    for (int c = 0; c < NCHK; ++c) {
      const hf* L = lbuf + (c & 1) * 4 * E1_MAT;
      const hf* Lw = L, *Lq = L + E1_MAT, *Li = L + 2 * E1_MAT, *Lk = L + 3 * E1_MAT;
      h4 uc[4];
#pragma unroll
      for (int mt = 0; mt < 4; ++mt) uc[mt] = un[mt];
      if (c + 1 < NCHK) {
        const size_t cb2 = ((size_t)bh * NCHK + c + 1) * 4096;
#pragma unroll
        for (int i = 0; i < 8; ++i) { const int idx = tid + i * 256, m = idx >> 9, r = (idx >> 3) & 63, c8 = idx & 7; st[i] = *(const h8*)(mats[m] + cb2 + r * 64 + c8 * 8); }
#pragma unroll
        for (int mt = 0; mt < 4; ++mt) un[mt] = *(const h4*)(uT + cb2 + (e0 + cl) * 64 + mt * 16 + q * 4);
      }
      const float egl = eg[bh * NCHK + c];
      h8 Sb[2]; Sb[0] = cvt_f4f4(S[0], S[1]); Sb[1] = cvt_f4f4(S[2], S[3]);
      f4 vn[4];
#pragma unroll
      for (int mt = 0; mt < 4; ++mt) {
        f4 a = f4{0, 0, 0, 0};
#pragma unroll
        for (int ks = 0; ks < 2; ++ks) a = mfma16(permload(Lw + (mt * 16 + cl) * 72 + ks * 32, q), Sb[ks], a);
#pragma unroll
        for (int r = 0; r < 4; ++r) vn[mt][r] = (float)uc[mt][r] - a[r];
      }
      h8 Vb[2]; Vb[0] = cvt_f4f4(vn[0], vn[1]); Vb[1] = cvt_f4f4(vn[2], vn[3]);
#pragma unroll
      for (int mt = 0; mt < 4; ++mt) {
        f4 o = f4{0, 0, 0, 0};
#pragma unroll
        for (int ks = 0; ks < 2; ++ks) {
          o = mfma16(permload(Lq + (mt * 16 + cl) * 72 + ks * 32, q), Sb[ks], o);
          o = mfma16(permload(Li + (mt * 16 + cl) * 72 + ks * 32, q), Vb[ks], o);
        }
#pragma unroll
        for (int r = 0; r < 4; ++r) ob[((size_t)b * SEQ + c * 64 + mt * 16 + q * 4 + r) * 512 + h * 64 + e0 + cl] = (hf)o[r];
      }
#pragma unroll
      for (int mt = 0; mt < 4; ++mt) {
        f4 sacc = S[mt] * egl;
#pragma unroll
        for (int ks = 0; ks < 2; ++ks) sacc = mfma16(permload(Lk + (mt * 16 + cl) * 72 + ks * 32, q), Vb[ks], sacc);
        S[mt] = sacc;
      }
      if (c + 1 < NCHK) {
        hf* Ln = lbuf + ((c + 1) & 1) * 4 * E1_MAT;
#pragma unroll
        for (int i = 0; i < 8; ++i) { const int idx = tid + i * 256, m = idx >> 9, r = (idx >> 3) & 63, c8 = idx & 7; *(h8*)(Ln + m * E1_MAT + r * 72 + c8 * 8) = st[i]; }
      }
      __syncthreads();
    }
    drain_stores();
    __syncthreads();
    if (tid == 0) { fence_release_agent(); add_relaxed_agent((unsigned*)(p.ws + O_CNT) + 48, 1u); }
  }
}

DI void obnorm_pass(const Params& p) {
  hf* ob = (hf*)(p.ws + O_OB); const hf* P3 = (const hf*)(p.ws + O_P3);
  const int lane = get_tid() & 63, wave = get_tid() >> 6;
  for (int row = blockIdx.x * 4 + wave; row < NTOK; row += gridDim.x * 4) {
    h8 v = *(const h8*)(ob + (size_t)row * 512 + lane * 8);
    h8 z = *(const h8*)(P3 + (size_t)row * 512 + lane * 8);
    float f[8], ss = 0.f;
#pragma unroll
    for (int e = 0; e < 8; ++e) { f[e] = (float)v[e]; ss += f[e] * f[e]; }
    ss += __shfl_xor(ss, 1); ss += __shfl_xor(ss, 2); ss += __shfl_xor(ss, 4);
    const float rstd = rsqrtf(ss * (1.0f / 64.0f) + EPSN);
    h8 o;
#pragma unroll
    for (int e = 0; e < 8; ++e) o[e] = (hf)(f[e] * rstd * p.norm_b_w[(lane & 7) * 8 + e] * siluf_((float)z[e]));
    *(h8*)(ob + (size_t)row * 512 + lane * 8) = o;
  }
}

constexpr int SELN = TOPK + 64;
constexpr int CAPC = 128;
constexpr int E2_WAVE_LDS = SELN * 4 + SELN * 8 * 4 + 256 * 4 + CAPC * 8;
DI int bin_of(float v, float vmin, float sc) { int bq = (int)((v - vmin) * sc); return bq > 255 ? 255 : (bq < 0 ? 0 : bq); }
DI void attn_token(const Params& p, int b, int t, float* srow, int* sel, float* Sb, hf* Vt1, int lane, bool dry) {
  unsigned* hist = (unsigned*)(Sb + SELN * 8); unsigned* candk = hist + 256; int* candi = (int*)(candk + CAPC);
  hf* P1 = (hf*)(p.ws + O_P1);
#ifndef EMU
  asm volatile("" : "+v"(lane));
#endif
  const int q = lane >> 4, cl = lane & 15;
  const int n = t + 1;
  int cnt;
  for (int rep_ = 0; rep_ < REP_SEL; ++rep_) {
  if (n <= TOPK) {
    cnt = n;
    for (int i = lane; i < SELN; i += 64) sel[i] = (i < n) ? i : 0;
  } else {
    cnt = TOPK;
    float val[SEQ / 64];
    {
      const hf* pb = (const hf*)srow + lane;
#pragma unroll
      for (int jg = 0; jg < SEQ / 64 / 8; ++jg) {
#ifndef EMU
        asm volatile("" : "+v"(pb));
#endif
#pragma unroll
        for (int jj = 0; jj < 8; ++jj) { const int j = jg * 8 + jj; const float v = (float)pb[jj * 64]; val[j] = (j * 64 + lane < n) ? v : -INFINITY; }
        pb += 512;
      }
    }
    float vmin = INFINITY, vmax = -INFINITY;
#pragma unroll
    for (int j = 0; j < SEQ / 64; ++j) { vmax = fmaxf(vmax, val[j]); vmin = fminf(vmin, (j * 64 + lane < n) ? val[j] : INFINITY); }
#pragma unroll
    for (int m = 32; m >= 1; m >>= 1) { vmax = fmaxf(vmax, __shfl_xor(vmax, m)); vmin = fminf(vmin, __shfl_xor(vmin, m)); }
    const float bscale = 255.99f / (vmax - vmin);
    for (int i = lane; i < 256; i += 64) hist[i] = 0u;
    wave_sync();
#pragma unroll
    for (int j = 0; j < SEQ / 64; ++j) { if (j * 64 + lane < n) atomicAdd(&hist[bin_of(val[j], vmin, bscale)], 1u); }
    wave_sync();
    int tb, ca, nc;
    {
      const unsigned h0 = hist[4 * lane], h1 = hist[4 * lane + 1], h2 = hist[4 * lane + 2], h3 = hist[4 * lane + 3];
      const int sL = (int)(h0 + h1 + h2 + h3);
      int tt = sL;
#pragma unroll
      for (int d = 1; d < 64; d <<= 1) { const int y = __shfl(tt, lane + d); if (lane + d < 64) tt += y; }
      const int above = tt - sL;
      const int c3 = above + (int)h3, c2 = c3 + (int)h2, c1 = c2 + (int)h1, c0 = c1 + (int)h0;
      int tb_ = -1, ca_ = 0, nc_ = 0;
      if (above < TOPK && c0 >= TOPK) {
        if (c3 >= TOPK) { tb_ = 4 * lane + 3; ca_ = above; nc_ = (int)h3; }
        else if (c2 >= TOPK) { tb_ = 4 * lane + 2; ca_ = c3; nc_ = (int)h2; }
        else if (c1 >= TOPK) { tb_ = 4 * lane + 1; ca_ = c2; nc_ = (int)h1; }
        else { tb_ = 4 * lane; ca_ = c1; nc_ = (int)h0; }
      }
      const unsigned long long bm = __ballot(tb_ >= 0);
      const int src = bm ? (int)__builtin_ctzll(bm) : 0;
      tb = __shfl(tb_, src); ca = __shfl(ca_, src); nc = __shfl(nc_, src);
      if (bm == 0ull) nc = CAPC + 1;
    }
    const unsigned long long lt = (lane == 0) ? 0ull : (~0ull >> (64 - lane));
    if (nc <= CAPC) {
      int base_gt = 0, base_c = 0;
#pragma unroll
      for (int j = 0; j < SEQ / 64; ++j) {
        const bool valid = j * 64 + lane < n;
        const int bn = valid ? bin_of(val[j], vmin, bscale) : -1;
        const bool mg = bn > tb, me = bn == tb;
        const unsigned long long bg = __ballot(mg), be = __ballot(me);
        if (mg) sel[base_gt + __popcll(bg & lt)] = j * 64 + lane;
        if (me) { const int pos = base_c + __popcll(be & lt); candk[pos] = f2ord(val[j]); candi[pos] = j * 64 + lane; }
        base_gt += __popcll(bg); base_c += __popcll(be);
      }
      wave_sync();
      const int need = TOPK - ca;
      int base = ca;
#pragma unroll
      for (int hb = 0; hb < CAPC / 64; ++hb) {
        const int my = hb * 64 + lane;
        bool pick = false; int myi = 0;
        if (my < nc) {
          const unsigned mk = candk[my]; myi = candi[my];
          int rank = 0;
          for (int c2 = 0; c2 < nc; ++c2) { const unsigned ok = candk[c2]; const int oi = candi[c2]; rank += (ok > mk || (ok == mk && oi < myi)) ? 1 : 0; }
          pick = rank < need;
        }
        const unsigned long long bp = __ballot(pick);
        if (pick) sel[base + __popcll(bp & lt)] = myi;
        base += __popcll(bp);
      }
    } else {
      unsigned T = 0;
      for (int bit = 31; bit >= 0; --bit) {
        const unsigned cand = T | (1u << bit);
        int cl_ = 0;
#pragma unroll
        for (int j = 0; j < SEQ / 64; ++j) cl_ += (f2ord(val[j]) >= cand) ? 1 : 0;
        const int tot = wave_sum_i(cl_);
        if (tot >= TOPK) T = cand;
        if (tot == TOPK) { T = cand - 1u; break; }
      }
      int cgt = 0;
#pragma unroll
      for (int j = 0; j < SEQ / 64; ++j) cgt += (f2ord(val[j]) > T) ? 1 : 0;
      cgt = wave_sum_i(cgt);
      int base_gt = 0, base_eq = cgt;
#pragma unroll
      for (int j = 0; j < SEQ / 64; ++j) {
        const unsigned kj = f2ord(val[j]);
        const bool mg = kj > T, me = kj == T;
        const unsigned long long bg = __ballot(mg), be = __ballot(me);
        if (mg) sel[base_gt + __popcll(bg & lt)] = j * 64 + lane;
        if (me) { int pos = base_eq + __popcll(be & lt); if (pos < TOPK) sel[pos] = j * 64 + lane; }
        base_gt += __popcll(bg); base_eq += __popcll(be);
      }
    }
    sel[TOPK + lane] = 0;
  }
  wave_sync();
  }
  const int ng = (cnt + 63) / 64;
  const size_t trow = (size_t)b * SEQ + t;
  const hf* kvb = P1 + (size_t)b * SEQ * LP1;
  const int k8 = lane >> 3, dch = lane & 7;
  h8 vc[8], vn[8];
#pragma unroll
  for (int j = 0; j < 4; ++j) { const hf* vr = kvb + (size_t)sel[j * 8 + k8] * LP1 + C_VA + dch * 8; vc[j] = *(const h8*)vr; vc[4 + j] = *(const h8*)(vr + 64); }
  hf* P16 = (hf*)Sb;
  hf* Vt = (hf*)Sb + 8 * SELN;
  {
    constexpr int NG = TOPK / 64;
    const h8 z8 = h8{0, 0, 0, 0, 0, 0, 0, 0};
    h8 qb[4];
#pragma unroll
    for (int s = 0; s < 4; ++s) {
      const h8 v = *(const h8*)(P1 + trow * LP1 + C_QA + (cl & 7) * 64 + 32 * (s & 1) + 8 * q);
      qb[s] = (cl < 8 && (cl >> 2) == (s >> 1)) ? v : z8;
    }
    f4 S[NG * 4];
    h8 kc[4][4], kn[4][4];
#pragma unroll
    for (int u = 0; u < 4; ++u) { const hf* kr = kvb + (size_t)sel[u * 16 + cl] * LP1 + C_KA + 8 * q;
#pragma unroll
      for (int s = 0; s < 4; ++s) kc[u][s] = *(const h8*)(kr + 32 * s); }
#pragma unroll
    for (int gg = 0; gg < NG; ++gg) {
      if (gg < ng) {
        if (gg + 1 < NG) {
          const int g2 = (gg + 1 < ng) ? gg + 1 : gg;
#pragma unroll
          for (int u = 0; u < 4; ++u) { const hf* kr = kvb + (size_t)sel[g2 * 64 + u * 16 + cl] * LP1 + C_KA + 8 * q;
#pragma unroll
            for (int s = 0; s < 4; ++s) kn[u][s] = *(const h8*)(kr + 32 * s); }
        }
#pragma unroll
        for (int u = 0; u < 4; ++u) {
          f4 acc = f4{0, 0, 0, 0};
#pragma unroll
          for (int s = 0; s < 4; ++s) acc = mfma16(kc[u][s], qb[s], acc);
#pragma unroll
          for (int r = 0; r < 4; ++r) if (gg * 64 + u * 16 + 4 * q + r >= cnt) acc[r] = -INFINITY;
          S[gg * 4 + u] = acc;
        }
        if (gg + 1 < NG) {
#pragma unroll
          for (int u = 0; u < 4; ++u)
#pragma unroll
            for (int s = 0; s < 4; ++s) kc[u][s] = kn[u][s];
        }
      } else {
#pragma unroll
        for (int u = 0; u < 4; ++u) S[gg * 4 + u] = f4{-INFINITY, -INFINITY, -INFINITY, -INFINITY};
      }
    }
    float mx = -INFINITY;
#pragma unroll
    for (int j = 0; j < NG * 4; ++j)
#pragma unroll
      for (int r = 0; r < 4; ++r) mx = fmaxf(mx, S[j][r]);
    mx = fmaxf(mx, __shfl_xor(mx, 16)); mx = fmaxf(mx, __shfl_xor(mx, 32));
    float sm = 0.f;
#pragma unroll
    for (int j = 0; j < NG * 4; ++j)
#pragma unroll
      for (int r = 0; r < 4; ++r) { const float e = __expf(S[j][r] - mx); S[j][r] = e; sm += e; }
    sm += __shfl_xor(sm, 16); sm += __shfl_xor(sm, 32);
    const float inv = 1.0f / sm;
    if (cl < 8) {
#pragma unroll
      for (int j = 0; j < NG * 4; ++j) if (j < ng * 4) {
        h4 pv; pv[0] = (hf)(S[j][0] * inv); pv[1] = (hf)(S[j][1] * inv); pv[2] = (hf)(S[j][2] * inv); pv[3] = (hf)(S[j][3] * inv);
        *(h4*)(P16 + cl * SELN + j * 16 + 4 * q) = pv;
      }
    }
  }
  wave_sync();
  {
    f4 O[2][4];
#pragma unroll
    for (int g = 0; g < 2; ++g)
#pragma unroll
      for (int nt = 0; nt < 4; ++nt) O[g][nt] = f4{0, 0, 0, 0};
    const int nst = ng * 2;
    for (int st = 0; st < nst; ++st) {
      {
        const int st2 = (st + 1 < nst) ? st + 1 : st;
#pragma unroll
        for (int j = 0; j < 4; ++j) { const hf* vr = kvb + (size_t)sel[st2 * 32 + j * 8 + k8] * LP1 + C_VA + dch * 8; vn[j] = *(const h8*)vr; vn[4 + j] = *(const h8*)(vr + 64); }
      }
      wave_sync();
#pragma unroll
      for (int j = 0; j < 4; ++j) { *(h8*)(Vt + (j * 8 + k8) * 72 + dch * 8) = vc[j]; *(h8*)(Vt1 + (j * 8 + k8) * 72 + dch * 8) = vc[4 + j]; }
      wave_sync();
#pragma unroll
      for (int g = 0; g < 2; ++g) {
        h8 pa;
        if (cl < 4) pa = *(const h8*)(P16 + (g * 4 + cl) * SELN + st * 32 + q * 8); else pa = h8{0, 0, 0, 0, 0, 0, 0, 0};
        const hf* vt = g ? Vt1 : Vt;
#pragma unroll
        for (int nt = 0; nt < 4; ++nt) {
          const hf* tp = vt + (q * 8 + (cl >> 2)) * 72 + nt * 16 + (cl & 3) * 4;
          const h4 lo = lds_read_tr16(tp), hi = lds_read_tr16(tp + 4 * 72);
          O[g][nt] = mfma16(pa, cat44(lo, hi), O[g][nt]);
        }
      }
#pragma unroll
      for (int j = 0; j < 8; ++j) vc[j] = vn[j];
    }
    if (q == 0) {
#pragma unroll
      for (int g = 0; g < 2; ++g)
#pragma unroll
        for (int nt = 0; nt < 4; ++nt)
#pragma unroll
          for (int r = 0; r < 4; ++r) {
            hf* dst = dry ? ((hf*)srow + (g * 4 + r) * 64 + nt * 16 + cl) : (P1 + trow * LP1 + C_QA + (g * 4 + r) * 64 + nt * 16 + cl);
            *dst = (hf)O[g][nt][r];
          }
    }
  }
  wave_sync();
}

DI void phase_E2(const Params& p, char* smem, bool dry) {
  const hf* P1 = (const hf*)(p.ws + O_P1); const float* aux = (const float*)(p.ws + O_AUX);
  int* cnt = (int*)(p.ws + O_CNT) + (dry ? 1 : 0);
  const int tid = get_tid(), lane = tid & 63, wave = tid >> 6;
  float* scr = (float*)(p.ws + O_SCR) + (size_t)blockIdx.x * QBT * SEQ;
  int* item_s = (int*)smem;
  char* wl = smem + 16 + wave * E2_WAVE_LDS;
  int* sel = (int*)wl; float* Sb = (float*)(wl + SELN * 4);
  constexpr int NQB = SEQ / QBT;
#ifdef EMU
  const int xq = (int)blockIdx.x % BATCH;
#else
  const int xq = (int)(xcd_words(smem)[2] % (unsigned)BATCH);
#endif
  int dq = 0;
  for (;;) {
    __syncthreads();
    const int bq = (xq + dq) % BATCH;
    if (tid == 0) item_s[0] = atomicAdd(cnt + 2 * bq, 1);
    __syncthreads();
    const int item = item_s[0];
    if (item >= NQB) { if (++dq >= BATCH) break; continue; }
    const int b = bq, qb = NQB - 1 - item;
    int lane_i = lane;
#ifndef EMU
    asm volatile("" : "+v"(lane_i));
#endif
    const int q = lane_i >> 4, cl = lane_i & 15;
    const int tw0 = qb * QBT + wave * 4;
    h8 aq[4][2]; h8 wA01, wA23;
    {
      f4 wv[4];
#pragma unroll
      for (int i = 0; i < 4; ++i) {
        const size_t row = (size_t)b * SEQ + tw0 + i;
        const hf* qp = P1 + row * LP1 + C_QI + cl * 64 + q * 8;
        aq[i][0] = *(const h8*)qp; aq[i][1] = *(const h8*)(qp + 32);
        wv[i] = *(const f4*)(aux + row * 32 + q * 4);
      }
      const f4 z4 = f4{0, 0, 0, 0};
      wA01 = cvt_f4f4(cl == 0 ? wv[0] : z4, cl == 4 ? wv[1] : z4);
      wA23 = cvt_f4f4(cl == 8 ? wv[2] : z4, cl == 12 ? wv[3] : z4);
    }
    const int ngrp = (tw0 + 3) / 64 + 1;
    const int ngrp_blk = (qb * QBT + QBT - 1) / 64 + 1;
    hf* kst = (hf*)(smem + 16 + 4 * E2_WAVE_LDS);
    const int tid_s = get_tid();
    const int skey = tid_s >> 3, sch = tid_s & 7;
    const hf* ksrc = P1 + ((size_t)b * SEQ + skey) * LP1 + C_KI + sch * 8;
    hf* scr_q = (hf*)(scr + (size_t)(wave * 4 + q) * SEQ) + cl;
    h8 sr0 = *(const h8*)ksrc, sr1 = *(const h8*)(ksrc + (size_t)32 * LP1);
    *(h8*)(kst + skey * 72 + sch * 8) = sr0; *(h8*)(kst + (skey + 32) * 72 + sch * 8) = sr1;
    { const int g1 = ngrp_blk > 1 ? 1 : 0; sr0 = *(const h8*)(ksrc + (size_t)(g1 * 64) * LP1); sr1 = *(const h8*)(ksrc + (size_t)(g1 * 64 + 32) * LP1); }
    h8 sq0, sq1;
    { const int g2 = ngrp_blk > 2 ? 2 : ngrp_blk - 1; sq0 = *(const h8*)(ksrc + (size_t)(g2 * 64) * LP1); sq1 = *(const h8*)(ksrc + (size_t)(g2 * 64 + 32) * LP1); }
    __syncthreads();
    for (int grp = 0; grp < ngrp_blk; ++grp) {
      const hf* ks = kst + (grp & 1) * (64 * 72);
      if (grp < ngrp) {
#pragma unroll
        for (int u = 0; u < 4; ++u) {
          const h8 b0 = *(const h8*)(ks + (u * 16 + cl) * 72 + q * 8), b1 = *(const h8*)(ks + (u * 16 + cl) * 72 + 32 + q * 8);
          f4 c4[4];
#pragma unroll
          for (int i = 0; i < 4; ++i) { f4 t4 = f4{0, 0, 0, 0}; t4 = mfma16(aq[i][0], b0, t4); t4 = mfma16(aq[i][1], b1, t4); c4[i] = t4; }
          f4 sc = f4{0, 0, 0, 0}; sc = mfma16(wA01, relu8(cvt_f4f4(c4[0], c4[1])), sc); sc = mfma16(wA23, relu8(cvt_f4f4(c4[2], c4[3])), sc);
          scr_q[grp * 64 + u * 16] = (hf)sc[0];
        }
      }
      if (grp + 1 < ngrp_blk) {
        hf* kn = kst + ((grp + 1) & 1) * (64 * 72);
        *(h8*)(kn + skey * 72 + sch * 8) = sr0; *(h8*)(kn + (skey + 32) * 72 + sch * 8) = sr1;
        sr0 = sq0; sr1 = sq1;
        const int g3 = (grp + 3 < ngrp_blk) ? grp + 3 : ngrp_blk - 1;
        sq0 = *(const h8*)(ksrc + (size_t)(g3 * 64) * LP1); sq1 = *(const h8*)(ksrc + (size_t)(g3 * 64 + 32) * LP1);
      }
      __syncthreads();
    }
    gmem_wave_sync();
#pragma unroll 1
    for (int i = 0; i < 4; ++i) attn_token(p, b, tw0 + i, scr + (size_t)(wave * 4 + i) * SEQ, sel, Sb, kst + wave * (32 * 72), lane, dry);
  }
  if (!dry) {
    unsigned* e1done = (unsigned*)(p.ws + O_CNT) + 48;
    if (get_tid() == 0) {
      unsigned spins = 0;
      while (ld_relaxed_agent(e1done) < (unsigned)(BATCH * 8)) { spin_pause(); if (++spins > (1u << 26)) break; }
      fence_acquire_agent();
    }
    __syncthreads();
    obnorm_pass(p);
  }
}

DI void phase_F1(const Params& p, char* smem) {
  const hf* P1 = (const hf*)(p.ws + O_P1); const hf* ob = (const hf*)(p.ws + O_OB); const hf* P4 = (const hf*)(p.ws + O_P4);
  const hf* WpaT = (const hf*)(p.ws + O_WPA); const hf* WpbT = (const hf*)(p.ws + O_WPB);
  hf* merged = (hf*)(p.ws + O_MERGED);
  const int lane = get_tid() & 63, wave = get_tid() >> 6, wm = wave >> 1, wn = wave & 1, q = lane >> 4, cl = lane & 15;
  constexpr int NTN = DM / 128, NTM = NTOK / 128;
  TileSched ts = tile_begin(NTM, NTN, p.ws + O_BAR, xcd_words(smem)); int tm, tn;
  while (tile_next(ts, tm, tn)) {
    const int m0 = tm * 128, n0 = tn * 128;
    f4 a1[4][4], a2[4][4]; zero_acc<4>(a1); zero_acc<4>(a2);
    gemm_mainloop<128, 64>(a1, P1 + C_QA, LP1, WpaT, 512, 512, m0, n0, smem);
    gemm_mainloop<128, 64>(a2, ob, 512, WpbT, 512, 512, m0, n0, smem);
    hf* t1 = (hf*)smem; hf* t2 = t1 + 128 * TLD;
    __syncthreads();
#pragma unroll
    for (int mt = 0; mt < 4; ++mt)
#pragma unroll
      for (int nt = 0; nt < 4; ++nt)
#pragma unroll
        for (int r = 0; r < 4; ++r) {
          const int lrow = wm * 64 + mt * 16 + q * 4 + r, lcol = wn * 64 + nt * 16 + cl;
          t1[lrow * TLD + lcol] = (hf)a1[mt][nt][r]; t2[lrow * TLD + lcol] = (hf)a2[mt][nt][r];
        }
    __syncthreads();
    {
      const int tid = get_tid();
#pragma unroll
      for (int i = 0; i < 8; ++i) {
        const int idx = tid + i * 256, row = idx >> 4, ch = idx & 15;
        const size_t grow = (size_t)(m0 + row);
        const h8 v1 = *(const h8*)(t1 + row * TLD + ch * 8), v2 = *(const h8*)(t2 + row * TLD + ch * 8);
        const h8 sa = *(const h8*)(P4 + grow * LP4 + n0 + ch * 8), sb = *(const h8*)(P4 + grow * LP4 + DM + n0 + ch * 8);
        h8 o;
#pragma unroll
        for (int e = 0; e < 8; ++e) o[e] = (hf)((float)sa[e] * (float)v1[e] + (float)sb[e] * (float)v2[e]);
        *(h8*)(merged + pr32_off((int)grow, n0 + ch * 8, DM)) = o;
      }
    }
  }
}
DI void phase_F2(const Params& p, char* smem) {
  const hf* merged = (const hf*)(p.ws + O_MERGED); const hf* WoT = (const hf*)(p.ws + O_WO); const float* mod = (const float*)(p.ws + O_MOD);
  const int lane = get_tid() & 63, wave = get_tid() >> 6, wm = wave >> 1, wn = wave & 1, q = lane >> 4, cl = lane & 15;
  constexpr int CBM = 256, CMT = CBM / 32, NTN = DM / 128, NTM = NTOK / CBM;
  TileSched ts = tile_begin(NTM, NTN, p.ws + O_BAR, xcd_words(smem)); int tm, tn;
  while (tile_next(ts, tm, tn)) {
    const int m0 = tm * CBM, n0 = tn * 128;
    f4 acc[CMT][4]; zero_acc<CMT>(acc);
    gemm_mainloop<CBM, 32, true>(acc, merged, DM, WoT, DM, DM, m0, n0, smem);
    hf* t1 = (hf*)smem;
    __syncthreads();
#pragma unroll
    for (int mt = 0; mt < CMT; ++mt)
#pragma unroll
      for (int nt = 0; nt < 4; ++nt)
#pragma unroll
        for (int r = 0; r < 4; ++r) t1[(wm * (CBM / 2) + mt * 16 + q * 4 + r) * TLD + wn * 64 + nt * 16 + cl] = (hf)acc[mt][nt][r];
    __syncthreads();
    {
      const int tid = get_tid();
#pragma unroll
      for (int i = 0; i < CBM / 16; ++i) {
        const int idx = tid + i * 256, row = idx >> 4, ch = idx & 15;
        const size_t grow = (size_t)(m0 + row); const int b = (int)(grow / SEQ), col = n0 + ch * 8;
        const h8 y = *(const h8*)(t1 + row * TLD + ch * 8);
        const float* xp = p.x + grow * DM + col; const float* gp = mod + (size_t)b * 6 * DM + 2 * DM + col; hf* op = (hf*)(p.ws + O_H16) + grow * DM + col;
        const f4 x0 = *(const f4*)xp, x1 = *(const f4*)(xp + 4), g0 = *(const f4*)gp, g1 = *(const f4*)(gp + 4);
        h8 o;
#pragma unroll
        for (int e = 0; e < 4; ++e) { o[e] = (hf)(x0[e] + g0[e] * (float)y[e]); o[4 + e] = (hf)(x1[e] + g1[e] * (float)y[4 + e]); }
        *(h8*)op = o;
      }
    }
  }
}
DI float quant_row_store(const float (&v)[DM / 64], unsigned char* dst, int lane, int bias) {
  float mx = 0.f;
#pragma unroll
  for (int i = 0; i < DM / 64; ++i) mx = fmaxf(mx, fabsf(v[i]));
#pragma unroll
  for (int m = 32; m >= 1; m >>= 1) mx = fmaxf(mx, __shfl_xor(mx, m));
  const float sc = mx > 0.f ? mx * (1.0f / 127.0f) : 1.0f, inv = 1.0f / sc;
#pragma unroll
  for (int i = 0; i < DM / 256; ++i) {
    unsigned w = 0;
#pragma unroll
    for (int j = 0; j < 4; ++j) { int qv = (int)rintf(v[4 * i + j] * inv); qv = qv > 127 ? 127 : (qv < -127 ? -127 : qv); w |= ((unsigned)(qv + bias) & 255u) << (8 * j); }
    *(unsigned*)(dst + i * 256 + lane * 4) = w;
  }
  return sc;
}
template <int MODE> DI void quant4_row_store(const float (&v)[DM / 64], unsigned char* dst, int lane, float& sc_o, float& mn_o) {
  float mx = v[0], mn = v[0];
#pragma unroll
  for (int i = 1; i < DM / 64; ++i) { mx = fmaxf(mx, v[i]); mn = fminf(mn, v[i]); }
#pragma unroll
  for (int m = 32; m >= 1; m >>= 1) { mx = fmaxf(mx, __shfl_xor(mx, m)); mn = fminf(mn, __shfl_xor(mn, m)); }
  {
    float s1 = 0.f, s2 = 0.f;
#pragma unroll
    for (int i = 0; i < DM / 64; ++i) { s1 += v[i]; s2 += v[i] * v[i]; }
    s1 = wave_sum(s1); s2 = wave_sum(s2);
    const float mean = s1 * (1.0f / DM), sd = sqrtf(fmaxf(s2 * (1.0f / DM) - mean * mean, 0.f));
    mn = fmaxf(mn, mean - 2.514f * sd); mx = fminf(mx, mean + 2.514f * sd);
  }
  const float sc = mx > mn ? (mx - mn) * (1.0f / 15.0f) : 1.0f, inv = 1.0f / sc;
#pragma unroll
  for (int i = 0; i < DM / 256; ++i) {
    unsigned nq = 0;
#pragma unroll
    for (int j = 0; j < 4; ++j) { int qv = (int)rintf((v[4 * i + j] - mn) * inv); qv = qv > 15 ? 15 : (qv < 0 ? 0 : qv);
      if (MODE == 0) nq |= (unsigned)qv << (8 * j);
      else { const int t = 4 * (lane & 1) + j; nq |= (unsigned)qv << (4 * ((t & 1) * 4 + (t >> 1))); } }
    const unsigned pn = __shfl_xor(nq, 1);
    if ((lane & 1) == 0) *(unsigned*)(dst + (i * 32 + (lane >> 1)) * 4) = (MODE == 0) ? (nq | (pn << 4)) : (nq | pn);
  }
  sc_o = sc; mn_o = mn;
}
DI void phase_F3(const Params& p) {
  const int tid = get_tid(), lane = tid & 63, wave = tid >> 6;
  const float* mod = (const float*)(p.ws + O_MOD);
  unsigned char* u8 = (unsigned char*)(p.uv + UV_U8); unsigned char* v8 = (unsigned char*)(p.uv + UV_V8); unsigned char* n2q = (unsigned char*)(p.uv + UV_N2Q);
  float* su = (float*)(p.uv + UV_SU); float* sv = (float*)(p.uv + UV_SV); float* sn = (float*)(p.uv + UV_SN);
  for (int row = blockIdx.x * 4 + wave; row < NTOK + 2 * NEXP; row += gridDim.x * 4) {
    float v[DM / 64];
    if (row < NTOK) {
      const hf* xr = (const hf*)(p.ws + O_H16) + (size_t)row * DM; const int b = row / SEQ; float ss = 0.f;
#pragma unroll
      for (int i = 0; i < DM / 256; ++i) { const h4 t4 = *(const h4*)(xr + i * 256 + lane * 4); f4 t = {(float)t4[0], (float)t4[1], (float)t4[2], (float)t4[3]}; v[4 * i] = t[0]; v[4 * i + 1] = t[1]; v[4 * i + 2] = t[2]; v[4 * i + 3] = t[3]; ss += t[0] * t[0] + t[1] * t[1] + t[2] * t[2] + t[3] * t[3]; }
      ss = wave_sum(ss);
      const float rstd = rsqrtf(ss * (1.0f / DM) + EPSN);
      const float* mb = mod + (size_t)b * 6 * DM;
#pragma unroll
      for (int i = 0; i < DM / 256; ++i) {
        const int d = i * 256 + lane * 4;
#pragma unroll
        for (int j = 0; j < 4; ++j) v[4 * i + j] = v[4 * i + j] * rstd * (1.0f + mb[4 * DM + d + j]) + mb[3 * DM + d + j];
      }
      const float sc = quant_row_store(v, n2q + (size_t)row * DM, lane, 0);
      if (lane == 0) sn[row] = sc;
    } else {
      const bool isu = row < NTOK + NEXP; const int e = isu ? row - NTOK : row - NTOK - NEXP;
      const float* xr = (isu ? p.pu : p.pv) + (size_t)e * DM;
#pragma unroll
      for (int i = 0; i < DM / 256; ++i) { f4 t = *(const f4*)(xr + i * 256 + lane * 4); v[4 * i] = t[0]; v[4 * i + 1] = t[1]; v[4 * i + 2] = t[2]; v[4 * i + 3] = t[3]; }
      float sc, mn;
      if (isu) { quant4_row_store<0>(v, u8 + (size_t)e * (DM / 2), lane, sc, mn); if (lane == 0) { su[2 * e] = sc; su[2 * e + 1] = mn; } }
      else { quant4_row_store<1>(v, v8 + (size_t)e * (DM / 2), lane, sc, mn); if (lane == 0) { sv[2 * e] = sc; sv[2 * e + 1] = mn; } }
    }
  }
}
DI void cmpx_desc(unsigned& hi, unsigned& lo) { const unsigned x = hi, y = lo; hi = x > y ? x : y; lo = x > y ? y : x; }
DI void bitonic_merge16(unsigned (&v)[16]) {
#pragma unroll
  for (int j = 8; j > 0; j >>= 1)
#pragma unroll
    for (int i = 0; i < 16; ++i) { const int l = i ^ j; if (l > i) cmpx_desc(v[i], v[l]); }
}
DI void bitonic_sort16(unsigned (&v)[16]) {
#pragma unroll
  for (int k = 2; k <= 16; k <<= 1)
#pragma unroll
    for (int j = k >> 1; j > 0; j >>= 1)
#pragma unroll
      for (int i = 0; i < 16; ++i) { const int l = i ^ j; if (l > i) { if ((i & k) == 0) cmpx_desc(v[i], v[l]); else cmpx_desc(v[l], v[i]); } }
}
DI void phase_G1(const Params& p, char* smem) {
  const hf* subk = (const hf*)(p.ws + O_SUBK);
  int* experts = (int*)(p.ws + O_P4); float* gates = (float*)(p.ws + O_P4 + (size_t)NTOK * 128 * 4);
  const float* sn_ = (const float*)(p.uv + UV_SN); const float* sq8 = (const float*)(p.ws + O_SQ8);
  const int tid = get_tid(), lane = tid & 63, wave = tid >> 6, wm = wave >> 1, wn = wave & 1, q = lane >> 4, cl = lane & 15;
  constexpr int NTM = NTOK / 128;
  hf* qt = (hf*)smem;
  float* sb = (float*)smem;
  unsigned* tl = (unsigned*)(smem + 2 * 64 * 129 * 4);
  TileSched ts = tile_begin(NTM, 8, p.ws + O_BAR, xcd_words(smem)); int tm, tn;
  while (tile_next(ts, tm, tn)) {
    const int hh = tn, mbase = tm * 128, n0 = hh * 128;
    f4 acc[4][4]; zero_acc<4>(acc);
    gemm_mainloop_r3<128, true>(acc, (const hf*)(p.uv + UV_N2Q), DM / 2, (const hf*)(p.ws + O_WQ8), DM / 2, DM / 2, mbase, n0, smem);
    for (int half = 0; half < 2; ++half) {
    const int m0 = mbase + half * 64;
    __syncthreads();
    if (wm == half) {
#pragma unroll
      for (int mt = 0; mt < 4; ++mt)
#pragma unroll
        for (int nt = 0; nt < 4; ++nt)
#pragma unroll
          for (int r = 0; r < 4; ++r) { const int row = mt * 16 + q * 4 + r, col = wn * 64 + nt * 16 + cl; const i4 ai = __builtin_bit_cast(i4, acc[mt][nt]);
            qt[row * 136 + col] = (hf)((float)ai[r] * (sn_[m0 + row] * sq8[n0 + col])); }
    }
    __syncthreads();
    const int pp = wave & 1, mh = wave >> 1;
    h8 af[2][2];
#pragma unroll
    for (int mt = 0; mt < 2; ++mt)
#pragma unroll
      for (int ks = 0; ks < 2; ++ks) af[mt][ks] = *(const h8*)(qt + (mh * 32 + mt * 16 + cl) * 136 + pp * 64 + ks * 32 + q * 8);
    __syncthreads();
    const hf* skp = subk + (size_t)(hh * 2 + pp) * 128 * 64;
#pragma unroll
    for (int nt = 0; nt < 8; ++nt) {
      h8 b0 = *(const h8*)(skp + (nt * 16 + cl) * 64 + q * 8), b1 = *(const h8*)(skp + (nt * 16 + cl) * 64 + 32 + q * 8);
#pragma unroll
      for (int mt = 0; mt < 2; ++mt) {
        f4 s = f4{0, 0, 0, 0};
        s = mfma16(af[mt][0], b0, s); s = mfma16(af[mt][1], b1, s);
#pragma unroll
        for (int r = 0; r < 4; ++r) sb[(pp * 64 + mh * 32 + mt * 16 + q * 4 + r) * 129 + nt * 16 + cl] = s[r];
      }
    }
    __syncthreads();
    {
      const int rp = tid >> 1, sub = tid & 1;
      const float* sr = sb + rp * 129 + sub * 64;
      unsigned top[16];
#pragma unroll
      for (int g = 0; g < 4; ++g) {
        unsigned v[16];
#pragma unroll
        for (int i = 0; i < 16; ++i) { const int n = sub * 64 + g * 16 + i; v[i] = (f2ord(sr[g * 16 + i]) & ~127u) | (unsigned)(127 - n); }
        bitonic_sort16(v);
        if (g == 0) {
#pragma unroll
          for (int i = 0; i < 16; ++i) top[i] = v[i];
        } else {
#pragma unroll
          for (int i = 0; i < 16; ++i) top[i] = top[i] > v[15 - i] ? top[i] : v[15 - i];
          bitonic_merge16(top);
        }
      }
      unsigned oth[16];
#pragma unroll
      for (int i = 0; i < 16; ++i) oth[i] = __shfl_xor(top[i], 1);
#pragma unroll
      for (int i = 0; i < 16; ++i) top[i] = top[i] > oth[15 - i] ? top[i] : oth[15 - i];
      bitonic_merge16(top);
      if (sub == 0) {
#pragma unroll
        for (int i = 0; i < 16; ++i) tl[rp * 16 + i] = top[i];
      }
    }
    __syncthreads();
    {
      const int tid2 = get_tid();
      const int rp = tid2 >> 2, sub = tid2 & 3;
      constexpr unsigned long long PT0 = 0x7060504030201000ull;
      constexpr unsigned long long PT1 = 0xf0e0d0c0b0a09080ull;
      constexpr unsigned long long PT2 = 0x7161514131211101ull;
      constexpr unsigned long long PT3 = 0x2313034232221202ull;
      constexpr unsigned long long PT4 = 0x1606150524140433ull;
      constexpr unsigned long long PT5 = 0x0d0c0b0a09081707ull;
      constexpr unsigned long long PT6 = 0xffffffffffff0f0eull;
      constexpr unsigned long long PT7 = 0xffffffffffffffffull;
      const unsigned long long wlo = sub == 0 ? PT0 : sub == 1 ? PT2 : sub == 2 ? PT4 : PT6;
      const unsigned long long whi = sub == 0 ? PT1 : sub == 1 ? PT3 : sub == 2 ? PT5 : PT7;
      const unsigned* t1 = tl + rp * 16; const unsigned* t2 = tl + (64 + rp) * 16;
      unsigned top[16];
#pragma unroll
      for (int s = 0; s < 16; ++s) {
        const unsigned e = (unsigned)(((s < 8 ? wlo : whi) >> (8 * (s & 7))) & 255ull);
        const int i = e & 15, j = (e >> 4) & 15;
        const float v = ord2f(t1[i] & ~127u) + ord2f(t2[j] & ~127u);
        top[s] = (e == 255u) ? 0u : ((f2ord(v) & ~255u) | (unsigned)(255 - (i * 16 + j)));
      }
      bitonic_sort16(top);
#pragma unroll
      for (int x = 1; x <= 2; x <<= 1) {
        unsigned oth[16];
#pragma unroll
        for (int i = 0; i < 16; ++i) oth[i] = __shfl_xor(top[i], x);
#pragma unroll
        for (int i = 0; i < 16; ++i) top[i] = top[i] > oth[15 - i] ? top[i] : oth[15 - i];
        bitonic_merge16(top);
      }
      float vals[16], sm = 0.f;
#pragma unroll
      for (int s = 0; s < 16; ++s) vals[s] = ord2f(top[s] & ~255u);
      const float mx = vals[0];
#pragma unroll
      for (int s = 0; s < 16; ++s) { vals[s] = __expf(vals[s] - mx); sm += vals[s]; }
      const float inv = 1.0f / sm;
      i4 eo; f4 go;
#pragma unroll
      for (int t = 0; t < 4; ++t) {
        const unsigned k = sub == 0 ? top[t] : sub == 1 ? top[4 + t] : sub == 2 ? top[8 + t] : top[12 + t];
        const float g = sub == 0 ? vals[t] : sub == 1 ? vals[4 + t] : sub == 2 ? vals[8 + t] : vals[12 + t];
        const int ci = 255 - (int)(k & 255u);
        const int e1 = 127 - (int)(t1[ci >> 4] & 127u), e2 = 127 - (int)(t2[ci & 15] & 127u);
        eo[t] = e1 * 128 + e2; go[t] = g * inv;
      }
      const size_t ob_ = ((size_t)(m0 + rp) * 8 + hh) * 16 + sub * 4;
      *(i4*)(experts + ob_) = eo; *(f4*)(gates + ob_) = go;
    }
  }
  }
}
#ifdef EMU
DI h2 pkfma(h2 a, h2 b, h2 c) { return a * b + c; }
#else
DI h2 pkfma(h2 a, h2 b, h2 c) { return __builtin_elementwise_fma(a, b, c); }
#endif
constexpr int VPL = DM / 64;
constexpr int G2_WAVE_LDS = 128 * 8 + 128 * 4;
DI void phase_G2(const Params& p, char* smem, bool dry) {
  const unsigned char* u8 = (const unsigned char*)(p.uv + UV_U8); const unsigned char* v8 = (const unsigned char*)(p.uv + UV_V8); const unsigned char* n2q = (const unsigned char*)(p.uv + UV_N2Q);
  const float* su = (const float*)(p.uv + UV_SU); const float* sv = (const float*)(p.uv + UV_SV); const float* sn = (const float*)(p.uv + UV_SN);
  const int* experts = (const int*)(p.ws + O_P4); const float* gates = (const float*)(p.ws + O_P4 + (size_t)NTOK * 128 * 4);
  const float* mod = (const float*)(p.ws + O_MOD);
  const int tid = get_tid(), lane = tid & 63, wave = tid >> 6, half = lane >> 5, li = lane & 31;
  char* wl = smem + wave * G2_WAVE_LDS;
  unsigned* coef2 = (unsigned*)wl; int* eix = (int*)(wl + 1024);
  constexpr int DW = VPL / 4;
  const int tok0 = blockIdx.x * 4 + wave;
  int e0n = 0, e1n = 0; float sntn = 0.f; int xqn[2 * DW];
  { const int tc = tok0 < NTOK ? tok0 : NTOK - 1;
    e0n = experts[(size_t)tc * 128 + lane]; e1n = experts[(size_t)tc * 128 + 64 + lane]; sntn = sn[tc];
#pragma unroll
    for (int w = 0; w < 2 * DW; ++w) xqn[w] = ((const int*)(n2q + (size_t)tc * DM + li * (8 * DW)))[w]; }
  for (int tok = tok0; tok < NTOK; tok += gridDim.x * 4) {
    const int b = tok / SEQ;
    wave_sync();
    eix[lane] = e0n; eix[64 + lane] = e1n;
    const float snt = sntn;
    int xq[2 * DW];
#pragma unroll
    for (int w = 0; w < 2 * DW; ++w) xq[w] = xqn[w];
    int sxq = 0;
#pragma unroll
    for (int w = 0; w < 2 * DW; ++w) sxq = __builtin_amdgcn_sdot4(xq[w], 0x01010101, sxq, false);
#pragma unroll
    for (int m = 16; m >= 1; m >>= 1) sxq += __shfl_xor(sxq, m);
    const float fsx = (float)sxq;
    wave_sync();
    float cmn = 0.f;
    for (int eb = 0; eb < 2; ++eb) {
      int part[32];
      const int em = eb * 64 + lane; const int eim = eix[em];
      const float su_e = su[2 * eim], mu_e = su[2 * eim + 1], sv_e = sv[2 * eim], mv_e = sv[2 * eim + 1], g_e = gates[(size_t)tok * 128 + em];
#pragma unroll
      for (int e = 0; e < 32; ++e) {
        const unsigned* ur = (const unsigned*)(u8 + (size_t)eix[eb * 64 + half * 32 + e] * (DM / 2) + li * (4 * DW));
        int acc = 0;
#pragma unroll
        for (int k = 0; k < DW; ++k) { const unsigned w = ur[k];
          acc = __builtin_amdgcn_sdot4((int)(w & 0x0F0F0F0Fu), xq[2 * k], acc, false);
          acc = __builtin_amdgcn_sdot4((int)((w >> 4) & 0x0F0F0F0Fu), xq[2 * k + 1], acc, false); }
        part[e] = acc;
      }
      const bool b4 = (lane & 16) != 0, b3 = (lane & 8) != 0, b2 = (lane & 4) != 0, b1 = (lane & 2) != 0, b0 = (lane & 1) != 0;
      int r16[16], r8[8], r4[4], r2[2];
#pragma unroll
      for (int i = 0; i < 16; ++i) { const int snd = b4 ? part[i] : part[16 + i], kp = b4 ? part[16 + i] : part[i]; r16[i] = kp + __shfl_xor(snd, 16); }
#pragma unroll
      for (int i = 0; i < 8; ++i) { const int snd = b3 ? r16[i] : r16[8 + i], kp = b3 ? r16[8 + i] : r16[i]; r8[i] = kp + __shfl_xor(snd, 8); }
#pragma unroll
      for (int i = 0; i < 4; ++i) { const int snd = b2 ? r8[i] : r8[4 + i], kp = b2 ? r8[4 + i] : r8[i]; r4[i] = kp + __shfl_xor(snd, 4); }
#pragma unroll
      for (int i = 0; i < 2; ++i) { const int snd = b1 ? r4[i] : r4[2 + i], kp = b1 ? r4[2 + i] : r4[i]; r2[i] = kp + __shfl_xor(snd, 2); }
      const int r1 = (b0 ? r2[1] : r2[0]) + __shfl_xor(b0 ? r2[0] : r2[1], 1);
      { const float av = ((float)r1 * su_e + fsx * mu_e) * snt;
        const float cr = 0.5f * av * (1.0f + erff(av * 0.70710678118654752f)) * g_e, cs = cr * sv_e;
        cmn += cr * mv_e;
        const hf ca = (hf)(cs * 16384.0f), cb = (hf)(cs * 1024.0f);
        h2 pa = {ca, ca}, pb = {cb, cb};
        coef2[2 * em] = __builtin_bit_cast(unsigned, pa); coef2[2 * em + 1] = __builtin_bit_cast(unsigned, pb); }
    }
    wave_sync();
    { const int tn = tok + gridDim.x * 4; const int tc = tn < NTOK ? tn : NTOK - 1;
      e0n = experts[(size_t)tc * 128 + lane]; e1n = experts[(size_t)tc * 128 + 64 + lane]; sntn = sn[tc];
#pragma unroll
      for (int w = 0; w < 2 * DW; ++w) xqn[w] = ((const int*)(n2q + (size_t)tc * DM + li * (8 * DW)))[w]; }
    const int dbase = li * (8 * DW) + half * (4 * DW);
    float hres[VPL], mg[VPL];
#pragma unroll
    for (int i = 0; i < VPL; ++i) { hres[i] = (float)((const hf*)(p.ws + O_H16))[(size_t)tok * DM + dbase + i]; mg[i] = mod[(size_t)b * 6 * DM + 5 * DM + dbase + i]; }
    cmn = wave_sum(cmn);
    h2 ya[4 * DW];
#pragma unroll
    for (int i = 0; i < 4 * DW; ++i) ya[i] = (h2){(hf)0.f, (hf)0.f};
#pragma unroll 8
    for (int e = 0; e < 64; ++e) {
      const int row = 2 * e + half;
      const unsigned* vr = (const unsigned*)(v8 + (size_t)eix[row] * (DM / 2) + li * (4 * DW));
      const h2 ca = __builtin_bit_cast(h2, coef2[2 * row]), cb = __builtin_bit_cast(h2, coef2[2 * row + 1]);
#pragma unroll
      for (int k = 0; k < DW; ++k) { const unsigned w = vr[k], w8 = w >> 8;
        ya[4 * k + 0] = pkfma(__builtin_bit_cast(h2, w & 0x000F000Fu), ca, ya[4 * k + 0]);
        ya[4 * k + 1] = pkfma(__builtin_bit_cast(h2, w & 0x00F000F0u), cb, ya[4 * k + 1]);
        ya[4 * k + 2] = pkfma(__builtin_bit_cast(h2, w8 & 0x000F000Fu), ca, ya[4 * k + 2]);
        ya[4 * k + 3] = pkfma(__builtin_bit_cast(h2, w8 & 0x00F000F0u), cb, ya[4 * k + 3]); }
    }
    float y[VPL];
#pragma unroll
    for (int i = 0; i < 2 * DW; ++i) {
      const unsigned snd = __builtin_bit_cast(unsigned, half ? ya[i] : ya[2 * DW + i]);
      const h2 oth = __builtin_bit_cast(h2, (unsigned)__shfl_xor((int)snd, 32));
      const h2 mine = half ? ya[2 * DW + i] : ya[i];
      y[2 * i] = ((float)mine[0] + (float)oth[0]) * 1024.0f + cmn; y[2 * i + 1] = ((float)mine[1] + (float)oth[1]) * 1024.0f + cmn;
    }
    float hv[VPL]; float ss = 0.f;
#pragma unroll
    for (int i = 0; i < VPL; ++i) { const float v = hres[i] + mg[i] * y[i]; hv[i] = v; ss += v * v; }
    ss = wave_sum(ss);
    const float rstd = rsqrtf(ss * (1.0f / DM) + EPSN);
#pragma unroll
    for (int i = 0; i < VPL; ++i) { const int d = dbase + i; const float o = hv[i] * rstd * p.fnw[d];
      if (dry) ((hf*)(p.ws + O_MERGED))[(size_t)tok * DM + d] = (hf)o; else p.out[(size_t)tok * DM + d] = o; }
  }
}

constexpr int cmax(int a, int b) { return a > b ? a : b; }
constexpr int LDS_GEMM = cmax(cmax((128 + 128) * (GBK_MAX + 8) * 2, 2 * 128 * TLD * 2), 256 * TLD * 2);
constexpr int LDS_A = cmax(64 * 65 * 4, (BATCH * DM + 4 * BATCH * 64) * 4);
constexpr int LDS_D1 = 2 * 64 * 72 * 2 + 64 * 128 * 4 + 64 * 64 * 4 + 512;
constexpr int LDS_E2 = 16 + 4 * E2_WAVE_LDS + 2 * 64 * 72 * 2;
constexpr int LDS_G1 = 2 * 64 * 129 * 4 + 2 * 64 * 16 * 4;
constexpr int LDS_G2 = 4 * G2_WAVE_LDS;
constexpr int SMEM_BYTES = cmax(cmax(cmax(LDS_GEMM, LDS_A), cmax(LDS_D1, LDS_E2)), cmax(cmax(LDS_G1, LDS_G2), LDS_E1));
constexpr int NPHASE = 11;
DI const volatile unsigned* xcd_words(char* smem) { return (const volatile unsigned*)(smem + SMEM_BYTES); }

DI void run_phase(const Params& p, int ph, char* smem, bool dry) {
  switch (ph) {
    case 0: phase_A(p, smem); break;
    case 1: phase_B(p); break;
    case 2: phase_C(p, smem); break;
    case 3: phase_D1(p, smem); break;
    case 4: if (!dry) phase_E1(p, smem); phase_E2(p, smem, dry); break;
    case 5: break;
    case 6: phase_F1(p, smem); break;
    case 7: phase_F2(p, smem); break;
    case 8: phase_F3(p); break;
    case 9: phase_G1(p, smem); break;
    case 10: phase_G2(p, smem, dry); break;
  }
}

#ifdef EMU
static void emu_kernel_all(void* arg) {
  const Params& p = *(const Params*)arg; char* smem = emu_cur->blk->smem;
  for (int ph = 0; ph < NPHASE; ++ph) { run_phase(p, ph, smem, false); emu_grid_sync(); }
}
#else
template <int PH> __global__ void __launch_bounds__(256, 2) phase_kernel(Params p) {
  __shared__ __attribute__((aligned(16))) char smem[SMEM_BYTES + 16];
  run_phase(p, PH, smem, false);
}
#if !MULTI_LAUNCH
#ifndef PROBE_DUP
#define PROBE_DUP 0
#endif
__global__ void __launch_bounds__(256, 2) mega_kernel(Params p) {
  __shared__ __attribute__((aligned(16))) char smem[SMEM_BYTES + 16];
  cooperative_groups::grid_group grid = cooperative_groups::this_grid();
  volatile LAS unsigned* st = (volatile LAS unsigned*)(smem + SMEM_BYTES);
  g_wtab[hw_wave_key()] = (unsigned char)(threadIdx.x >> 6);
  if (threadIdx.x == 0) { st[0] = 0u; st[1] = 0u; }
  __syncthreads();
  if (PROBE_DUP & 1) run_phase(p, 0, smem, false);
  run_phase(p, 0, smem, false);
  grid.sync();
  XcdBarrier xb = xcd_barrier_post((unsigned*)(p.ws + O_BAR), st);
#define XBAR() { xcd_barrier(xb); if (PROBE_BAR2) xcd_barrier(xb); }
#define PH(k) { if (PROBE_DUP & (1 << (k))) { run_phase(p, (k), smem, true); xcd_barrier(xb); } run_phase(p, (k), smem, false); }
  PH(1); XBAR(); PH(2); XBAR(); PH(3); XBAR(); PH(4); XBAR();
  PH(6); XBAR(); PH(7); XBAR(); PH(8); XBAR(); PH(9); XBAR(); PH(10);
#undef PH
}
#endif
#endif

extern "C" void kernel_launch(void* const* d_in, const int* in_sizes, int n_in, void* d_out, int out_size, void* d_ws, size_t ws_size, hipStream_t stream) {
  Params p{};
  p.x = (const float*)d_in[0]; p.c = (const float*)d_in[1]; p.pos = (const int*)d_in[2]; p.w_ada = (const float*)d_in[3]; p.b_ada = (const float*)d_in[4];
  p.w_in = (const float*)d_in[5]; p.conv_w = (const float*)d_in[6]; p.a_log = (const float*)d_in[7]; p.dt_bias = (const float*)d_in[8]; p.norm_b_w = (const float*)d_in[9];
  p.w_pa = (const float*)d_in[10]; p.w_pb = (const float*)d_in[11]; p.w_o = (const float*)d_in[12]; p.wq = (const float*)d_in[13]; p.subk = (const float*)d_in[14];
  p.pu = (const float*)d_in[15]; p.pv = (const float*)d_in[16]; p.fnw = (const float*)d_in[17];
  p.out = (float*)d_out; p.ws = (char*)d_ws;
#ifdef EMU
  const int grid = 4;
  p.dscan = p.ws + WS_TOTAL; p.uv = p.ws + WS_TOTAL + DSCAN_BYTES;
  if (WS_TOTAL + DSCAN_BYTES + UV_BYTES > ws_size) { fprintf(stderr, "ws too small\n"); exit(2); }
  if (O_SCR + (size_t)grid * QBT * SEQ * 4 > O_OB) { fprintf(stderr, "scratch overflow\n"); exit(2); }
  fprintf(stderr, "emu: SMEM_BYTES=%d WS_TOTAL=%zu\n", SMEM_BYTES, WS_TOTAL);
  emu_launch(emu_kernel_all, &p, grid, 256, SMEM_BYTES);
#else
  static_assert((size_t)NTOK * DM * 4 >= DSCAN_BYTES, "d_out too small for scan scratch");
  static_assert(UV_BYTES <= (size_t)NTOK * LP1 * 2, "P1 too small for expert tables");
  p.dscan = (char*)d_out; p.uv = p.ws + O_P1;
  static int grid = 0;
  if (!grid) {
    int dev = 0, cus = 0, per_cu = 0;
    hipGetDevice(&dev); hipDeviceGetAttribute(&cus, hipDeviceAttributeMultiprocessorCount, dev);
#if MULTI_LAUNCH
    hipOccupancyMaxActiveBlocksPerMultiprocessor(&per_cu, phase_kernel<5>, 256, 0);
#else
    hipOccupancyMaxActiveBlocksPerMultiprocessor(&per_cu, mega_kernel, 256, 0);
#endif
    if (per_cu > 2) per_cu = 2;
    if (per_cu < 1) per_cu = 1;
    grid = cus * per_cu;
    if (grid > 512) grid = 512;
  }
  if (WS_TOTAL > ws_size) { fprintf(stderr, "workspace too small: need %zu have %zu\n", WS_TOTAL, ws_size); return; }
#if MULTI_LAUNCH
  hipLaunchKernelGGL(phase_kernel<0>, dim3(grid), dim3(256), 0, stream, p);
  hipLaunchKernelGGL(phase_kernel<1>, dim3(grid), dim3(256), 0, stream, p);
  hipLaunchKernelGGL(phase_kernel<2>, dim3(grid), dim3(256), 0, stream, p);
  hipLaunchKernelGGL(phase_kernel<3>, dim3(grid), dim3(256), 0, stream, p);
  hipLaunchKernelGGL(phase_kernel<4>, dim3(grid), dim3(256), 0, stream, p);
  hipLaunchKernelGGL(phase_kernel<5>, dim3(grid), dim3(256), 0, stream, p);
  hipLaunchKernelGGL(phase_kernel<6>, dim3(grid), dim3(256), 0, stream, p);
  hipLaunchKernelGGL(phase_kernel<7>, dim3(grid), dim3(256), 0, stream, p);
  hipLaunchKernelGGL(phase_kernel<8>, dim3(grid), dim3(256), 0, stream, p);
  hipLaunchKernelGGL(phase_kernel<9>, dim3(grid), dim3(256), 0, stream, p);
  hipLaunchKernelGGL(phase_kernel<10>, dim3(grid), dim3(256), 0, stream, p);
#else
  void* args[] = {&p};
  hipError_t e = hipLaunchCooperativeKernel((void*)mega_kernel, dim3(grid), dim3(256), args, 0, stream);
  if (e != hipSuccess) fprintf(stderr, "cooperative launch failed: %s (grid %d)\n", hipGetErrorString(e), grid);
#endif
#endif
}
```

```cpp
#ifdef EMU
#include "hip_emu.h"
#else
#include <hip/hip_runtime.h>
#include <hip/hip_cooperative_groups.h>
#include <cstdio>
#include <cstdint>
#endif

#ifndef PROBE_BAR2
#define PROBE_BAR2 0
#endif
#ifndef REP_CEPI
#define REP_CEPI 1
#endif
#ifndef REP_CMAIN
#define REP_CMAIN 1
#endif
#ifndef REP_IDX
#define REP_IDX 1
#endif
#ifndef REP_SEL
#define REP_SEL 1
#endif
#ifndef REP_QK
#define REP_QK 1
#endif
#ifndef REP_PV
#define REP_PV 1
#endif
#ifndef MULTI_LAUNCH
#define MULTI_LAUNCH 0
#endif

#ifdef EMU
#ifndef EMU_B
#define EMU_B 2
#endif
#ifndef EMU_S
#define EMU_S 512
#endif
#ifndef EMU_D
#define EMU_D 256
#endif
constexpr int BATCH = EMU_B, SEQ = EMU_S, DM = EMU_D;
#else
constexpr int BATCH = 8, SEQ = 4096, DM = 1024;
#endif
constexpr int NTOK = BATCH * SEQ;
constexpr int TOPK = (SEQ / 4 < 256) ? SEQ / 4 : 256;
constexpr int NCHK = SEQ / 64;
constexpr int NEXP = 16384;
constexpr int C_QA = 0, C_KA = 512, C_VA = 640, C_QI = 768, C_KI = 1792, C_WI = 1856, C_BB = 1872, C_AB = 1880;
constexpr int C_QB = 1920, C_ZB = 3456, C_GA = 3968;
constexpr int NP = 3968 + 2 * DM;
constexpr int IN_W = 3936 + 2 * DM;
constexpr int LP1 = 1920, LP2 = 1536, LP3 = 512, LP4 = 2 * DM;
constexpr int QBT = 16;
constexpr float EPSN = 1e-6f;

typedef _Float16 hf;
typedef _Float16 h8 __attribute__((ext_vector_type(8)));
typedef _Float16 h4 __attribute__((ext_vector_type(4)));
typedef _Float16 h2 __attribute__((ext_vector_type(2)));
typedef float f4 __attribute__((ext_vector_type(4)));
typedef int i4 __attribute__((ext_vector_type(4)));
#define DI __device__ __forceinline__

constexpr size_t al256(size_t x) { return (x + 255) & ~size_t(255); }
constexpr size_t O_MOD = 0;
constexpr size_t O_CNT = O_MOD + al256((size_t)BATCH * 6 * DM * 4);
constexpr size_t O_BAR = O_CNT + 256;
constexpr size_t O_CS = O_BAR + 16384;
constexpr size_t O_AUX = O_CS + al256((size_t)NTOK * 16 * 4);
constexpr size_t O_WIN = O_AUX + al256((size_t)NTOK * 32 * 4);
constexpr size_t O_WPA = O_WIN + al256((size_t)NP * DM * 2);
constexpr size_t O_WPB = O_WPA + al256((size_t)DM * 512 * 2);
constexpr size_t O_WO = O_WPB + al256((size_t)DM * 512 * 2);
constexpr size_t O_WQ = O_WO + al256((size_t)DM * DM * 2);
constexpr size_t O_SUBK = O_WQ + al256((size_t)1024 * DM * 2);
constexpr size_t O_EG = O_SUBK + al256((size_t)8 * 2 * 128 * 64 * 2);
constexpr size_t O_P1 = O_EG + al256((size_t)BATCH * 8 * NCHK * 4);
constexpr size_t O_P3 = O_P1 + al256((size_t)NTOK * LP1 * 2);
constexpr size_t O_P4 = O_P3 + al256((size_t)NTOK * LP3 * 2);
constexpr size_t R_BYTES = ((size_t)NTOK * DM * 2 > (size_t)NTOK * 1024) ? (size_t)NTOK * DM * 2 : (size_t)NTOK * 1024;
constexpr size_t O_R = O_P4 + al256((size_t)NTOK * LP4 * 2);
constexpr size_t O_P2 = O_R + al256(R_BYTES);
constexpr size_t O_OB = O_P2 + al256((size_t)NTOK * LP2 * 2);
constexpr size_t O_W8 = O_OB + al256((size_t)NTOK * 512 * 2);
constexpr size_t O_SB8 = O_W8 + al256((size_t)NP * DM);
constexpr size_t O_WQ8 = O_SB8 + al256((size_t)NP * 4);
constexpr size_t O_SQ8 = O_WQ8 + al256((size_t)1024 * DM);
constexpr size_t WS_TOTAL = O_SQ8 + al256((size_t)1024 * 4);
constexpr size_t O_INTRA = O_R;
constexpr size_t O_SCR = O_R + (size_t)NTOK * 1024;
constexpr size_t O_MERGED = O_R;
constexpr size_t O_N2H = O_R + (size_t)NTOK * DM * 2;
constexpr size_t O_H16 = O_P2;
static_assert((size_t)NTOK * DM * 2 <= (size_t)NTOK * LP2 * 2, "P2 too small for h");
constexpr size_t DSCAN_BYTES = (size_t)NTOK * 4096;
constexpr size_t UV_U8 = 0, UV_V8 = (size_t)NEXP * DM, UV_N2Q = (size_t)2 * NEXP * DM, UV_SU = UV_N2Q + (size_t)NTOK * DM, UV_SV = UV_SU + (size_t)NEXP * 8, UV_SN = UV_SV + (size_t)NEXP * 8;
constexpr size_t UV_BYTES = UV_SN + (size_t)NTOK * 4;

struct Params {
  const float *x, *c; const int* pos;
  const float *w_ada, *b_ada, *w_in, *conv_w, *a_log, *dt_bias, *norm_b_w, *w_pa, *w_pb, *w_o, *wq, *subk, *pu, *pv, *fnw;
  float* out; char* ws; char* dscan; char* uv;
};

#ifdef EMU
DI int get_tid() { return (int)threadIdx.x; }
#else
#if MULTI_LAUNCH
DI int get_tid() { int t = threadIdx.x; asm volatile("" : "+v"(t)); return t; }
#else
__shared__ unsigned char g_wtab[64];
DI int hw_wave_key() { return (int)(__builtin_amdgcn_s_getreg(0x2804) & 63u); }
DI int get_tid() {
  const int w = __builtin_amdgcn_readfirstlane((int)g_wtab[hw_wave_key()]);
  int l;
  asm volatile("v_mbcnt_lo_u32_b32 %0, -1, 0\n\tv_mbcnt_hi_u32_b32 %0, -1, %0" : "=v"(l));
  return (w << 6) | l;
}
#endif
#endif
DI f4 mfma16(h8 a, h8 b, f4 c) { return __builtin_amdgcn_mfma_f32_16x16x32_f16(a, b, c, 0, 0, 0); }
DI f4 mfma16_i8(h8 a, h8 b, f4 c) { return __builtin_bit_cast(f4, __builtin_amdgcn_mfma_i32_16x16x64_i8(__builtin_bit_cast(i4, a), __builtin_bit_cast(i4, b), __builtin_bit_cast(i4, c), 0, 0, 0)); }
#ifdef EMU
DI void wave_sync() { int z = 0, r; emu_collective(&z, 4, &r, 4, [](EmuWave*) {}); }
DI void gmem_wave_sync() { wave_sync(); }
#else
DI void wave_sync() { __builtin_amdgcn_fence(__ATOMIC_RELEASE, "wavefront"); __builtin_amdgcn_wave_barrier(); __builtin_amdgcn_fence(__ATOMIC_ACQUIRE, "wavefront"); }
DI void gmem_wave_sync() { __builtin_amdgcn_fence(__ATOMIC_SEQ_CST, "workgroup"); __builtin_amdgcn_wave_barrier(); }
#endif
#ifdef EMU
DI unsigned ld_relaxed_agent(unsigned* p) { return *(volatile unsigned*)p; }
DI void add_relaxed_agent(unsigned* p, unsigned v) { *p += v; }
DI void fence_release_agent() {}
DI void fence_acquire_agent() {}
DI void drain_stores() {}
DI void spin_pause() { emu_yield(); }
#else
DI unsigned ld_relaxed_agent(unsigned* p) { return __hip_atomic_load(p, __ATOMIC_RELAXED, __HIP_MEMORY_SCOPE_AGENT); }
DI void add_relaxed_agent(unsigned* p, unsigned v) { (void)__hip_atomic_fetch_add(p, v, __ATOMIC_RELAXED, __HIP_MEMORY_SCOPE_AGENT); }
DI void fence_release_agent() { __builtin_amdgcn_fence(__ATOMIC_RELEASE, "agent"); asm volatile("s_waitcnt vmcnt(0)" ::: "memory"); }
DI void fence_acquire_agent() { __builtin_amdgcn_fence(__ATOMIC_ACQUIRE, "agent"); asm volatile("s_waitcnt vmcnt(0)" ::: "memory"); }
DI void drain_stores() { asm volatile("s_waitcnt vmcnt(0)" ::: "memory"); }
DI void spin_pause() { __builtin_amdgcn_s_sleep(8); }
#endif
DI float wave_sum(float v) { for (int m = 32; m >= 1; m >>= 1) v += __shfl_xor(v, m); return v; }
DI int wave_sum_i(int v) { for (int m = 32; m >= 1; m >>= 1) v += __shfl_xor(v, m); return v; }
DI float sigmoidf_(float x) { return 1.0f / (1.0f + __expf(-x)); }
DI float siluf_(float x) { return x / (1.0f + __expf(-x)); }
DI float softplusf_(float x) { return x > 20.f ? x : log1pf(__expf(x)); }
DI unsigned f2ord(float f) { unsigned u = __builtin_bit_cast(unsigned, f); return (u & 0x80000000u) ? ~u : (u | 0x80000000u); }
DI float ord2f(unsigned k) { unsigned u = (k & 0x80000000u) ? (k & 0x7fffffffu) : ~k; return __builtin_bit_cast(float, u); }
DI h8 cat44(h4 a, h4 b) { h8 r; r[0] = a[0]; r[1] = a[1]; r[2] = a[2]; r[3] = a[3]; r[4] = b[0]; r[5] = b[1]; r[6] = b[2]; r[7] = b[3]; return r; }
DI h8 cvt_f4f4(f4 a, f4 b) { h8 r; r[0] = (hf)a[0]; r[1] = (hf)a[1]; r[2] = (hf)a[2]; r[3] = (hf)a[3]; r[4] = (hf)b[0]; r[5] = (hf)b[1]; r[6] = (hf)b[2]; r[7] = (hf)b[3]; return r; }
#ifdef EMU
DI h4 lds_read_tr16(const hf* p) {
  h4 r; const hf* pp = p;
  emu_collective(&pp, sizeof(pp), &r, sizeof(r), [&](EmuWave* w) {
    for (int l = 0; l < 64; ++l) { const int gb = l & ~15, i = l & 15; h4 o;
      for (int qq = 0; qq < 4; ++qq) { const hf* src; memcpy(&src, w->in[gb + 4 * qq + (i >> 2)], sizeof(src)); o[qq] = src[i & 3]; }
      memcpy(w->out[l], &o, sizeof(o)); }
  });
  return r;
}
#else
typedef short s4v __attribute__((ext_vector_type(4)));
DI h4 lds_read_tr16(const hf* p) {
  const s4v v = __builtin_amdgcn_ds_read_tr16_b64_v4i16((__attribute__((address_space(3))) s4v*)p);
  return __builtin_bit_cast(h4, v);
}
#endif
DI h8 relu8(h8 v) { const h8 z = h8{0, 0, 0, 0, 0, 0, 0, 0}; return __builtin_elementwise_max(v, z); }
DI h8 permload(const hf* p, int q) { return cat44(*(const h4*)(p + 4 * q), *(const h4*)(p + 16 + 4 * q)); }


#ifndef EMU
#define XB_TMO      128
#define XB_XCNT(j)  (256  + 64 * (j))
#define XB_XSUB(j)  (1280 + 64 * (j))
#define XB_XGEN(j)  (2304 + 64 * (j))
#define XB_TOP      3328
#define XB_TOPGEN   3392
#define XCD_BAR_WORDS 3456
#define XB_SPIN_CAP (1u << 22)
#define LAS __attribute__((address_space(3)))
DI unsigned xb_ld(unsigned* p) { return __hip_atomic_load(p, __ATOMIC_RELAXED, __HIP_MEMORY_SCOPE_AGENT); }
DI unsigned xb_add(unsigned* p, unsigned v) { return __hip_atomic_fetch_add(p, v, __ATOMIC_RELAXED, __HIP_MEMORY_SCOPE_AGENT); }
DI unsigned xb_xcc_id() { return (unsigned)__builtin_amdgcn_s_getreg((3 << 11) | 20) & 0xFu; }
#define XB_SPIN(cond, bar) do { unsigned _sp = 0; while (cond) { __builtin_amdgcn_s_sleep(1); \
    if ((++_sp & 255u) == 0u) { if (xb_ld(&(bar)[XB_TMO])) break; if (_sp > XB_SPIN_CAP) { atomicAdd(&(bar)[XB_TMO], 1u); break; } } } } while (0)
struct XcdBarrier { unsigned* bar; unsigned x; volatile LAS unsigned* st; };
DI XcdBarrier xcd_barrier_post(unsigned* bar, volatile LAS unsigned* st) {
  XcdBarrier b; b.bar = bar; b.x = xb_xcc_id(); b.st = st;
  if (threadIdx.x == 0) { const unsigned li = xb_add(&bar[XB_XCNT(b.x)], 1u); st[2] = b.x; st[3] = li; }
  return b;
}
DI void xcd_barrier_complete(unsigned* bar, unsigned x, unsigned& nloc, unsigned& nx) {
  const unsigned G = gridDim.x * gridDim.y * gridDim.z;
  unsigned sum, cnt, mine, sp = 0u;
  for (;;) {
    sum = 0u; cnt = 0u; mine = 0u;
#pragma unroll
    for (unsigned j = 0; j < 16; ++j) { const unsigned c = xb_ld(&bar[XB_XCNT(j)]); sum += c; cnt += (c > 0u) ? 1u : 0u; mine = (j == x) ? c : mine; }
    if (sum == G) break;
    __builtin_amdgcn_s_sleep(1);
    if ((++sp & 255u) == 0u) { if (xb_ld(&bar[XB_TMO])) break; if (sp > XB_SPIN_CAP) { atomicAdd(&bar[XB_TMO], 1u); break; } }
  }
  nloc = mine > 0u ? mine : 1u; nx = cnt > 0u ? cnt : 1u;
}
DI void xcd_barrier(const XcdBarrier& b) {
  asm volatile("s_waitcnt vmcnt(0)" ::: "memory");
  __syncthreads();
  if (threadIdx.x == 0) {
    unsigned* bar = b.bar;
    __builtin_amdgcn_s_waitcnt(0);
    unsigned nloc = b.st[0], nx = b.st[1];
    if (nloc == 0u) { xcd_barrier_complete(bar, b.x, nloc, nx); b.st[0] = nloc; b.st[1] = nx; }
    const unsigned old = xb_add(&bar[XB_XSUB(b.x)], 1u);
    const unsigned gen = old / nloc;
    if (old + 1u == (gen + 1u) * nloc) {
      __builtin_amdgcn_fence(__ATOMIC_RELEASE, "agent");
      asm volatile("s_waitcnt vmcnt(0)" ::: "memory");
      const unsigned og = xb_add(&bar[XB_TOP], 1u);
      const unsigned tg = og / nx;
      if (og + 1u == (tg + 1u) * nx) xb_add(&bar[XB_TOPGEN], 1u);
      else XB_SPIN(xb_ld(&bar[XB_TOPGEN]) == tg, bar);
      __builtin_amdgcn_fence(__ATOMIC_ACQUIRE, "agent");
      xb_add(&bar[XB_XGEN(b.x)], 1u);
      asm volatile("s_waitcnt vmcnt(0)" ::: "memory");
    } else {
      XB_SPIN(xb_ld(&bar[XB_XGEN(b.x)]) == gen, bar);
      __builtin_amdgcn_fence(__ATOMIC_ACQUIRE, "agent");
      asm volatile("s_waitcnt vmcnt(0)" ::: "memory");
    }
  }
  __syncthreads();
}
#endif

DI size_t pr32_off(int row, int k, int K) { return ((size_t)(row >> 1) * (K / 32) + (k >> 5)) * 64 + (row & 1) * 32 + (k & 31); }

constexpr int GBK_MAX = 128;
template <int BM, int GBK = 128, bool PR = false, bool I8 = false>
DI void gemm_mainloop(f4 (&acc)[BM / 32][4], const hf* __restrict__ A, int lda, const hf* __restrict__ Bt, int ldb, int K, int m0, int n0, char* smem, int krot = 0) {
  constexpr int GLD = GBK + 8, MT = BM / 32, CPR = GBK / 8, ACH = BM * CPR / 256, BCH = 128 * CPR / 256;
  hf* sA = (hf*)smem; hf* sB = sA + BM * GLD;
  const int tid = get_tid(), lane = tid & 63, wave = tid >> 6, wm = wave >> 1, wn = wave & 1;
  h8 ra[ACH], rb[BCH];
#pragma unroll
  for (int i = 0; i < ACH; ++i) { int idx = tid + i * 256, r = idx / CPR, c = idx % CPR; ra[i] = *(const h8*)(PR ? (A + pr32_off(m0 + r, c * 8, K)) : (A + (size_t)(m0 + r) * lda + krot + c * 8)); }
#pragma unroll
  for (int i = 0; i < BCH; ++i) { int idx = tid + i * 256, r = idx / CPR, c = idx % CPR; rb[i] = *(const h8*)(PR ? (Bt + pr32_off(n0 + r, c * 8, K)) : (Bt + (size_t)(n0 + r) * ldb + krot + c * 8)); }
  for (int k0 = 0; k0 < K; k0 += GBK) {
    __syncthreads();
#pragma unroll
    for (int i = 0; i < ACH; ++i) { int idx = tid + i * 256, r = idx / CPR, c = idx % CPR; *(h8*)(sA + r * GLD + c * 8) = ra[i]; }
#pragma unroll
    for (int i = 0; i < BCH; ++i) { int idx = tid + i * 256, r = idx / CPR, c = idx % CPR; *(h8*)(sB + r * GLD + c * 8) = rb[i]; }
    __syncthreads();
    if (k0 + GBK < K) {
      int kn = k0 + GBK + krot; kn = kn >= K ? kn - K : kn;
#pragma unroll
      for (int i = 0; i < ACH; ++i) { int idx = tid + i * 256, r = idx / CPR, c = idx % CPR; ra[i] = *(const h8*)(PR ? (A + pr32_off(m0 + r, kn + c * 8, K)) : (A + (size_t)(m0 + r) * lda + kn + c * 8)); }
#pragma unroll
      for (int i = 0; i < BCH; ++i) { int idx = tid + i * 256, r = idx / CPR, c = idx % CPR; rb[i] = *(const h8*)(PR ? (Bt + pr32_off(n0 + r, kn + c * 8, K)) : (Bt + (size_t)(n0 + r) * ldb + kn + c * 8)); }
    }
#pragma unroll
    for (int ks = 0; ks < GBK / 32; ++ks) {
      h8 af[MT], bf[4];
#pragma unroll
      for (int mt = 0; mt < MT; ++mt) af[mt] = *(const h8*)(sA + (wm * (BM / 2) + mt * 16 + (lane & 15)) * GLD + ks * 32 + (lane >> 4) * 8);
#pragma unroll
      for (int nt = 0; nt < 4; ++nt) bf[nt] = *(const h8*)(sB + (wn * 64 + nt * 16 + (lane & 15)) * GLD + ks * 32 + (lane >> 4) * 8);
#pragma unroll
      for (int mt = 0; mt < MT; ++mt)
#pragma unroll
        for (int nt = 0; nt < 4; ++nt) acc[mt][nt] = I8 ? mfma16_i8(af[mt], bf[nt], acc[mt][nt]) : mfma16(af[mt], bf[nt], acc[mt][nt]);
    }
  }
}
template <int BM, bool I8>
DI void gemm_mainloop_2set(f4 (&acc)[BM / 32][4], const hf* __restrict__ A, const hf* __restrict__ Bt, int K, int m0, int n0, char* smem) {
  constexpr int GBK = 32, GLD = GBK + 8, MT = BM / 32, CPR = GBK / 8, ACH = BM * CPR / 256, BCH = 128 * CPR / 256;
  hf* sA = (hf*)smem; hf* sB = sA + BM * GLD;
  const int tid = get_tid(), lane = tid & 63, wave = tid >> 6, wm = wave >> 1, wn = wave & 1;
  h8 ra[ACH], ra2[ACH], rb[BCH];
  const unsigned voff = (unsigned)(((tid >> 3) * (K / 32)) * 64 + ((tid >> 2) & 1) * 32 + (tid & 3) * 8) * 2u;
#ifndef EMU
  m0 = __builtin_amdgcn_readfirstlane(m0); n0 = __builtin_amdgcn_readfirstlane(n0);
#endif
  const char* Ab = (const char*)(A + (size_t)(m0 >> 1) * (K / 32) * 64);
  const char* Bb = (const char*)(Bt + (size_t)(n0 >> 1) * (K / 32) * 64);
  const size_t chunk_b = (size_t)32 * (K / 32) * 64 * 2;
#ifdef EMU
#define G2LDA(RA, kk) { _Pragma("unroll") for (int i = 0; i < ACH; ++i) RA[i] = *(const h8*)(Ab + i * chunk_b + (size_t)((kk) >> 5) * 128 + voff); }
#define G2LDB(kk) { _Pragma("unroll") for (int i = 0; i < BCH; ++i) rb[i] = *(const h8*)(Bb + i * chunk_b + (size_t)((kk) >> 5) * 128 + voff); }
#else
  const __amdgpu_buffer_rsrc_t rsA = __builtin_amdgcn_make_buffer_rsrc((void*)Ab, 0, 0x7fffffff, 0x00020000);
  const __amdgpu_buffer_rsrc_t rsB = __builtin_amdgcn_make_buffer_rsrc((void*)Bb, 0, 0x7fffffff, 0x00020000);
#define G2LDA(RA, kk) { _Pragma("unroll") for (int i = 0; i < ACH; ++i) RA[i] = __builtin_bit_cast(h8, __builtin_amdgcn_raw_buffer_load_b128(rsA, (int)voff, (int)(i * chunk_b) + ((kk) >> 5) * 128, 0)); }
#define G2LDB(kk) { _Pragma("unroll") for (int i = 0; i < BCH; ++i) rb[i] = __builtin_bit_cast(h8, __builtin_amdgcn_raw_buffer_load_b128(rsB, (int)voff, (int)(i * chunk_b) + ((kk) >> 5) * 128, 0)); }
#endif
#define G2STEP(RA, kb_next, ka_next, LDB_, LDA_) { __syncthreads(); \
    _Pragma("unroll") for (int i = 0; i < ACH; ++i) { const int idx = tid + i * 256, r = idx / CPR, c = idx % CPR; *(h8*)(sA + r * GLD + c * 8) = RA[i]; } \
    _Pragma("unroll") for (int i = 0; i < BCH; ++i) { const int idx = tid + i * 256, r = idx / CPR, c = idx % CPR; *(h8*)(sB + r * GLD + c * 8) = rb[i]; } \
    __syncthreads(); \
    if (LDB_) G2LDB(kb_next) \
    if (LDA_) G2LDA(RA, ka_next) \
    { h8 bf[4]; \
      _Pragma("unroll") for (int nt = 0; nt < 4; ++nt) bf[nt] = *(const h8*)(sB + (wn * 64 + nt * 16 + (lane & 15)) * GLD + (lane >> 4) * 8); \
      _Pragma("unroll") for (int mh = 0; mh < MT / 4; ++mh) { h8 af[4]; \
        _Pragma("unroll") for (int mt = 0; mt < 4; ++mt) af[mt] = *(const h8*)(sA + (wm * (BM / 2) + (mh * 4 + mt) * 16 + (lane & 15)) * GLD + (lane >> 4) * 8); \
        _Pragma("unroll") for (int mt = 0; mt < 4; ++mt) _Pragma("unroll") for (int nt = 0; nt < 4; ++nt) acc[mh * 4 + mt][nt] = I8 ? mfma16_i8(af[mt], bf[nt], acc[mh * 4 + mt][nt]) : mfma16(af[mt], bf[nt], acc[mh * 4 + mt][nt]); } } }
  G2LDB(0) G2LDA(ra, 0) G2LDA(ra2, GBK)
  for (int k0 = 0; k0 < K - 2 * GBK; k0 += 2 * GBK) {
    G2STEP(ra, k0 + GBK, k0 + 2 * GBK, true, true)
    G2STEP(ra2, k0 + 2 * GBK, k0 + 3 * GBK, true, true)
  }
  G2STEP(ra, K - GBK, 0, true, false)
  G2STEP(ra2, 0, 0, false, false)
#undef G2LDA
#undef G2LDB
#undef G2STEP
}
template <int BM, bool I8 = false>
DI void gemm_mainloop_r3(f4 (&acc)[BM / 32][4], const hf* __restrict__ A, int lda, const hf* __restrict__ Bt, int ldb, int K, int m0, int n0, char* smem) {
  constexpr int GLD = 72, MT = BM / 32, ACH = BM * 8 / 256;
  hf* sA = (hf*)smem; hf* sB = sA + BM * GLD;
  const int tid = get_tid(), lane = tid & 63, wave = tid >> 6, wm = wave >> 1, wn = wave & 1;
  const int nk = K / 64;
  h8 a0[ACH], b0[4], a1[ACH], b1[4], a2[ACH], b2[4];
  const hf* Ap = A + (size_t)(m0 + (tid >> 3)) * lda + (tid & 7) * 8;
  const hf* Bp = Bt + (size_t)(n0 + (tid >> 3)) * ldb + (tid & 7) * 8;
#define GL(ra, rb, kt) { const int kk_ = ((kt) < nk ? (kt) : nk - 1) * 64; \
    _Pragma("unroll") for (int i = 0; i < ACH; ++i) ra[i] = *(const h8*)(Ap + (size_t)(i * 32) * lda + kk_); \
    _Pragma("unroll") for (int i = 0; i < 4; ++i) rb[i] = *(const h8*)(Bp + (size_t)(i * 32) * ldb + kk_); }
#define GSTEP(ra, rb, knext) { __syncthreads(); \
    _Pragma("unroll") for (int i = 0; i < ACH; ++i) *(h8*)(sA + ((tid >> 3) + i * 32) * GLD + (tid & 7) * 8) = ra[i]; \
    _Pragma("unroll") for (int i = 0; i < 4; ++i) *(h8*)(sB + ((tid >> 3) + i * 32) * GLD + (tid & 7) * 8) = rb[i]; \
    __syncthreads(); \
    GL(ra, rb, knext) \
    _Pragma("unroll") for (int ks = 0; ks < 2; ++ks) { h8 af[MT], bf[4]; \
      _Pragma("unroll") for (int mt = 0; mt < MT; ++mt) af[mt] = *(const h8*)(sA + (wm * (BM / 2) + mt * 16 + (lane & 15)) * GLD + ks * 32 + (lane >> 4) * 8); \
      _Pragma("unroll") for (int nt = 0; nt < 4; ++nt) bf[nt] = *(const h8*)(sB + (wn * 64 + nt * 16 + (lane & 15)) * GLD + ks * 32 + (lane >> 4) * 8); \
      _Pragma("unroll") for (int mt = 0; mt < MT; ++mt) _Pragma("unroll") for (int nt = 0; nt < 4; ++nt) acc[mt][nt] = I8 ? mfma16_i8(af[mt], bf[nt], acc[mt][nt]) : mfma16(af[mt], bf[nt], acc[mt][nt]); } }
  GL(a0, b0, 0) GL(a1, b1, 1) GL(a2, b2, 2)
  for (int kt = 0; kt < nk; kt += 3) {
    GSTEP(a0, b0, kt + 3)
    if (kt + 1 < nk) GSTEP(a1, b1, kt + 4)
    if (kt + 2 < nk) GSTEP(a2, b2, kt + 5)
  }
#undef GL
#undef GSTEP
}
constexpr int TLD = 136;
template <int MT> DI void zero_acc(f4 (&acc)[MT][4]) {
#pragma unroll
  for (int i = 0; i < MT; ++i)
#pragma unroll
    for (int j = 0; j < 4; ++j) acc[i][j] = f4{0.f, 0.f, 0.f, 0.f};
}


DI const volatile unsigned* xcd_words(char* smem);
struct TileSched { int s, step, total, rp0, ntn, sr; };
DI TileSched tile_begin(int NTM_, int NTN_, const void* g_bar = nullptr, const volatile unsigned* g_st = nullptr) {
  const int G = (int)gridDim.x;
  const int ng = (G % 8 == 0 && NTM_ % 8 == 0) ? 8 : ((G % 4 == 0 && NTM_ % 4 == 0) ? 4 : 1);
  int x = (int)blockIdx.x % ng, li = (int)blockIdx.x / ng; const int rpg = NTM_ / ng;
#ifndef EMU
  if (ng == 8) {
    const unsigned* bar = (const unsigned*)g_bar; bool ok = true;
#pragma unroll
    for (int j = 0; j < 8; ++j) ok = ok && (__hip_atomic_load(&bar[XB_XCNT(j)], __ATOMIC_RELAXED, __HIP_MEMORY_SCOPE_AGENT) == (unsigned)(G / 8));
    if (ok) { x = (int)g_st[2]; li = (int)g_st[3]; }
  }
  x = __builtin_amdgcn_readfirstlane(x); li = __builtin_amdgcn_readfirstlane(li);
#endif
  TileSched t; t.s = li; t.step = G / ng; t.total = rpg * NTN_; t.rp0 = x * rpg; t.ntn = NTN_; t.sr = (rpg % 8 == 0) ? 8 : ((rpg % 4 == 0) ? 4 : ((rpg % 2 == 0) ? 2 : 1));
  return t;
}
DI bool tile_next(TileSched& t, int& tm, int& tn) {
  if (t.s >= t.total) return false;
  const int SC = 8;
  const int per_rg = t.sr * t.ntn, rg = t.s / per_rg, rem = t.s % per_rg, nfull = t.ntn / SC, fullsz = nfull * t.sr * SC;
  int r, c, cg;
  if (rem < fullsz) { cg = rem / (t.sr * SC); const int loc = rem % (t.sr * SC); r = loc / SC; c = loc % SC; }
  else { const int loc = rem - fullsz, w = t.ntn - nfull * SC; cg = nfull; r = loc / w; c = loc % w; }
  tm = t.rp0 + rg * t.sr + r; tn = cg * SC + c; t.s += t.step;
  return true;
}

DI int win_colmap(int c) {
  if (c < 1872) return c;
  if (c < 1880) return 3920 + (c - 1872);
  if (c < 1888) return 3928 + (c - 1880);
  if (c < 1920) return -1;
  if (c < 3968) return 1872 + (c - 1920);
  return 3936 + (c - 3968);
}
DI void transpose_tile(const float* src, int lds_, hf* dst, int K, int k0, int n0, bool use_map, char* smem, bool pr = false) {
  float* t = (float*)smem;
  const int tid = get_tid(), c = tid & 63, r0 = tid >> 6;
  int sc = use_map ? win_colmap(n0 + c) : (n0 + c);
  __syncthreads();
  float tv[16];
#pragma unroll
  for (int i = 0; i < 16; ++i) { int r = i * 4 + r0; tv[i] = sc >= 0 ? src[(size_t)(k0 + r) * lds_ + sc] : 0.f; }
#pragma unroll
  for (int i = 0; i < 16; ++i) t[c * 65 + i * 4 + r0] = tv[i];
  __syncthreads();
#pragma unroll 4
  for (int i = 0; i < 16; ++i) { int r = i * 4 + r0; dst[pr ? pr32_off(n0 + r, k0 + c, K) : ((size_t)(n0 + r) * K + k0 + c)] = (hf)t[r * 65 + c]; }
}
DI void phase_A(const Params& p, char* smem) {
  float* mod = (float*)(p.ws + O_MOD);
  const int tid = get_tid(), lane = tid & 63, wave = tid >> 6;
  constexpr int N_MOD = 6 * DM / 64;
  constexpr int N_WIN = (NP / 64) * (DM / 64), N_WPA = (DM / 64) * 8, N_WO = (DM / 64) * (DM / 64), N_WQ = 16 * (DM / 64);
  constexpr int N_SUBK = 8, N_CS = NTOK / 256;
  constexpr int T1 = N_MOD, T2 = T1 + N_WIN, T3 = T2 + N_WPA, T4 = T3 + N_WPA, T5 = T4 + N_WO, T6 = T5 + N_WQ, T7 = T6 + N_SUBK, T8 = T7 + N_CS;
  if (blockIdx.x == 0) { if (tid < 64) ((int*)(p.ws + O_CNT))[tid] = 0; for (int i = tid; i < 4096; i += 256) ((unsigned*)(p.ws + O_BAR))[i] = 0u; }
  for (int it = blockIdx.x; it < T8; it += gridDim.x) {
    if (it < T1) {
      float* sil = (float*)smem;
      float* red = sil + BATCH * DM;
      __syncthreads();
      for (int i = tid; i < BATCH * DM; i += 256) sil[i] = siluf_(p.c[i]);
      __syncthreads();
      const int j = it * 64 + lane;
      float a[BATCH];
#pragma unroll
      for (int b = 0; b < BATCH; ++b) a[b] = 0.f;
      for (int k = wave * (DM / 4); k < (wave + 1) * (DM / 4); ++k) {
        float w = p.w_ada[(size_t)k * 6 * DM + j];
#pragma unroll
        for (int b = 0; b < BATCH; ++b) a[b] += sil[b * DM + k] * w;
      }
#pragma unroll
      for (int b = 0; b < BATCH; ++b) red[(wave * BATCH + b) * 64 + lane] = a[b];
      __syncthreads();
      if (wave == 0) {
#pragma unroll
        for (int b = 0; b < BATCH; ++b) {
          float s = red[(0 * BATCH + b) * 64 + lane] + red[(1 * BATCH + b) * 64 + lane] + red[(2 * BATCH + b) * 64 + lane] + red[(3 * BATCH + b) * 64 + lane];
          mod[(size_t)b * 6 * DM + j] = s + p.b_ada[j];
        }
      }
    } else if (it < T2) { int t = it - T1; transpose_tile(p.w_in, IN_W, (hf*)(p.ws + O_WIN), DM, (t % (DM / 64)) * 64, (t / (DM / 64)) * 64, true, smem, true); }
    else if (it < T3) { int t = it - T2; transpose_tile(p.w_pa, DM, (hf*)(p.ws + O_WPA), 512, (t % 8) * 64, (t / 8) * 64, false, smem); }
    else if (it < T4) { int t = it - T3; transpose_tile(p.w_pb, DM, (hf*)(p.ws + O_WPB), 512, (t % 8) * 64, (t / 8) * 64, false, smem); }
    else if (it < T5) { int t = it - T4; transpose_tile(p.w_o, DM, (hf*)(p.ws + O_WO), DM, (t % (DM / 64)) * 64, (t / (DM / 64)) * 64, false, smem, true); }
    else if (it < T6) { int t = it - T5; transpose_tile(p.wq, 1024, (hf*)(p.ws + O_WQ), DM, (t % (DM / 64)) * 64, (t / (DM / 64)) * 64, false, smem); }
    else if (it < T7) { int t = it - T6; hf* d = (hf*)(p.ws + O_SUBK); for (int i = tid; i < 16384; i += 256) d[t * 16384 + i] = (hf)p.subk[t * 16384 + i]; }
    else {
      int tok = (it - T7) * 256 + tid;
      float* cs = (float*)(p.ws + O_CS) + (size_t)tok * 16;
      float pos = (float)p.pos[tok];
#pragma unroll
      for (int i = 0; i < 8; ++i) { float inv = powf(500000.0f, -(float)i * 0.125f); float ang = pos * inv; cs[i] = cosf(ang); cs[8 + i] = sinf(ang); }
    }
  }
}

DI void adaln_rows(const float* src, hf* dst, const float* mod, int sh_off, int sc_off, bool pr) {
  const int tid = get_tid(), lane = tid & 63, wave = tid >> 6;
  for (int row = blockIdx.x * 4 + wave; row < NTOK; row += gridDim.x * 4) {
    const float* xr = src + (size_t)row * DM; const int b = row / SEQ;
    float v[DM / 64]; float ss = 0.f;
#pragma unroll
    for (int i = 0; i < DM / 256; ++i) { f4 t = *(const f4*)(xr + i * 256 + lane * 4); v[4 * i] = t[0]; v[4 * i + 1] = t[1]; v[4 * i + 2] = t[2]; v[4 * i + 3] = t[3]; ss += t[0] * t[0] + t[1] * t[1] + t[2] * t[2] + t[3] * t[3]; }
    ss = wave_sum(ss);
    float rstd = rsqrtf(ss * (1.0f / DM) + EPSN);
    const float* mb = mod + (size_t)b * 6 * DM;
#pragma unroll
    for (int i = 0; i < DM / 256; ++i) {
      int d = i * 256 + lane * 4; h4 o;
#pragma unroll
      for (int j = 0; j < 4; ++j) o[j] = (hf)(v[4 * i + j] * rstd * (1.0f + mb[sc_off + d + j]) + mb[sh_off + d + j]);
      *(h4*)(dst + (pr ? pr32_off(row, d, DM) : ((size_t)row * DM + d))) = o;
    }
  }
}

constexpr size_t Q_W8 = 0, Q_SB = al256((size_t)NP * DM), Q_N1 = al256(Q_SB + (size_t)NP * 4), Q_SA = Q_N1 + (size_t)NTOK * DM;
static_assert(Q_SA + (size_t)NTOK * 4 <= DSCAN_BYTES, "scan scratch too small for the int8 in-projection operands");
#ifndef TN_I8
#define TN_I8 0
#endif
static_assert(TN_I8 == 0, "the query scale is folded into the int8 dequant scale: every in-projection tile must take the int8 path");
DI size_t pr64b_off(int row, int k, int K) { return ((size_t)(row >> 1) * (K / 64) + (k >> 6)) * 128 + (row & 1) * 64 + (k & 63); }
DI void phase_B(const Params& p) {
  const int tid = get_tid(), lane = tid & 63, wave = tid >> 6;
  const float* mod = (const float*)(p.ws + O_MOD);
  signed char* n1q = (signed char*)(TN_I8 > 0 ? p.dscan + Q_N1 : p.ws + O_R); float* sa = (float*)(TN_I8 > 0 ? p.dscan + Q_SA : p.ws + O_R + (size_t)NTOK * DM); hf* n1h = (hf*)(p.ws + O_R);
  signed char* w8 = (signed char*)(p.ws + O_W8); float* sb = (float*)(p.ws + O_SB8);
  for (int row = blockIdx.x * 4 + wave; row < NTOK; row += gridDim.x * 4) {
    const float* xr = p.x + (size_t)row * DM; const int b = row / SEQ;
    float v[DM / 64]; float ss = 0.f;
#pragma unroll
    for (int i = 0; i < DM / 256; ++i) { f4 t = *(const f4*)(xr + i * 256 + lane * 4); v[4 * i] = t[0]; v[4 * i + 1] = t[1]; v[4 * i + 2] = t[2]; v[4 * i + 3] = t[3]; ss += t[0] * t[0] + t[1] * t[1] + t[2] * t[2] + t[3] * t[3]; }
    ss = wave_sum(ss);
    const float rstd = rsqrtf(ss * (1.0f / DM) + EPSN);
    const float* mb = mod + (size_t)b * 6 * DM;
    float mx = 0.f;
#pragma unroll
    for (int i = 0; i < DM / 256; ++i)
#pragma unroll
      for (int j = 0; j < 4; ++j) { const int d = i * 256 + lane * 4 + j; v[4 * i + j] = v[4 * i + j] * rstd * (1.0f + mb[DM + d]) + mb[d]; mx = fmaxf(mx, fabsf(v[4 * i + j])); }
    if (TN_I8 > 0) {
#pragma unroll
      for (int i = 0; i < DM / 256; ++i) { h4 o; o[0] = (hf)v[4 * i]; o[1] = (hf)v[4 * i + 1]; o[2] = (hf)v[4 * i + 2]; o[3] = (hf)v[4 * i + 3]; *(h4*)(n1h + pr32_off(row, i * 256 + lane * 4, DM)) = o; }
    }
#pragma unroll
    for (int m = 32; m >= 1; m >>= 1) mx = fmaxf(mx, __shfl_xor(mx, m));
    const float sc = mx > 0.f ? mx * (1.0f / 127.0f) : 1.0f, inv = 1.0f / sc;
#pragma unroll
    for (int i = 0; i < DM / 256; ++i) {
      unsigned w = 0;
#pragma unroll
      for (int j = 0; j < 4; ++j) { int qv = (int)rintf(v[4 * i + j] * inv); qv = qv > 127 ? 127 : (qv < -127 ? -127 : qv); w |= ((unsigned)qv & 255u) << (8 * j); }
      *(unsigned*)(n1q + pr64b_off(row, i * 256 + lane * 4, DM)) = w;
    }
    if (lane == 0) sa[row] = sc;
  }
  const hf* WinT = (const hf*)(p.ws + O_WIN);
  for (int n = blockIdx.x * 4 + wave; n < NP; n += gridDim.x * 4) {
    constexpr int EPL = DM / 64;
    const hf* wr = WinT + pr32_off(n, lane * EPL, DM);
    float v[EPL]; float mx = 0.f;
#pragma unroll
    for (int i = 0; i < EPL; ++i) { v[i] = (float)wr[i]; mx = fmaxf(mx, fabsf(v[i])); }
#pragma unroll
    for (int m = 32; m >= 1; m >>= 1) mx = fmaxf(mx, __shfl_xor(mx, m));
    const float sc = mx > 0.f ? mx * (1.0f / 127.0f) : 1.0f, inv = 1.0f / sc;
#pragma unroll
    for (int i4_ = 0; i4_ < EPL / 4; ++i4_) {
      unsigned w = 0;
#pragma unroll
      for (int j = 0; j < 4; ++j) { int qv = (int)rintf(v[4 * i4_ + j] * inv); qv = qv > 127 ? 127 : (qv < -127 ? -127 : qv); w |= ((unsigned)qv & 255u) << (8 * j); }
      *(unsigned*)(w8 + pr64b_off(n, lane * EPL + 4 * i4_, DM)) = w;
    }
    if (lane == 0) sb[n] = sc;
  }
  const hf* WqT = (const hf*)(p.ws + O_WQ); signed char* wq8 = (signed char*)(p.ws + O_WQ8); float* sq8 = (float*)(p.ws + O_SQ8);
  for (int n = blockIdx.x * 4 + wave; n < 1024; n += gridDim.x * 4) {
    constexpr int EPL = DM / 64;
    const hf* wr = WqT + (size_t)n * DM + lane * EPL;
    float v[EPL]; float mx = 0.f;
#pragma unroll
    for (int i = 0; i < EPL; ++i) { v[i] = (float)wr[i]; mx = fmaxf(mx, fabsf(v[i])); }
#pragma unroll
    for (int m = 32; m >= 1; m >>= 1) mx = fmaxf(mx, __shfl_xor(mx, m));
    const float sc = mx > 0.f ? mx * (1.0f / 127.0f) : 1.0f, inv = 1.0f / sc;
#pragma unroll
    for (int i4_ = 0; i4_ < EPL / 4; ++i4_) {
      unsigned w = 0;
#pragma unroll
      for (int j = 0; j < 4; ++j) { int qv = (int)rintf(v[4 * i4_ + j] * inv); qv = qv > 127 ? 127 : (qv < -127 ? -127 : qv); w |= ((unsigned)qv & 255u) << (8 * j); }
      *(unsigned*)(wq8 + (size_t)n * DM + lane * EPL + 4 * i4_) = w;
    }
    if (lane == 0) sq8[n] = sc;
  }
}
DI void phase_C(const Params& p, char* smem) {
  const hf* n1h = (const hf*)(p.ws + O_R); const hf* WinT = (const hf*)(p.ws + O_WIN);
  const hf* n1q = (const hf*)(TN_I8 > 0 ? p.dscan + Q_N1 : p.ws + O_R); const hf* W8 = (const hf*)(p.ws + O_W8);
  const float* sa = (const float*)(TN_I8 > 0 ? p.dscan + Q_SA : p.ws + O_R + (size_t)NTOK * DM); const float* sb = (const float*)(p.ws + O_SB8);
  hf* P1 = (hf*)(p.ws + O_P1); hf* P2 = (hf*)(p.ws + O_P2); hf* P3 = (hf*)(p.ws + O_P3); hf* P4 = (hf*)(p.ws + O_P4);
  float* aux = (float*)(p.ws + O_AUX); const float* cs = (const float*)(p.ws + O_CS);
  constexpr int CBM = 256, CMT = CBM / 32, NTN = NP / 128, NTM = NTOK / CBM;
  TileSched ts = tile_begin(NTM, NTN, p.ws + O_BAR, xcd_words(smem)); int tm, tn;
  while (tile_next(ts, tm, tn)) {
    const int m0 = tm * CBM, n0 = tn * 128;
    f4 acc[CMT][4];
    for (int rep_ = 0; rep_ < REP_CMAIN; ++rep_) { zero_acc<CMT>(acc);
    if (TN_I8 == 0 || tn >= TN_I8) gemm_mainloop_2set<CBM, true>(acc, n1q, W8, DM / 2, m0, n0, smem);
    else gemm_mainloop<CBM, 32, true, false>(acc, n1h, DM, WinT, DM, DM, m0, n0, smem); }
    const int tid_e = get_tid();
    const int lane = tid_e & 63, wave = tid_e >> 6, wm = wave >> 1, wn = wave & 1, q = lane >> 4, cl = lane & 15;
    const bool rope = (tn <= 4) || (tn >= 6 && tn <= 14);
    hf* tileS = (hf*)smem;
    for (int repe_ = 0; repe_ < REP_CEPI; ++repe_) {
    __syncthreads();
#pragma unroll
    for (int mt = 0; mt < CMT; ++mt) {
#pragma unroll
      for (int nt = 0; nt < 4; ++nt) {
        const int lrow = wm * (CBM / 2) + mt * 16 + q * 4, lcol = wn * 64 + nt * 16 + cl;
        const int rbase = m0 + lrow;
        f4 v = acc[mt][nt];
        if (TN_I8 == 0 || tn >= TN_I8) { const i4 ai = __builtin_bit_cast(i4, acc[mt][nt]); const float sbn = sb[n0 + lcol] * ((tn < 4) ? 0.125f : 1.0f); const f4 sa4 = *(const f4*)(sa + rbase);
#pragma unroll
          for (int r = 0; r < 4; ++r) v[r] = (float)ai[r] * (sa4[r] * sbn); }
        if (rope && nt == 0 && !(tn == 14 && wn == 1)) {
#pragma unroll
          for (int r = 0; r < 4; ++r) {
            float pv = __shfl_xor(v[r], 8);
            const float* c2 = cs + (size_t)(rbase + r) * 16; float co = c2[cl & 7], si = c2[8 + (cl & 7)];
            v[r] = (cl < 8) ? (v[r] * co - pv * si) : (v[r] * co + pv * si);
          }
        }
        if (tn == 14 && wn == 1) {
          const int lc = nt * 16 + cl;
          if (lc < 32) {
            const int hh = lc & 7;
#pragma unroll
            for (int r = 0; r < 4; ++r) {
              float o;
              if (lc < 16) o = v[r] * (0.25f * 0.125f);
              else if (lc < 24) o = sigmoidf_(v[r]);
              else o = -__expf(p.a_log[hh]) * softplusf_(v[r] + p.dt_bias[hh]);
              aux[(size_t)(rbase + r) * 32 + lc] = o;
            }
          }
        } else {
          if (tn >= 31) {
#pragma unroll
            for (int r = 0; r < 4; ++r) v[r] = sigmoidf_(v[r]);
          }
#pragma unroll
          for (int r = 0; r < 4; ++r) tileS[(lrow + r) * TLD + lcol] = (hf)v[r];
        }
      }
    }
    __syncthreads();
    {
      hf* dst; int ld, nch = 16;
      if (tn < 15) { dst = P1 + n0; ld = LP1; if (tn == 14) nch = 8; }
      else if (tn < 27) { dst = P2 + (n0 - C_QB); ld = LP2; }
      else if (tn < 31) { dst = P3 + (n0 - C_ZB); ld = LP3; }
      else { dst = P4 + (n0 - C_GA); ld = LP4; }
      const int tid = get_tid();
#pragma unroll
      for (int i = 0; i < CBM / 16; ++i) {
        const int idx = tid + i * 256, row = idx >> 4, ch = idx & 15;
        if (ch < nch) *(h8*)(dst + (size_t)(m0 + row) * ld + ch * 8) = *(const h8*)(tileS + row * TLD + ch * 8);
      }
    }
    }
  }
}

DI void phase_D1(const Params& p, char* smem) {
  const hf* P2 = (const hf*)(p.ws + O_P2); const float* aux = (const float*)(p.ws + O_AUX);
  hf* Qs = (hf*)smem;
  hf* Ks = Qs + 64 * 72;
  float* RHS = (float*)(Ks + 64 * 72);
  float* Lm = RHS + 64 * 128;
  float* gcs = Lm + 64 * 64;
  float* bts = gcs + 64;
  const int tid = get_tid(), lane = tid & 63, wave = tid >> 6, q = lane >> 4, cl = lane & 15;
  constexpr size_t MSZ = (size_t)NTOK * 512;
  hf* uT = (hf*)p.dscan; hf* wm_ = uT + MSZ; hf* qg = wm_ + MSZ; hf* kdT = qg + MSZ; hf* intra = (hf*)(p.ws + O_INTRA);
  float* eg = (float*)(p.ws + O_EG);
  for (int it = blockIdx.x; it < BATCH * 8 * NCHK; it += gridDim.x) {
    const int c = it % NCHK, h = (it / NCHK) % 8, b = it / (NCHK * 8);
    const size_t cbase = (size_t)it * 4096;
    const int tk = tid >> 2, qq = tid & 3, t0 = c * 64;
    const size_t grow = (size_t)b * SEQ + t0 + tk;
    __syncthreads();
    float g = aux[grow * 32 + 24 + h], beta = aux[grow * 32 + 16 + h];
    if (qq == 0) { gcs[tk] = g; bts[tk] = beta; }
    float val[3][16];
#pragma unroll
    for (int m = 0; m < 3; ++m) {
      const int ch0 = m * 512 + h * 64 + qq * 16;
#pragma unroll
      for (int e = 0; e < 16; ++e) val[m][e] = 0.f;
#pragma unroll
      for (int i = 0; i < 4; ++i) {
        const int tt = t0 + tk - 3 + i;
        if (tt >= 0) {
          const hf* src = P2 + ((size_t)b * SEQ + tt) * LP2 + ch0;
          h8 x0 = *(const h8*)src, x1 = *(const h8*)(src + 8);
          const float* wv = p.conv_w + (size_t)i * 1536 + ch0;
#pragma unroll
          for (int e = 0; e < 8; ++e) { val[m][e] += (float)x0[e] * wv[e]; val[m][8 + e] += (float)x1[e] * wv[8 + e]; }
        }
      }
#pragma unroll
      for (int e = 0; e < 16; ++e) val[m][e] = siluf_(val[m][e]);
    }
    float sq = 0.f, sk = 0.f;
#pragma unroll
    for (int e = 0; e < 16; ++e) { sq += val[0][e] * val[0][e]; sk += val[1][e] * val[1][e]; }
    sq += __shfl_xor(sq, 1); sq += __shfl_xor(sq, 2); sk += __shfl_xor(sk, 1); sk += __shfl_xor(sk, 2);
    const float nq = rsqrtf(sq + EPSN) * 0.125f, nk = rsqrtf(sk + EPSN);
    __syncthreads();
    if (wave == 0) { float v = gcs[lane];
#pragma unroll
      for (int d = 1; d < 64; d <<= 1) { const float y = __shfl(v, lane - d); if (lane >= d) v += y; }
      gcs[lane] = v; }
    __syncthreads();
    const float gc = gcs[tk], glast = gcs[63];
    const float egc = __expf(gc), ekd = __expf(glast - gc);
    if (tid == 0) eg[it] = __expf(glast);
#pragma unroll
    for (int e = 0; e < 16; ++e) {
      const int ch = qq * 16 + e;
      const float qv = val[0][e] * nq, kv = val[1][e] * nk, vv = val[2][e];
      Qs[tk * 72 + ch] = (hf)qv; Ks[tk * 72 + ch] = (hf)kv;
      RHS[tk * 128 + ch] = vv * beta; RHS[tk * 128 + 64 + ch] = kv * beta * egc;
      qg[cbase + tk * 64 + ch] = (hf)(qv * egc);
      kdT[cbase + ch * 64 + tk] = (hf)(kv * ekd);
    }
    __syncthreads();
    {
      f4 akk[4], aqk[4];
#pragma unroll
      for (int nt = 0; nt < 4; ++nt) { akk[nt] = f4{0, 0, 0, 0}; aqk[nt] = f4{0, 0, 0, 0}; }
#pragma unroll
      for (int ks = 0; ks < 2; ++ks) {
        h8 ak = *(const h8*)(Ks + (wave * 16 + cl) * 72 + ks * 32 + q * 8);
        h8 aq = *(const h8*)(Qs + (wave * 16 + cl) * 72 + ks * 32 + q * 8);
#pragma unroll
        for (int nt = 0; nt < 4; ++nt) {
          h8 bk = *(const h8*)(Ks + (nt * 16 + cl) * 72 + ks * 32 + q * 8);
          akk[nt] = mfma16(ak, bk, akk[nt]); aqk[nt] = mfma16(aq, bk, aqk[nt]);
        }
      }
#pragma unroll
      for (int nt = 0; nt < 4; ++nt) {
        const int j = nt * 16 + cl; const float gj = gcs[j];
#pragma unroll
        for (int r = 0; r < 4; ++r) {
          const int i = wave * 16 + q * 4 + r;
          const float dec = (i >= j) ? __expf(gcs[i] - gj) : 0.f;
          Lm[i * 64 + j] = (i > j) ? bts[i] * akk[nt][r] * dec : 0.f;
          intra[cbase + i * 64 + j] = (hf)(aqk[nt][r] * dec);
        }
      }
    }
    __syncthreads();
    if (wave < 2) {
      float xr[64];
#pragma unroll
      for (int i = 0; i < 64; ++i) xr[i] = 0.f;
#pragma unroll
      for (int i = 0; i < 64; ++i) {
        float s0 = 0.f, s1 = 0.f, s2 = 0.f, s3 = 0.f;
#pragma unroll
        for (int j4 = 0; j4 < (i + 3) / 4; ++j4) {
          f4 l4 = *(const f4*)(Lm + i * 64 + j4 * 4);
          s0 += l4[0] * xr[j4 * 4]; s1 += l4[1] * xr[j4 * 4 + 1]; s2 += l4[2] * xr[j4 * 4 + 2]; s3 += l4[3] * xr[j4 * 4 + 3];
        }
        xr[i] = RHS[i * 128 + wave * 64 + lane] - ((s0 + s1) + (s2 + s3));
      }
      if (wave == 0) {
#pragma unroll
        for (int i8 = 0; i8 < 8; ++i8) { h8 o;
#pragma unroll
          for (int e = 0; e < 8; ++e) o[e] = (hf)xr[i8 * 8 + e];
          *(h8*)(uT + cbase + lane * 64 + i8 * 8) = o; }
      } else {
#pragma unroll
        for (int i = 0; i < 64; ++i) wm_[cbase + i * 64 + lane] = (hf)xr[i];
      }
    }
  }
}

constexpr int E1_MAT = 64 * 72;
constexpr int LDS_E1 = 2 * 4 * E1_MAT * 2;
DI void phase_E1(const Params& p, char* smem) {
  const int tid = get_tid(), lane = tid & 63, wave = tid >> 6, q = lane >> 4, cl = lane & 15;
  constexpr size_t MSZ = (size_t)NTOK * 512;
  const hf* uT = (const hf*)p.dscan; const hf* intra = (const hf*)(p.ws + O_INTRA);
  const hf* mats[4] = {uT + MSZ, uT + 2 * MSZ, intra, uT + 3 * MSZ};
  const float* eg = (const float*)(p.ws + O_EG);
  hf* ob = (hf*)(p.ws + O_OB);
  hf* lbuf = (hf*)smem;
  for (int bh = blockIdx.x; bh < BATCH * 8; bh += gridDim.x) {
    const int b = bh / 8, h = bh % 8, e0 = wave * 16;
    f4 S[4];
#pragma unroll
    for (int i = 0; i < 4; ++i) S[i] = f4{0, 0, 0, 0};
    h8 st[8]; h4 un[4];
    {
      const size_t cbase = (size_t)bh * NCHK * 4096;
#pragma unroll
      for (int i = 0; i < 8; ++i) { const int idx = tid + i * 256, m = idx >> 9, r = (idx >> 3) & 63, c8 = idx & 7; st[i] = *(const h8*)(mats[m] + cbase + r * 64 + c8 * 8); }
#pragma unroll
      for (int mt = 0; mt < 4; ++mt) un[mt] = *(const h4*)(uT + cbase + (e0 + cl) * 64 + mt * 16 + q * 4);
      __syncthreads();
#pragma unroll
      for (int i = 0; i < 8; ++i) { const int idx = tid + i * 256, m = idx >> 9, r = (idx >> 3) & 63, c8 = idx & 7; *(h8*)(lbuf + m * E1_MAT + r * 72 + c8 * 8) = st[i]; }
      __syncthreads();
    }
    for (int c = 0; c < NCHK; ++c) {
      const hf* L = lbuf + (c & 1) * 4 * E1_MAT;
      const hf* Lw = L, *Lq = L + E1_MAT, *Li = L + 2 * E1_MAT, *Lk = L + 3 * E1_MAT;
      h4 uc[4];
#pragma unroll
      for (int mt = 0; mt < 4; ++mt) uc[mt] = un[mt];
      if (c + 1 < NCHK) {
        const size_t cb2 = ((size_t)bh * NCHK + c + 1) * 4096;
#pragma unroll
        for (int i = 0; i < 8; ++i) { const int idx = tid + i * 256, m = idx >> 9, r = (idx >> 3) & 63, c8 = idx & 7; st[i] = *(const h8*)(mats[m] + cb2 + r * 64 + c8 * 8); }
#pragma unroll
        for (int mt = 0; mt < 4; ++mt) un[mt] = *(const h4*)(uT + cb2 + (e0 + cl) * 64 + mt * 16 + q * 4);
      }
      const float egl = eg[bh * NCHK + c];
      h8 Sb[2]; Sb[0] = cvt_f4f4(S[0], S[1]); Sb[1] = cvt_f4f4(S[2], S[3]);
      f4 vn[4];
#pragma unroll
      for (int mt = 0; mt < 4; ++mt) {
        f4 a = f4{0, 0, 0, 0};
#pragma unroll
        for (int ks = 0; ks < 2; ++ks) a = mfma16(permload(Lw + (mt * 16 + cl) * 72 + ks * 32, q), Sb[ks], a);
#pragma unroll
        for (int r = 0; r < 4; ++r) vn[mt][r] = (float)uc[mt][r] - a[r];
      }
      h8 Vb[2]; Vb[0] = cvt_f4f4(vn[0], vn[1]); Vb[1] = cvt_f4f4(vn[2], vn[3]);
#pragma unroll
      for (int mt = 0; mt < 4; ++mt) {
        f4 o = f4{0, 0, 0, 0};
#pragma unroll
        for (int ks = 0; ks < 2; ++ks) {
          o = mfma16(permload(Lq + (mt * 16 + cl) * 72 + ks * 32, q), Sb[ks], o);
          o = mfma16(permload(Li + (mt * 16 + cl) * 72 + ks * 32, q), Vb[ks], o);
        }
#pragma unroll
        for (int r = 0; r < 4; ++r) ob[((size_t)b * SEQ + c * 64 + mt * 16 + q * 4 + r) * 512 + h * 64 + e0 + cl] = (hf)o[r];
      }
#pragma unroll
      for (int mt = 0; mt < 4; ++mt) {
        f4 sacc = S[mt] * egl;
#pragma unroll
        for (int ks = 0; ks < 2; ++ks) sacc = mfma16(permload(Lk + (mt * 16 + cl) * 72 + ks * 32, q), Vb[ks], sacc);
        S[mt] = sacc;
      }
      if (c + 1 < NCHK) {
        hf* Ln = lbuf + ((c + 1) & 1) * 4 * E1_MAT;
#pragma unroll
        for (int i = 0; i < 8; ++i) { const int idx = tid + i * 256, m = idx >> 9, r = (idx >> 3) & 63, c8 = idx & 7; *(h8*)(Ln + m * E1_MAT + r * 72 + c8 * 8) = st[i]; }
      }
      __syncthreads();
    }
    drain_stores();
    __syncthreads();
    if (tid == 0) { fence_release_agent(); add_relaxed_agent((unsigned*)(p.ws + O_CNT) + 48, 1u); }
  }
}

DI void obnorm_pass(const Params& p) {
  hf* ob = (hf*)(p.ws + O_OB); const hf* P3 = (const hf*)(p.ws + O_P3);
  const int lane = get_tid() & 63, wave = get_tid() >> 6;
  for (int row = blockIdx.x * 4 + wave; row < NTOK; row += gridDim.x * 4) {
    h8 v = *(const h8*)(ob + (size_t)row * 512 + lane * 8);
    h8 z = *(const h8*)(P3 + (size_t)row * 512 + lane * 8);
    float f[8], ss = 0.f;
#pragma unroll
    for (int e = 0; e < 8; ++e) { f[e] = (float)v[e]; ss += f[e] * f[e]; }
    ss += __shfl_xor(ss, 1); ss += __shfl_xor(ss, 2); ss += __shfl_xor(ss, 4);
    const float rstd = rsqrtf(ss * (1.0f / 64.0f) + EPSN);
    h8 o;
#pragma unroll
    for (int e = 0; e < 8; ++e) o[e] = (hf)(f[e] * rstd * p.norm_b_w[(lane & 7) * 8 + e] * siluf_((float)z[e]));
    *(h8*)(ob + (size_t)row * 512 + lane * 8) = o;
  }
}

constexpr int SELN = TOPK + 64;
constexpr int CAPC = 128;
constexpr int E2_WAVE_LDS = SELN * 4 + SELN * 8 * 4 + 256 * 4 + CAPC * 8;
DI int bin_of(float v, float vmin, float sc) { int bq = (int)((v - vmin) * sc); return bq > 255 ? 255 : (bq < 0 ? 0 : bq); }
DI void attn_token(const Params& p, int b, int t, float* srow, int* sel, float* Sb, hf* Vt1, int lane, bool dry) {
  unsigned* hist = (unsigned*)(Sb + SELN * 8); unsigned* candk = hist + 256; int* candi = (int*)(candk + CAPC);
  hf* P1 = (hf*)(p.ws + O_P1);
#ifndef EMU
  asm volatile("" : "+v"(lane));
#endif
  const int q = lane >> 4, cl = lane & 15;
  const int n = t + 1;
  int cnt;
  for (int rep_ = 0; rep_ < REP_SEL; ++rep_) {
  if (n <= TOPK) {
    cnt = n;
    for (int i = lane; i < SELN; i += 64) sel[i] = (i < n) ? i : 0;
  } else {
    cnt = TOPK;
    float val[SEQ / 64];
    {
      const hf* pb = (const hf*)srow + lane;
#pragma unroll
      for (int jg = 0; jg < SEQ / 64 / 8; ++jg) {
#ifndef EMU
        asm volatile("" : "+v"(pb));
#endif
#pragma unroll
        for (int jj = 0; jj < 8; ++jj) { const int j = jg * 8 + jj; const float v = (float)pb[jj * 64]; val[j] = (j * 64 + lane < n) ? v : -INFINITY; }
        pb += 512;
      }
    }
    float vmin = INFINITY, vmax = -INFINITY;
#pragma unroll
    for (int j = 0; j < SEQ / 64; ++j) { vmax = fmaxf(vmax, val[j]); vmin = fminf(vmin, (j * 64 + lane < n) ? val[j] : INFINITY); }
#pragma unroll
    for (int m = 32; m >= 1; m >>= 1) { vmax = fmaxf(vmax, __shfl_xor(vmax, m)); vmin = fminf(vmin, __shfl_xor(vmin, m)); }
    const float bscale = 255.99f / (vmax - vmin);
    for (int i = lane; i < 256; i += 64) hist[i] = 0u;
    wave_sync();
#pragma unroll
    for (int j = 0; j < SEQ / 64; ++j) { if (j * 64 + lane < n) atomicAdd(&hist[bin_of(val[j], vmin, bscale)], 1u); }
    wave_sync();
    int tb, ca, nc;
    {
      const unsigned h0 = hist[4 * lane], h1 = hist[4 * lane + 1], h2 = hist[4 * lane + 2], h3 = hist[4 * lane + 3];
      const int sL = (int)(h0 + h1 + h2 + h3);
      int tt = sL;
#pragma unroll
      for (int d = 1; d < 64; d <<= 1) { const int y = __shfl(tt, lane + d); if (lane + d < 64) tt += y; }
      const int above = tt - sL;
      const int c3 = above + (int)h3, c2 = c3 + (int)h2, c1 = c2 + (int)h1, c0 = c1 + (int)h0;
      int tb_ = -1, ca_ = 0, nc_ = 0;
      if (above < TOPK && c0 >= TOPK) {
        if (c3 >= TOPK) { tb_ = 4 * lane + 3; ca_ = above; nc_ = (int)h3; }
        else if (c2 >= TOPK) { tb_ = 4 * lane + 2; ca_ = c3; nc_ = (int)h2; }
        else if (c1 >= TOPK) { tb_ = 4 * lane + 1; ca_ = c2; nc_ = (int)h1; }
        else { tb_ = 4 * lane; ca_ = c1; nc_ = (int)h0; }
      }
      const unsigned long long bm = __ballot(tb_ >= 0);
      const int src = bm ? (int)__builtin_ctzll(bm) : 0;
      tb = __shfl(tb_, src); ca = __shfl(ca_, src); nc = __shfl(nc_, src);
      if (bm == 0ull) nc = CAPC + 1;
    }
    const unsigned long long lt = (lane == 0) ? 0ull : (~0ull >> (64 - lane));
    if (nc <= CAPC) {
      int base_gt = 0, base_c = 0;
#pragma unroll
      for (int j = 0; j < SEQ / 64; ++j) {
        const bool valid = j * 64 + lane < n;
        const int bn = valid ? bin_of(val[j], vmin, bscale) : -1;
        const bool mg = bn > tb, me = bn == tb;
        const unsigned long long bg = __ballot(mg), be = __ballot(me);
        if (mg) sel[base_gt + __popcll(bg & lt)] = j * 64 + lane;
        if (me) { const int pos = base_c + __popcll(be & lt); candk[pos] = f2ord(val[j]); candi[pos] = j * 64 + lane; }
        base_gt += __popcll(bg); base_c += __popcll(be);
      }
      wave_sync();
      const int need = TOPK - ca;
      int base = ca;
#pragma unroll
      for (int hb = 0; hb < CAPC / 64; ++hb) {
        const int my = hb * 64 + lane;
        bool pick = false; int myi = 0;
        if (my < nc) {
          const unsigned mk = candk[my]; myi = candi[my];
          int rank = 0;
          for (int c2 = 0; c2 < nc; ++c2) { const unsigned ok = candk[c2]; const int oi = candi[c2]; rank += (ok > mk || (ok == mk && oi < myi)) ? 1 : 0; }
          pick = rank < need;
        }
        const unsigned long long bp = __ballot(pick);
        if (pick) sel[base + __popcll(bp & lt)] = myi;
        base += __popcll(bp);
      }
    } else {
      unsigned T = 0;
      for (int bit = 31; bit >= 0; --bit) {
        const unsigned cand = T | (1u << bit);
        int cl_ = 0;
#pragma unroll
        for (int j = 0; j < SEQ / 64; ++j) cl_ += (f2ord(val[j]) >= cand) ? 1 : 0;
        const int tot = wave_sum_i(cl_);
        if (tot >= TOPK) T = cand;
        if (tot == TOPK) { T = cand - 1u; break; }
      }
      int cgt = 0;
#pragma unroll
      for (int j = 0; j < SEQ / 64; ++j) cgt += (f2ord(val[j]) > T) ? 1 : 0;
      cgt = wave_sum_i(cgt);
      int base_gt = 0, base_eq = cgt;
#pragma unroll
      for (int j = 0; j < SEQ / 64; ++j) {
        const unsigned kj = f2ord(val[j]);
        const bool mg = kj > T, me = kj == T;
        const unsigned long long bg = __ballot(mg), be = __ballot(me);
        if (mg) sel[base_gt + __popcll(bg & lt)] = j * 64 + lane;
        if (me) { int pos = base_eq + __popcll(be & lt); if (pos < TOPK) sel[pos] = j * 64 + lane; }
        base_gt += __popcll(bg); base_eq += __popcll(be);
      }
    }
    sel[TOPK + lane] = 0;
  }
  wave_sync();
  }
  const int ng = (cnt + 63) / 64;
  const size_t trow = (size_t)b * SEQ + t;
  const hf* kvb = P1 + (size_t)b * SEQ * LP1;
  const int k8 = lane >> 3, dch = lane & 7;
  h8 vc[8], vn[8];
#pragma unroll
  for (int j = 0; j < 4; ++j) { const hf* vr = kvb + (size_t)sel[j * 8 + k8] * LP1 + C_VA + dch * 8; vc[j] = *(const h8*)vr; vc[4 + j] = *(const h8*)(vr + 64); }
  hf* P16 = (hf*)Sb;
  hf* Vt = (hf*)Sb + 8 * SELN;
  {
    constexpr int NG = TOPK / 64;
    const h8 z8 = h8{0, 0, 0, 0, 0, 0, 0, 0};
    h8 qb[4];
#pragma unroll
    for (int s = 0; s < 4; ++s) {
      const h8 v = *(const h8*)(P1 + trow * LP1 + C_QA + (cl & 7) * 64 + 32 * (s & 1) + 8 * q);
      qb[s] = (cl < 8 && (cl >> 2) == (s >> 1)) ? v : z8;
    }
    f4 S[NG * 4];
    h8 kc[4][4], kn[4][4];
#pragma unroll
    for (int u = 0; u < 4; ++u) { const hf* kr = kvb + (size_t)sel[u * 16 + cl] * LP1 + C_KA + 8 * q;
#pragma unroll
      for (int s = 0; s < 4; ++s) kc[u][s] = *(const h8*)(kr + 32 * s); }
#pragma unroll
    for (int gg = 0; gg < NG; ++gg) {
      if (gg < ng) {
        if (gg + 1 < NG) {
          const int g2 = (gg + 1 < ng) ? gg + 1 : gg;
#pragma unroll
          for (int u = 0; u < 4; ++u) { const hf* kr = kvb + (size_t)sel[g2 * 64 + u * 16 + cl] * LP1 + C_KA + 8 * q;
#pragma unroll
            for (int s = 0; s < 4; ++s) kn[u][s] = *(const h8*)(kr + 32 * s); }
        }
#pragma unroll
        for (int u = 0; u < 4; ++u) {
          f4 acc = f4{0, 0, 0, 0};
#pragma unroll
          for (int s = 0; s < 4; ++s) acc = mfma16(kc[u][s], qb[s], acc);
#pragma unroll
          for (int r = 0; r < 4; ++r) if (gg * 64 + u * 16 + 4 * q + r >= cnt) acc[r] = -INFINITY;
          S[gg * 4 + u] = acc;
        }
        if (gg + 1 < NG) {
#pragma unroll
          for (int u = 0; u < 4; ++u)
#pragma unroll
            for (int s = 0; s < 4; ++s) kc[u][s] = kn[u][s];
        }
      } else {
#pragma unroll
        for (int u = 0; u < 4; ++u) S[gg * 4 + u] = f4{-INFINITY, -INFINITY, -INFINITY, -INFINITY};
      }
    }
    float mx = -INFINITY;
#pragma unroll
    for (int j = 0; j < NG * 4; ++j)
#pragma unroll
      for (int r = 0; r < 4; ++r) mx = fmaxf(mx, S[j][r]);
    mx = fmaxf(mx, __shfl_xor(mx, 16)); mx = fmaxf(mx, __shfl_xor(mx, 32));
    float sm = 0.f;
#pragma unroll
    for (int j = 0; j < NG * 4; ++j)
#pragma unroll
      for (int r = 0; r < 4; ++r) { const float e = __expf(S[j][r] - mx); S[j][r] = e; sm += e; }
    sm += __shfl_xor(sm, 16); sm += __shfl_xor(sm, 32);
    const float inv = 1.0f / sm;
    if (cl < 8) {
#pragma unroll
      for (int j = 0; j < NG * 4; ++j) if (j < ng * 4) {
        h4 pv; pv[0] = (hf)(S[j][0] * inv); pv[1] = (hf)(S[j][1] * inv); pv[2] = (hf)(S[j][2] * inv); pv[3] = (hf)(S[j][3] * inv);
        *(h4*)(P16 + cl * SELN + j * 16 + 4 * q) = pv;
      }
    }
  }
  wave_sync();
  {
    f4 O[2][4];
#pragma unroll
    for (int g = 0; g < 2; ++g)
#pragma unroll
      for (int nt = 0; nt < 4; ++nt) O[g][nt] = f4{0, 0, 0, 0};
    const int nst = ng * 2;
    for (int st = 0; st < nst; ++st) {
      {
        const int st2 = (st + 1 < nst) ? st + 1 : st;
#pragma unroll
        for (int j = 0; j < 4; ++j) { const hf* vr = kvb + (size_t)sel[st2 * 32 + j * 8 + k8] * LP1 + C_VA + dch * 8; vn[j] = *(const h8*)vr; vn[4 + j] = *(const h8*)(vr + 64); }
      }
      wave_sync();
#pragma unroll
      for (int j = 0; j < 4; ++j) { *(h8*)(Vt + (j * 8 + k8) * 72 + dch * 8) = vc[j]; *(h8*)(Vt1 + (j * 8 + k8) * 72 + dch * 8) = vc[4 + j]; }
      wave_sync();
#pragma unroll
      for (int g = 0; g < 2; ++g) {
        h8 pa;
        if (cl < 4) pa = *(const h8*)(P16 + (g * 4 + cl) * SELN + st * 32 + q * 8); else pa = h8{0, 0, 0, 0, 0, 0, 0, 0};
        const hf* vt = g ? Vt1 : Vt;
#pragma unroll
        for (int nt = 0; nt < 4; ++nt) {
          const hf* tp = vt + (q * 8 + (cl >> 2)) * 72 + nt * 16 + (cl & 3) * 4;
          const h4 lo = lds_read_tr16(tp), hi = lds_read_tr16(tp + 4 * 72);
          O[g][nt] = mfma16(pa, cat44(lo, hi), O[g][nt]);
        }
      }
#pragma unroll
      for (int j = 0; j < 8; ++j) vc[j] = vn[j];
    }
    if (q == 0) {
#pragma unroll
      for (int g = 0; g < 2; ++g)
#pragma unroll
        for (int nt = 0; nt < 4; ++nt)
#pragma unroll
          for (int r = 0; r < 4; ++r) {
            hf* dst = dry ? ((hf*)srow + (g * 4 + r) * 64 + nt * 16 + cl) : (P1 + trow * LP1 + C_QA + (g * 4 + r) * 64 + nt * 16 + cl);
            *dst = (hf)O[g][nt][r];
          }
    }
  }
  wave_sync();
}

DI void phase_E2(const Params& p, char* smem, bool dry) {
  const hf* P1 = (const hf*)(p.ws + O_P1); const float* aux = (const float*)(p.ws + O_AUX);
  int* cnt = (int*)(p.ws + O_CNT) + (dry ? 1 : 0);
  const int tid = get_tid(), lane = tid & 63, wave = tid >> 6;
  float* scr = (float*)(p.ws + O_SCR) + (size_t)blockIdx.x * QBT * SEQ;
  int* item_s = (int*)smem;
  char* wl = smem + 16 + wave * E2_WAVE_LDS;
  int* sel = (int*)wl; float* Sb = (float*)(wl + SELN * 4);
  constexpr int NQB = SEQ / QBT;
#ifdef EMU
  const int xq = (int)blockIdx.x % BATCH;
#else
  const int xq = (int)(xcd_words(smem)[2] % (unsigned)BATCH);
#endif
  int dq = 0;
  for (;;) {
    __syncthreads();
    const int bq = (xq + dq) % BATCH;
    if (tid == 0) item_s[0] = atomicAdd(cnt + 2 * bq, 1);
    __syncthreads();
    const int item = item_s[0];
    if (item >= NQB) { if (++dq >= BATCH) break; continue; }
    const int b = bq, qb = NQB - 1 - item;
    int lane_i = lane;
#ifndef EMU
    asm volatile("" : "+v"(lane_i));
#endif
    const int q = lane_i >> 4, cl = lane_i & 15;
    const int tw0 = qb * QBT + wave * 4;
    h8 aq[4][2]; h8 wA01, wA23;
    {
      f4 wv[4];
#pragma unroll
      for (int i = 0; i < 4; ++i) {
        const size_t row = (size_t)b * SEQ + tw0 + i;
        const hf* qp = P1 + row * LP1 + C_QI + cl * 64 + q * 8;
        aq[i][0] = *(const h8*)qp; aq[i][1] = *(const h8*)(qp + 32);
        wv[i] = *(const f4*)(aux + row * 32 + q * 4);
      }
      const f4 z4 = f4{0, 0, 0, 0};
      wA01 = cvt_f4f4(cl == 0 ? wv[0] : z4, cl == 4 ? wv[1] : z4);
      wA23 = cvt_f4f4(cl == 8 ? wv[2] : z4, cl == 12 ? wv[3] : z4);
    }
    const int ngrp = (tw0 + 3) / 64 + 1;
    const int ngrp_blk = (qb * QBT + QBT - 1) / 64 + 1;
    hf* kst = (hf*)(smem + 16 + 4 * E2_WAVE_LDS);
    const int tid_s = get_tid();
    const int skey = tid_s >> 3, sch = tid_s & 7;
    const hf* ksrc = P1 + ((size_t)b * SEQ + skey) * LP1 + C_KI + sch * 8;
    hf* scr_q = (hf*)(scr + (size_t)(wave * 4 + q) * SEQ) + cl;
    h8 sr0 = *(const h8*)ksrc, sr1 = *(const h8*)(ksrc + (size_t)32 * LP1);
    *(h8*)(kst + skey * 72 + sch * 8) = sr0; *(h8*)(kst + (skey + 32) * 72 + sch * 8) = sr1;
    { const int g1 = ngrp_blk > 1 ? 1 : 0; sr0 = *(const h8*)(ksrc + (size_t)(g1 * 64) * LP1); sr1 = *(const h8*)(ksrc + (size_t)(g1 * 64 + 32) * LP1); }
    h8 sq0, sq1;
    { const int g2 = ngrp_blk > 2 ? 2 : ngrp_blk - 1; sq0 = *(const h8*)(ksrc + (size_t)(g2 * 64) * LP1); sq1 = *(const h8*)(ksrc + (size_t)(g2 * 64 + 32) * LP1); }
    __syncthreads();
    for (int grp = 0; grp < ngrp_blk; ++grp) {
      const hf* ks = kst + (grp & 1) * (64 * 72);
      if (grp < ngrp) {
#pragma unroll
        for (int u = 0; u < 4; ++u) {
          const h8 b0 = *(const h8*)(ks + (u * 16 + cl) * 72 + q * 8), b1 = *(const h8*)(ks + (u * 16 + cl) * 72 + 32 + q * 8);
          f4 c4[4];
#pragma unroll
          for (int i = 0; i < 4; ++i) { f4 t4 = f4{0, 0, 0, 0}; t4 = mfma16(aq[i][0], b0, t4); t4 = mfma16(aq[i][1], b1, t4); c4[i] = t4; }
          f4 sc = f4{0, 0, 0, 0}; sc = mfma16(wA01, relu8(cvt_f4f4(c4[0], c4[1])), sc); sc = mfma16(wA23, relu8(cvt_f4f4(c4[2], c4[3])), sc);
          scr_q[grp * 64 + u * 16] = (hf)sc[0];
        }
      }
      if (grp + 1 < ngrp_blk) {
        hf* kn = kst + ((grp + 1) & 1) * (64 * 72);
        *(h8*)(kn + skey * 72 + sch * 8) = sr0; *(h8*)(kn + (skey + 32) * 72 + sch * 8) = sr1;
        sr0 = sq0; sr1 = sq1;
        const int g3 = (grp + 3 < ngrp_blk) ? grp + 3 : ngrp_blk - 1;
        sq0 = *(const h8*)(ksrc + (size_t)(g3 * 64) * LP1); sq1 = *(const h8*)(ksrc + (size_t)(g3 * 64 + 32) * LP1);
      }
      __syncthreads();
    }
    gmem_wave_sync();
#pragma unroll 1
    for (int i = 0; i < 4; ++i) attn_token(p, b, tw0 + i, scr + (size_t)(wave * 4 + i) * SEQ, sel, Sb, kst + wave * (32 * 72), lane, dry);
  }
  if (!dry) {
    unsigned* e1done = (unsigned*)(p.ws + O_CNT) + 48;
    if (get_tid() == 0) {
      unsigned spins = 0;
      while (ld_relaxed_agent(e1done) < (unsigned)(BATCH * 8)) { spin_pause(); if (++spins > (1u << 26)) break; }
      fence_acquire_agent();
    }
    __syncthreads();
    obnorm_pass(p);
  }
}

DI void phase_F1(const Params& p, char* smem) {
  const hf* P1 = (const hf*)(p.ws + O_P1); const hf* ob = (const hf*)(p.ws + O_OB); const hf* P4 = (const hf*)(p.ws + O_P4);
  const hf* WpaT = (const hf*)(p.ws + O_WPA); const hf* WpbT = (const hf*)(p.ws + O_WPB);
  hf* merged = (hf*)(p.ws + O_MERGED);
  const int lane = get_tid() & 63, wave = get_tid() >> 6, wm = wave >> 1, wn = wave & 1, q = lane >> 4, cl = lane & 15;
  constexpr int NTN = DM / 128, NTM = NTOK / 128;
  TileSched ts = tile_begin(NTM, NTN, p.ws + O_BAR, xcd_words(smem)); int tm, tn;
  while (tile_next(ts, tm, tn)) {
    const int m0 = tm * 128, n0 = tn * 128;
    f4 a1[4][4], a2[4][4]; zero_acc<4>(a1); zero_acc<4>(a2);
    gemm_mainloop<128, 64>(a1, P1 + C_QA, LP1, WpaT, 512, 512, m0, n0, smem);
    gemm_mainloop<128, 64>(a2, ob, 512, WpbT, 512, 512, m0, n0, smem);
    hf* t1 = (hf*)smem; hf* t2 = t1 + 128 * TLD;
    __syncthreads();
#pragma unroll
    for (int mt = 0; mt < 4; ++mt)
#pragma unroll
      for (int nt = 0; nt < 4; ++nt)
#pragma unroll
        for (int r = 0; r < 4; ++r) {
          const int lrow = wm * 64 + mt * 16 + q * 4 + r, lcol = wn * 64 + nt * 16 + cl;
          t1[lrow * TLD + lcol] = (hf)a1[mt][nt][r]; t2[lrow * TLD + lcol] = (hf)a2[mt][nt][r];
        }
    __syncthreads();
    {
      const int tid = get_tid();
#pragma unroll
      for (int i = 0; i < 8; ++i) {
        const int idx = tid + i * 256, row = idx >> 4, ch = idx & 15;
        const size_t grow = (size_t)(m0 + row);
        const h8 v1 = *(const h8*)(t1 + row * TLD + ch * 8), v2 = *(const h8*)(t2 + row * TLD + ch * 8);
        const h8 sa = *(const h8*)(P4 + grow * LP4 + n0 + ch * 8), sb = *(const h8*)(P4 + grow * LP4 + DM + n0 + ch * 8);
        h8 o;
#pragma unroll
        for (int e = 0; e < 8; ++e) o[e] = (hf)((float)sa[e] * (float)v1[e] + (float)sb[e] * (float)v2[e]);
        *(h8*)(merged + pr32_off((int)grow, n0 + ch * 8, DM)) = o;
      }
    }
  }
}
DI void phase_F2(const Params& p, char* smem) {
  const hf* merged = (const hf*)(p.ws + O_MERGED); const hf* WoT = (const hf*)(p.ws + O_WO); const float* mod = (const float*)(p.ws + O_MOD);
  const int lane = get_tid() & 63, wave = get_tid() >> 6, wm = wave >> 1, wn = wave & 1, q = lane >> 4, cl = lane & 15;
  constexpr int CBM = 256, CMT = CBM / 32, NTN = DM / 128, NTM = NTOK / CBM;
  TileSched ts = tile_begin(NTM, NTN, p.ws + O_BAR, xcd_words(smem)); int tm, tn;
  while (tile_next(ts, tm, tn)) {
    const int m0 = tm * CBM, n0 = tn * 128;
    f4 acc[CMT][4]; zero_acc<CMT>(acc);
    gemm_mainloop_2set<CBM, false>(acc, merged, WoT, DM, m0, n0, smem);
    hf* t1 = (hf*)smem;
    __syncthreads();
#pragma unroll
    for (int mt = 0; mt < CMT; ++mt)
#pragma unroll
      for (int nt = 0; nt < 4; ++nt)
#pragma unroll
        for (int r = 0; r < 4; ++r) t1[(wm * (CBM / 2) + mt * 16 + q * 4 + r) * TLD + wn * 64 + nt * 16 + cl] = (hf)acc[mt][nt][r];
    __syncthreads();
    {
      const int tid = get_tid();
#pragma unroll
      for (int i = 0; i < CBM / 16; ++i) {
        const int idx = tid + i * 256, row = idx >> 4, ch = idx & 15;
        const size_t grow = (size_t)(m0 + row); const int b = (int)(grow / SEQ), col = n0 + ch * 8;
        const h8 y = *(const h8*)(t1 + row * TLD + ch * 8);
        const float* xp = p.x + grow * DM + col; const float* gp = mod + (size_t)b * 6 * DM + 2 * DM + col; hf* op = (hf*)(p.ws + O_H16) + grow * DM + col;
        const f4 x0 = *(const f4*)xp, x1 = *(const f4*)(xp + 4), g0 = *(const f4*)gp, g1 = *(const f4*)(gp + 4);
        h8 o;
#pragma unroll
        for (int e = 0; e < 4; ++e) { o[e] = (hf)(x0[e] + g0[e] * (float)y[e]); o[4 + e] = (hf)(x1[e] + g1[e] * (float)y[4 + e]); }
        *(h8*)op = o;
      }
    }
  }
}
DI float quant_row_store(const float (&v)[DM / 64], unsigned char* dst, int lane, int bias) {
  float mx = 0.f;
#pragma unroll
  for (int i = 0; i < DM / 64; ++i) mx = fmaxf(mx, fabsf(v[i]));
#pragma unroll
  for (int m = 32; m >= 1; m >>= 1) mx = fmaxf(mx, __shfl_xor(mx, m));
  const float sc = mx > 0.f ? mx * (1.0f / 127.0f) : 1.0f, inv = 1.0f / sc;
#pragma unroll
  for (int i = 0; i < DM / 256; ++i) {
    unsigned w = 0;
#pragma unroll
    for (int j = 0; j < 4; ++j) { int qv = (int)rintf(v[4 * i + j] * inv); qv = qv > 127 ? 127 : (qv < -127 ? -127 : qv); w |= ((unsigned)(qv + bias) & 255u) << (8 * j); }
    *(unsigned*)(dst + i * 256 + lane * 4) = w;
  }
  return sc;
}
template <int MODE> DI void quant4_row_store(const float (&v)[DM / 64], unsigned char* dst, int lane, float& sc_o, float& mn_o) {
  float mx = v[0], mn = v[0];
#pragma unroll
  for (int i = 1; i < DM / 64; ++i) { mx = fmaxf(mx, v[i]); mn = fminf(mn, v[i]); }
#pragma unroll
  for (int m = 32; m >= 1; m >>= 1) { mx = fmaxf(mx, __shfl_xor(mx, m)); mn = fminf(mn, __shfl_xor(mn, m)); }
  {
    float s1 = 0.f, s2 = 0.f;
#pragma unroll
    for (int i = 0; i < DM / 64; ++i) { s1 += v[i]; s2 += v[i] * v[i]; }
    s1 = wave_sum(s1); s2 = wave_sum(s2);
    const float mean = s1 * (1.0f / DM), sd = sqrtf(fmaxf(s2 * (1.0f / DM) - mean * mean, 0.f));
    mn = fmaxf(mn, mean - 2.514f * sd); mx = fminf(mx, mean + 2.514f * sd);
  }
  const float sc = mx > mn ? (mx - mn) * (1.0f / 15.0f) : 1.0f, inv = 1.0f / sc;
#pragma unroll
  for (int i = 0; i < DM / 256; ++i) {
    unsigned nq = 0;
#pragma unroll
    for (int j = 0; j < 4; ++j) { int qv = (int)rintf((v[4 * i + j] - mn) * inv); qv = qv > 15 ? 15 : (qv < 0 ? 0 : qv);
      if (MODE == 0) nq |= (unsigned)qv << (8 * j);
      else { const int t = 4 * (lane & 1) + j; nq |= (unsigned)qv << (4 * ((t & 1) * 4 + (t >> 1))); } }
    const unsigned pn = __shfl_xor(nq, 1);
    if ((lane & 1) == 0) *(unsigned*)(dst + (i * 32 + (lane >> 1)) * 4) = (MODE == 0) ? (nq | (pn << 4)) : (nq | pn);
  }
  sc_o = sc; mn_o = mn;
}
DI void phase_F3(const Params& p) {
  const int tid = get_tid(), lane = tid & 63, wave = tid >> 6;
  const float* mod = (const float*)(p.ws + O_MOD);
  unsigned char* u8 = (unsigned char*)(p.uv + UV_U8); unsigned char* v8 = (unsigned char*)(p.uv + UV_V8); unsigned char* n2q = (unsigned char*)(p.uv + UV_N2Q);
  float* su = (float*)(p.uv + UV_SU); float* sv = (float*)(p.uv + UV_SV); float* sn = (float*)(p.uv + UV_SN);
  for (int row = blockIdx.x * 4 + wave; row < NTOK + 2 * NEXP; row += gridDim.x * 4) {
    float v[DM / 64];
    if (row < NTOK) {
      const hf* xr = (const hf*)(p.ws + O_H16) + (size_t)row * DM; const int b = row / SEQ; float ss = 0.f;
#pragma unroll
      for (int i = 0; i < DM / 256; ++i) { const h4 t4 = *(const h4*)(xr + i * 256 + lane * 4); f4 t = {(float)t4[0], (float)t4[1], (float)t4[2], (float)t4[3]}; v[4 * i] = t[0]; v[4 * i + 1] = t[1]; v[4 * i + 2] = t[2]; v[4 * i + 3] = t[3]; ss += t[0] * t[0] + t[1] * t[1] + t[2] * t[2] + t[3] * t[3]; }
      ss = wave_sum(ss);
      const float rstd = rsqrtf(ss * (1.0f / DM) + EPSN);
      const float* mb = mod + (size_t)b * 6 * DM;
#pragma unroll
      for (int i = 0; i < DM / 256; ++i) {
        const int d = i * 256 + lane * 4;
#pragma unroll
        for (int j = 0; j < 4; ++j) v[4 * i + j] = v[4 * i + j] * rstd * (1.0f + mb[4 * DM + d + j]) + mb[3 * DM + d + j];
      }
      const float sc = quant_row_store(v, n2q + (size_t)row * DM, lane, 0);
      if (lane == 0) sn[row] = sc;
    } else {
      const bool isu = row < NTOK + NEXP; const int e = isu ? row - NTOK : row - NTOK - NEXP;
      const float* xr = (isu ? p.pu : p.pv) + (size_t)e * DM;
#pragma unroll
      for (int i = 0; i < DM / 256; ++i) { f4 t = *(const f4*)(xr + i * 256 + lane * 4); v[4 * i] = t[0]; v[4 * i + 1] = t[1]; v[4 * i + 2] = t[2]; v[4 * i + 3] = t[3]; }
      float sc, mn;
      if (isu) { quant4_row_store<0>(v, u8 + (size_t)e * (DM / 2), lane, sc, mn); if (lane == 0) { su[2 * e] = sc; su[2 * e + 1] = mn; } }
      else { quant4_row_store<1>(v, v8 + (size_t)e * (DM / 2), lane, sc, mn); if (lane == 0) { sv[2 * e] = sc; sv[2 * e + 1] = mn; } }
    }
  }
}
DI void cmpx_desc(unsigned& hi, unsigned& lo) { const unsigned x = hi, y = lo; hi = x > y ? x : y; lo = x > y ? y : x; }
DI void bitonic_merge16(unsigned (&v)[16]) {
#pragma unroll
  for (int j = 8; j > 0; j >>= 1)
#pragma unroll
    for (int i = 0; i < 16; ++i) { const int l = i ^ j; if (l > i) cmpx_desc(v[i], v[l]); }
}
DI void bitonic_sort16(unsigned (&v)[16]) {
#pragma unroll
  for (int k = 2; k <= 16; k <<= 1)
#pragma unroll
    for (int j = k >> 1; j > 0; j >>= 1)
#pragma unroll
      for (int i = 0; i < 16; ++i) { const int l = i ^ j; if (l > i) { if ((i & k) == 0) cmpx_desc(v[i], v[l]); else cmpx_desc(v[l], v[i]); } }
}
DI void phase_G1(const Params& p, char* smem) {
  const hf* subk = (const hf*)(p.ws + O_SUBK);
  int* experts = (int*)(p.ws + O_P4); float* gates = (float*)(p.ws + O_P4 + (size_t)NTOK * 128 * 4);
  const float* sn_ = (const float*)(p.uv + UV_SN); const float* sq8 = (const float*)(p.ws + O_SQ8);
  const int tid = get_tid(), lane = tid & 63, wave = tid >> 6, wm = wave >> 1, wn = wave & 1, q = lane >> 4, cl = lane & 15;
  constexpr int NTM = NTOK / 128;
  hf* qt = (hf*)smem;
  float* sb = (float*)smem;
  unsigned* tl = (unsigned*)(smem + 2 * 64 * 129 * 4);
  TileSched ts = tile_begin(NTM, 8, p.ws + O_BAR, xcd_words(smem)); int tm, tn;
  while (tile_next(ts, tm, tn)) {
    const int hh = tn, mbase = tm * 128, n0 = hh * 128;
    f4 acc[4][4]; zero_acc<4>(acc);
    gemm_mainloop_r3<128, true>(acc, (const hf*)(p.uv + UV_N2Q), DM / 2, (const hf*)(p.ws + O_WQ8), DM / 2, DM / 2, mbase, n0, smem);
    for (int half = 0; half < 2; ++half) {
    const int m0 = mbase + half * 64;
    __syncthreads();
    if (wm == half) {
#pragma unroll
      for (int mt = 0; mt < 4; ++mt)
#pragma unroll
        for (int nt = 0; nt < 4; ++nt)
#pragma unroll
          for (int r = 0; r < 4; ++r) { const int row = mt * 16 + q * 4 + r, col = wn * 64 + nt * 16 + cl; const i4 ai = __builtin_bit_cast(i4, acc[mt][nt]);
            qt[row * 136 + col] = (hf)((float)ai[r] * (sn_[m0 + row] * sq8[n0 + col])); }
    }
    __syncthreads();
    const int pp = wave & 1, mh = wave >> 1;
    h8 af[2][2];
#pragma unroll
    for (int mt = 0; mt < 2; ++mt)
#pragma unroll
      for (int ks = 0; ks < 2; ++ks) af[mt][ks] = *(const h8*)(qt + (mh * 32 + mt * 16 + cl) * 136 + pp * 64 + ks * 32 + q * 8);
    __syncthreads();
    const hf* skp = subk + (size_t)(hh * 2 + pp) * 128 * 64;
#pragma unroll
    for (int nt = 0; nt < 8; ++nt) {
      h8 b0 = *(const h8*)(skp + (nt * 16 + cl) * 64 + q * 8), b1 = *(const h8*)(skp + (nt * 16 + cl) * 64 + 32 + q * 8);
#pragma unroll
      for (int mt = 0; mt < 2; ++mt) {
        f4 s = f4{0, 0, 0, 0};
        s = mfma16(af[mt][0], b0, s); s = mfma16(af[mt][1], b1, s);
#pragma unroll
        for (int r = 0; r < 4; ++r) sb[(pp * 64 + mh * 32 + mt * 16 + q * 4 + r) * 129 + nt * 16 + cl] = s[r];
      }
    }
    __syncthreads();
    {
      const int rp = tid >> 1, sub = tid & 1;
      const float* sr = sb + rp * 129 + sub * 64;
      unsigned top[16];
#pragma unroll
      for (int g = 0; g < 4; ++g) {
        unsigned v[16];
#pragma unroll
        for (int i = 0; i < 16; ++i) { const int n = sub * 64 + g * 16 + i; v[i] = (f2ord(sr[g * 16 + i]) & ~127u) | (unsigned)(127 - n); }
        bitonic_sort16(v);
        if (g == 0) {
#pragma unroll
          for (int i = 0; i < 16; ++i) top[i] = v[i];
        } else {
#pragma unroll
          for (int i = 0; i < 16; ++i) top[i] = top[i] > v[15 - i] ? top[i] : v[15 - i];
          bitonic_merge16(top);
        }
      }
      unsigned oth[16];
#pragma unroll
      for (int i = 0; i < 16; ++i) oth[i] = __shfl_xor(top[i], 1);
#pragma unroll
      for (int i = 0; i < 16; ++i) top[i] = top[i] > oth[15 - i] ? top[i] : oth[15 - i];
      bitonic_merge16(top);
      if (sub == 0) {
#pragma unroll
        for (int i = 0; i < 16; ++i) tl[rp * 16 + i] = top[i];
      }
    }
    __syncthreads();
    {
      const int tid2 = get_tid();
      const int rp = tid2 >> 2, sub = tid2 & 3;
      constexpr unsigned long long PT0 = 0x7060504030201000ull;
      constexpr unsigned long long PT1 = 0xf0e0d0c0b0a09080ull;
      constexpr unsigned long long PT2 = 0x7161514131211101ull;
      constexpr unsigned long long PT3 = 0x2313034232221202ull;
      constexpr unsigned long long PT4 = 0x1606150524140433ull;
      constexpr unsigned long long PT5 = 0x0d0c0b0a09081707ull;
      constexpr unsigned long long PT6 = 0xffffffffffff0f0eull;
      constexpr unsigned long long PT7 = 0xffffffffffffffffull;
      const unsigned long long wlo = sub == 0 ? PT0 : sub == 1 ? PT2 : sub == 2 ? PT4 : PT6;
      const unsigned long long whi = sub == 0 ? PT1 : sub == 1 ? PT3 : sub == 2 ? PT5 : PT7;
      const unsigned* t1 = tl + rp * 16; const unsigned* t2 = tl + (64 + rp) * 16;
      unsigned top[16];
#pragma unroll
      for (int s = 0; s < 16; ++s) {
        const unsigned e = (unsigned)(((s < 8 ? wlo : whi) >> (8 * (s & 7))) & 255ull);
        const int i = e & 15, j = (e >> 4) & 15;
        const float v = ord2f(t1[i] & ~127u) + ord2f(t2[j] & ~127u);
        top[s] = (e == 255u) ? 0u : ((f2ord(v) & ~255u) | (unsigned)(255 - (i * 16 + j)));
      }
      bitonic_sort16(top);
#pragma unroll
      for (int x = 1; x <= 2; x <<= 1) {
        unsigned oth[16];
#pragma unroll
        for (int i = 0; i < 16; ++i) oth[i] = __shfl_xor(top[i], x);
#pragma unroll
        for (int i = 0; i < 16; ++i) top[i] = top[i] > oth[15 - i] ? top[i] : oth[15 - i];
        bitonic_merge16(top);
      }
      float vals[16], sm = 0.f;
#pragma unroll
      for (int s = 0; s < 16; ++s) vals[s] = ord2f(top[s] & ~255u);
      const float mx = vals[0];
#pragma unroll
      for (int s = 0; s < 16; ++s) { vals[s] = __expf(vals[s] - mx); sm += vals[s]; }
      const float inv = 1.0f / sm;
      i4 eo; f4 go;
#pragma unroll
      for (int t = 0; t < 4; ++t) {
        const unsigned k = sub == 0 ? top[t] : sub == 1 ? top[4 + t] : sub == 2 ? top[8 + t] : top[12 + t];
        const float g = sub == 0 ? vals[t] : sub == 1 ? vals[4 + t] : sub == 2 ? vals[8 + t] : vals[12 + t];
        const int ci = 255 - (int)(k & 255u);
        const int e1 = 127 - (int)(t1[ci >> 4] & 127u), e2 = 127 - (int)(t2[ci & 15] & 127u);
        eo[t] = e1 * 128 + e2; go[t] = g * inv;
      }
      const size_t ob_ = ((size_t)(m0 + rp) * 8 + hh) * 16 + sub * 4;
      *(i4*)(experts + ob_) = eo; *(f4*)(gates + ob_) = go;
    }
  }
  }
}
#ifdef EMU
DI h2 pkfma(h2 a, h2 b, h2 c) { return a * b + c; }
#else
DI h2 pkfma(h2 a, h2 b, h2 c) { return __builtin_elementwise_fma(a, b, c); }
#endif
constexpr int VPL = DM / 64;
constexpr int G2_WAVE_LDS = 128 * 8 + 128 * 4;
DI void phase_G2(const Params& p, char* smem, bool dry) {
  const unsigned char* u8 = (const unsigned char*)(p.uv + UV_U8); const unsigned char* v8 = (const unsigned char*)(p.uv + UV_V8); const unsigned char* n2q = (const unsigned char*)(p.uv + UV_N2Q);
  const float* su = (const float*)(p.uv + UV_SU); const float* sv = (const float*)(p.uv + UV_SV); const float* sn = (const float*)(p.uv + UV_SN);
  const int* experts = (const int*)(p.ws + O_P4); const float* gates = (const float*)(p.ws + O_P4 + (size_t)NTOK * 128 * 4);
  const float* mod = (const float*)(p.ws + O_MOD);
  const int tid = get_tid(), lane = tid & 63, wave = tid >> 6, half = lane >> 5, li = lane & 31;
  char* wl = smem + wave * G2_WAVE_LDS;
  unsigned* coef2 = (unsigned*)wl; int* eix = (int*)(wl + 1024);
  constexpr int DW = VPL / 4;
  const int tok0 = blockIdx.x * 4 + wave;
  int e0n = 0, e1n = 0; float sntn = 0.f; int xqn[2 * DW];
  { const int tc = tok0 < NTOK ? tok0 : NTOK - 1;
    e0n = experts[(size_t)tc * 128 + lane]; e1n = experts[(size_t)tc * 128 + 64 + lane]; sntn = sn[tc];
#pragma unroll
    for (int w = 0; w < 2 * DW; ++w) xqn[w] = ((const int*)(n2q + (size_t)tc * DM + li * (8 * DW)))[w]; }
  for (int tok = tok0; tok < NTOK; tok += gridDim.x * 4) {
    const int b = tok / SEQ;
    wave_sync();
    eix[lane] = e0n; eix[64 + lane] = e1n;
    const float snt = sntn;
    int xq[2 * DW];
#pragma unroll
    for (int w = 0; w < 2 * DW; ++w) xq[w] = xqn[w];
    int sxq = 0;
#pragma unroll
    for (int w = 0; w < 2 * DW; ++w) sxq = __builtin_amdgcn_sdot4(xq[w], 0x01010101, sxq, false);
#pragma unroll
    for (int m = 16; m >= 1; m >>= 1) sxq += __shfl_xor(sxq, m);
    const float fsx = (float)sxq;
    wave_sync();
    float cmn = 0.f;
    for (int eb = 0; eb < 2; ++eb) {
      int part[32];
      const int em = eb * 64 + lane; const int eim = eix[em];
      const float su_e = su[2 * eim], mu_e = su[2 * eim + 1], sv_e = sv[2 * eim], mv_e = sv[2 * eim + 1], g_e = gates[(size_t)tok * 128 + em];
#pragma unroll
      for (int e = 0; e < 32; ++e) {
        const unsigned* ur = (const unsigned*)(u8 + (size_t)eix[eb * 64 + half * 32 + e] * (DM / 2) + li * (4 * DW));
        int acc = 0;
#pragma unroll
        for (int k = 0; k < DW; ++k) { const unsigned w = ur[k];
          acc = __builtin_amdgcn_sdot4((int)(w & 0x0F0F0F0Fu), xq[2 * k], acc, false);
          acc = __builtin_amdgcn_sdot4((int)((w >> 4) & 0x0F0F0F0Fu), xq[2 * k + 1], acc, false); }
        part[e] = acc;
      }
      const bool b4 = (lane & 16) != 0, b3 = (lane & 8) != 0, b2 = (lane & 4) != 0, b1 = (lane & 2) != 0, b0 = (lane & 1) != 0;
      int r16[16], r8[8], r4[4], r2[2];
#pragma unroll
      for (int i = 0; i < 16; ++i) { const int snd = b4 ? part[i] : part[16 + i], kp = b4 ? part[16 + i] : part[i]; r16[i] = kp + __shfl_xor(snd, 16); }
#pragma unroll
      for (int i = 0; i < 8; ++i) { const int snd = b3 ? r16[i] : r16[8 + i], kp = b3 ? r16[8 + i] : r16[i]; r8[i] = kp + __shfl_xor(snd, 8); }
#pragma unroll
      for (int i = 0; i < 4; ++i) { const int snd = b2 ? r8[i] : r8[4 + i], kp = b2 ? r8[4 + i] : r8[i]; r4[i] = kp + __shfl_xor(snd, 4); }
#pragma unroll
      for (int i = 0; i < 2; ++i) { const int snd = b1 ? r4[i] : r4[2 + i], kp = b1 ? r4[2 + i] : r4[i]; r2[i] = kp + __shfl_xor(snd, 2); }
      const int r1 = (b0 ? r2[1] : r2[0]) + __shfl_xor(b0 ? r2[0] : r2[1], 1);
      { const float av = ((float)r1 * su_e + fsx * mu_e) * snt;
        const float cr = 0.5f * av * (1.0f + erff(av * 0.70710678118654752f)) * g_e, cs = cr * sv_e;
        cmn += cr * mv_e;
        const hf ca = (hf)(cs * 16384.0f), cb = (hf)(cs * 1024.0f);
        h2 pa = {ca, ca}, pb = {cb, cb};
        coef2[2 * em] = __builtin_bit_cast(unsigned, pa); coef2[2 * em + 1] = __builtin_bit_cast(unsigned, pb); }
    }
    wave_sync();
    { const int tn = tok + gridDim.x * 4; const int tc = tn < NTOK ? tn : NTOK - 1;
      e0n = experts[(size_t)tc * 128 + lane]; e1n = experts[(size_t)tc * 128 + 64 + lane]; sntn = sn[tc];
#pragma unroll
      for (int w = 0; w < 2 * DW; ++w) xqn[w] = ((const int*)(n2q + (size_t)tc * DM + li * (8 * DW)))[w]; }
    const int dbase = li * (8 * DW) + half * (4 * DW);
    float hres[VPL], mg[VPL];
#pragma unroll
    for (int i = 0; i < VPL; ++i) { hres[i] = (float)((const hf*)(p.ws + O_H16))[(size_t)tok * DM + dbase + i]; mg[i] = mod[(size_t)b * 6 * DM + 5 * DM + dbase + i]; }
    cmn = wave_sum(cmn);
    h2 ya[4 * DW];
#pragma unroll
    for (int i = 0; i < 4 * DW; ++i) ya[i] = (h2){(hf)0.f, (hf)0.f};
#pragma unroll 8
    for (int e = 0; e < 64; ++e) {
      const int row = 2 * e + half;
      const unsigned* vr = (const unsigned*)(v8 + (size_t)eix[row] * (DM / 2) + li * (4 * DW));
      const h2 ca = __builtin_bit_cast(h2, coef2[2 * row]), cb = __builtin_bit_cast(h2, coef2[2 * row + 1]);
#pragma unroll
      for (int k = 0; k < DW; ++k) { const unsigned w = vr[k], w8 = w >> 8;
        ya[4 * k + 0] = pkfma(__builtin_bit_cast(h2, w & 0x000F000Fu), ca, ya[4 * k + 0]);
        ya[4 * k + 1] = pkfma(__builtin_bit_cast(h2, w & 0x00F000F0u), cb, ya[4 * k + 1]);
        ya[4 * k + 2] = pkfma(__builtin_bit_cast(h2, w8 & 0x000F000Fu), ca, ya[4 * k + 2]);
        ya[4 * k + 3] = pkfma(__builtin_bit_cast(h2, w8 & 0x00F000F0u), cb, ya[4 * k + 3]); }
    }
    float y[VPL];
#pragma unroll
    for (int i = 0; i < 2 * DW; ++i) {
      const unsigned snd = __builtin_bit_cast(unsigned, half ? ya[i] : ya[2 * DW + i]);
      const h2 oth = __builtin_bit_cast(h2, (unsigned)__shfl_xor((int)snd, 32));
      const h2 mine = half ? ya[2 * DW + i] : ya[i];
      y[2 * i] = ((float)mine[0] + (float)oth[0]) * 1024.0f + cmn; y[2 * i + 1] = ((float)mine[1] + (float)oth[1]) * 1024.0f + cmn;
    }
    float hv[VPL]; float ss = 0.f;
#pragma unroll
    for (int i = 0; i < VPL; ++i) { const float v = hres[i] + mg[i] * y[i]; hv[i] = v; ss += v * v; }
    ss = wave_sum(ss);
    const float rstd = rsqrtf(ss * (1.0f / DM) + EPSN);
#pragma unroll
    for (int i = 0; i < VPL; ++i) { const int d = dbase + i; const float o = hv[i] * rstd * p.fnw[d];
      if (dry) ((hf*)(p.ws + O_MERGED))[(size_t)tok * DM + d] = (hf)o; else p.out[(size_t)tok * DM + d] = o; }
  }
}

constexpr int cmax(int a, int b) { return a > b ? a : b; }
constexpr int LDS_GEMM = cmax(cmax((128 + 128) * (GBK_MAX + 8) * 2, 2 * 128 * TLD * 2), 256 * TLD * 2);
constexpr int LDS_A = cmax(64 * 65 * 4, (BATCH * DM + 4 * BATCH * 64) * 4);
constexpr int LDS_D1 = 2 * 64 * 72 * 2 + 64 * 128 * 4 + 64 * 64 * 4 + 512;
constexpr int LDS_E2 = 16 + 4 * E2_WAVE_LDS + 2 * 64 * 72 * 2;
constexpr int LDS_G1 = 2 * 64 * 129 * 4 + 2 * 64 * 16 * 4;
constexpr int LDS_G2 = 4 * G2_WAVE_LDS;
constexpr int SMEM_BYTES = cmax(cmax(cmax(LDS_GEMM, LDS_A), cmax(LDS_D1, LDS_E2)), cmax(cmax(LDS_G1, LDS_G2), LDS_E1));
constexpr int NPHASE = 11;
DI const volatile unsigned* xcd_words(char* smem) { return (const volatile unsigned*)(smem + SMEM_BYTES); }

DI void run_phase(const Params& p, int ph, char* smem, bool dry) {
  switch (ph) {
    case 0: phase_A(p, smem); break;
    case 1: phase_B(p); break;
    case 2: phase_C(p, smem); break;
    case 3: phase_D1(p, smem); break;
    case 4: if (!dry) phase_E1(p, smem); phase_E2(p, smem, dry); break;
    case 5: break;
    case 6: phase_F1(p, smem); break;
    case 7: phase_F2(p, smem); break;
    case 8: phase_F3(p); break;
    case 9: phase_G1(p, smem); break;
    case 10: phase_G2(p, smem, dry); break;
  }
}

#ifdef EMU
static void emu_kernel_all(void* arg) {
  const Params& p = *(const Params*)arg; char* smem = emu_cur->blk->smem;
  for (int ph = 0; ph < NPHASE; ++ph) { run_phase(p, ph, smem, false); emu_grid_sync(); }
}
#else
template <int PH> __global__ void __launch_bounds__(256, 2) phase_kernel(Params p) {
  __shared__ __attribute__((aligned(16))) char smem[SMEM_BYTES + 16];
  run_phase(p, PH, smem, false);
}
#if !MULTI_LAUNCH
#ifndef PROBE_DUP
#define PROBE_DUP 0
#endif
__global__ void __launch_bounds__(256, 2) mega_kernel(Params p) {
  __shared__ __attribute__((aligned(16))) char smem[SMEM_BYTES + 16];
  cooperative_groups::grid_group grid = cooperative_groups::this_grid();
  volatile LAS unsigned* st = (volatile LAS unsigned*)(smem + SMEM_BYTES);
  g_wtab[hw_wave_key()] = (unsigned char)(threadIdx.x >> 6);
  if (threadIdx.x == 0) { st[0] = 0u; st[1] = 0u; }
  __syncthreads();
  if (PROBE_DUP & 1) run_phase(p, 0, smem, false);
  run_phase(p, 0, smem, false);
  grid.sync();
  XcdBarrier xb = xcd_barrier_post((unsigned*)(p.ws + O_BAR), st);
#define XBAR() { xcd_barrier(xb); if (PROBE_BAR2) xcd_barrier(xb); }
#define PH(k) { if (PROBE_DUP & (1 << (k))) { run_phase(p, (k), smem, true); xcd_barrier(xb); } run_phase(p, (k), smem, false); }
  PH(1); XBAR(); PH(2); XBAR(); PH(3); XBAR(); PH(4); XBAR();
  PH(6); XBAR(); PH(7); XBAR(); PH(8); XBAR(); PH(9); XBAR(); PH(10);
#undef PH
}
#endif
#endif

extern "C" void kernel_launch(void* const* d_in, const int* in_sizes, int n_in, void* d_out, int out_size, void* d_ws, size_t ws_size, hipStream_t stream) {
  Params p{};
  p.x = (const float*)d_in[0]; p.c = (const float*)d_in[1]; p.pos = (const int*)d_in[2]; p.w_ada = (const float*)d_in[3]; p.b_ada = (const float*)d_in[4];
  p.w_in = (const float*)d_in[5]; p.conv_w = (const float*)d_in[6]; p.a_log = (const float*)d_in[7]; p.dt_bias = (const float*)d_in[8]; p.norm_b_w = (const float*)d_in[9];
  p.w_pa = (const float*)d_in[10]; p.w_pb = (const float*)d_in[11]; p.w_o = (const float*)d_in[12]; p.wq = (const float*)d_in[13]; p.subk = (const float*)d_in[14];
  p.pu = (const float*)d_in[15]; p.pv = (const float*)d_in[16]; p.fnw = (const float*)d_in[17];
  p.out = (float*)d_out; p.ws = (char*)d_ws;
#ifdef EMU
  const int grid = 4;
  p.dscan = p.ws + WS_TOTAL; p.uv = p.ws + WS_TOTAL + DSCAN_BYTES;
  if (WS_TOTAL + DSCAN_BYTES + UV_BYTES > ws_size) { fprintf(stderr, "ws too small\n"); exit(2); }
  if (O_SCR + (size_t)grid * QBT * SEQ * 4 > O_OB) { fprintf(stderr, "scratch overflow\n"); exit(2); }
  fprintf(stderr, "emu: SMEM_BYTES=%d WS_TOTAL=%zu\n", SMEM_BYTES, WS_TOTAL);
  emu_launch(emu_kernel_all, &p, grid, 256, SMEM_BYTES);
#else
  static_assert((size_t)NTOK * DM * 4 >= DSCAN_BYTES, "d_out too small for scan scratch");
  static_assert(UV_BYTES <= (size_t)NTOK * LP1 * 2, "P1 too small for expert tables");
  p.dscan = (char*)d_out; p.uv = p.ws + O_P1;
  static int grid = 0;
  if (!grid) {
    int dev = 0, cus = 0, per_cu = 0;
    hipGetDevice(&dev); hipDeviceGetAttribute(&cus, hipDeviceAttributeMultiprocessorCount, dev);
#if MULTI_LAUNCH
    hipOccupancyMaxActiveBlocksPerMultiprocessor(&per_cu, phase_kernel<5>, 256, 0);
#else
    hipOccupancyMaxActiveBlocksPerMultiprocessor(&per_cu, mega_kernel, 256, 0);
#endif
    if (per_cu > 2) per_cu = 2;
    if (per_cu < 1) per_cu = 1;
    grid = cus * per_cu;
    if (grid > 512) grid = 512;
  }
  if (WS_TOTAL > ws_size) { fprintf(stderr, "workspace too small: need %zu have %zu\n", WS_TOTAL, ws_size); return; }
#if MULTI_LAUNCH
  hipLaunchKernelGGL(phase_kernel<0>, dim3(grid), dim3(256), 0, stream, p);
  hipLaunchKernelGGL(phase_kernel<1>, dim3(grid), dim3(256), 0, stream, p);
  hipLaunchKernelGGL(phase_kernel<2>, dim3(grid), dim3(256), 0, stream, p);
  hipLaunchKernelGGL(phase_kernel<3>, dim3(grid), dim3(256), 0, stream, p);
  hipLaunchKernelGGL(phase_kernel<4>, dim3(grid), dim3(256), 0, stream, p);
  hipLaunchKernelGGL(phase_kernel<5>, dim3(grid), dim3(256), 0, stream, p);
  hipLaunchKernelGGL(phase_kernel<6>, dim3(grid), dim3(256), 0, stream, p);
  hipLaunchKernelGGL(phase_kernel<7>, dim3(grid), dim3(256), 0, stream, p);
  hipLaunchKernelGGL(phase_kernel<8>, dim3(grid), dim3(256), 0, stream, p);
  hipLaunchKernelGGL(phase_kernel<9>, dim3(grid), dim3(256), 0, stream, p);
  hipLaunchKernelGGL(phase_kernel<10>, dim3(grid), dim3(256), 0, stream, p);
#else
  void* args[] = {&p};
  hipError_t e = hipLaunchCooperativeKernel((void*)mega_kernel, dim3(grid), dim3(256), args, 0, stream);
  if (e != hipSuccess) fprintf(stderr, "cooperative launch failed: %s (grid %d)\n", hipGetErrorString(e), grid);
#endif
#endif
}
```

```cpp
#ifdef EMU
#include "hip_emu.h"
#else
#include <hip/hip_runtime.h>
#include <hip/hip_cooperative_groups.h>
#include <cstdio>
#include <cstdint>
#endif

#ifndef PROBE_BAR2
#define PROBE_BAR2 0
#endif
#ifndef REP_CEPI
#define REP_CEPI 1
#endif
#ifndef REP_CMAIN
#define REP_CMAIN 1
#endif
#ifndef REP_IDX
#define REP_IDX 1
#endif
#ifndef REP_SEL
#define REP_SEL 1
#endif
#ifndef REP_QK
#define REP_QK 1
#endif
#ifndef REP_PV
#define REP_PV 1
#endif
#ifndef MULTI_LAUNCH
#define MULTI_LAUNCH 0
#endif

#ifdef EMU
#ifndef EMU_B
#define EMU_B 2
#endif
#ifndef EMU_S
#define EMU_S 512
#endif
#ifndef EMU_D
#define EMU_D 256
#endif
constexpr int BATCH = EMU_B, SEQ = EMU_S, DM = EMU_D;
#else
constexpr int BATCH = 8, SEQ = 4096, DM = 1024;
#endif
constexpr int NTOK = BATCH * SEQ;
constexpr int TOPK = (SEQ / 4 < 256) ? SEQ / 4 : 256;
constexpr int NCHK = SEQ / 64;
constexpr int NEXP = 16384;
constexpr int C_QA = 0, C_KA = 512, C_VA = 640, C_QI = 768, C_KI = 1792, C_WI = 1856, C_BB = 1872, C_AB = 1880;
constexpr int C_QB = 1920, C_ZB = 3456, C_GA = 3968;
constexpr int NP = 3968 + 2 * DM;
constexpr int IN_W = 3936 + 2 * DM;
constexpr int LP1 = 1920, LP2 = 1536, LP3 = 512, LP4 = 2 * DM;
constexpr int QBT = 16;
constexpr float EPSN = 1e-6f;

typedef _Float16 hf;
typedef _Float16 h8 __attribute__((ext_vector_type(8)));
typedef _Float16 h4 __attribute__((ext_vector_type(4)));
typedef _Float16 h2 __attribute__((ext_vector_type(2)));
typedef float f4 __attribute__((ext_vector_type(4)));
typedef int i4 __attribute__((ext_vector_type(4)));
#define DI __device__ __forceinline__

constexpr size_t al256(size_t x) { return (x + 255) & ~size_t(255); }
constexpr size_t O_MOD = 0;
constexpr size_t O_CNT = O_MOD + al256((size_t)BATCH * 6 * DM * 4);
constexpr size_t O_BAR = O_CNT + 256;
constexpr size_t O_CS = O_BAR + 16384;
constexpr size_t O_AUX = O_CS + al256((size_t)NTOK * 16 * 4);
constexpr size_t O_WIN = O_AUX + al256((size_t)NTOK * 32 * 4);
constexpr size_t O_WPA = O_WIN + al256((size_t)NP * DM * 2);
constexpr size_t O_WPB = O_WPA + al256((size_t)DM * 512 * 2);
constexpr size_t O_WO = O_WPB + al256((size_t)DM * 512 * 2);
constexpr size_t O_WQ = O_WO + al256((size_t)DM * DM * 2);
constexpr size_t O_SUBK = O_WQ + al256((size_t)1024 * DM * 2);
constexpr size_t O_EG = O_SUBK + al256((size_t)8 * 2 * 128 * 64 * 2);
constexpr size_t O_P1 = O_EG + al256((size_t)BATCH * 8 * NCHK * 4);
constexpr size_t O_P3 = O_P1 + al256((size_t)NTOK * LP1 * 2);
constexpr size_t O_P4 = O_P3 + al256((size_t)NTOK * LP3 * 2);
constexpr size_t R_BYTES = ((size_t)NTOK * DM * 2 > (size_t)NTOK * 1024) ? (size_t)NTOK * DM * 2 : (size_t)NTOK * 1024;
constexpr size_t O_R = O_P4 + al256((size_t)NTOK * LP4 * 2);
constexpr size_t O_P2 = O_R + al256(R_BYTES);
constexpr size_t O_OB = O_P2 + al256((size_t)NTOK * LP2 * 2);
constexpr size_t O_W8 = O_OB + al256((size_t)NTOK * 512 * 2);
constexpr size_t O_SB8 = O_W8 + al256((size_t)NP * DM);
constexpr size_t O_WQ8 = O_SB8 + al256((size_t)NP * 4);
constexpr size_t O_SQ8 = O_WQ8 + al256((size_t)1024 * DM);
constexpr size_t WS_TOTAL = O_SQ8 + al256((size_t)1024 * 4);
constexpr size_t O_INTRA = O_R;
constexpr size_t O_SCR = O_R + (size_t)NTOK * 1024;
constexpr size_t O_MERGED = O_R;
constexpr size_t O_N2H = O_R + (size_t)NTOK * DM * 2;
constexpr size_t O_H16 = O_P2;
static_assert((size_t)NTOK * DM * 2 <= (size_t)NTOK * LP2 * 2, "P2 too small for h");
constexpr size_t DSCAN_BYTES = (size_t)NTOK * 4096;
constexpr size_t UV_U8 = 0, UV_V8 = (size_t)NEXP * DM, UV_N2Q = (size_t)2 * NEXP * DM, UV_SU = UV_N2Q + (size_t)NTOK * DM, UV_SV = UV_SU + (size_t)NEXP * 8, UV_SN = UV_SV + (size_t)NEXP * 8;
constexpr size_t UV_BYTES = UV_SN + (size_t)NTOK * 4;

struct Params {
  const float *x, *c; const int* pos;
  const float *w_ada, *b_ada, *w_in, *conv_w, *a_log, *dt_bias, *norm_b_w, *w_pa, *w_pb, *w_o, *wq, *subk, *pu, *pv, *fnw;
  float* out; char* ws; char* dscan; char* uv;
};

#ifdef EMU
DI int get_tid() { return (int)threadIdx.x; }
#else
#if MULTI_LAUNCH
DI int get_tid() { int t = threadIdx.x; asm volatile("" : "+v"(t)); return t; }
#else
__shared__ unsigned char g_wtab[64];
DI int hw_wave_key() { return (int)(__builtin_amdgcn_s_getreg(0x2804) & 63u); }
DI int get_tid() {
  const int w = __builtin_amdgcn_readfirstlane((int)g_wtab[hw_wave_key()]);
  int l;
  asm volatile("v_mbcnt_lo_u32_b32 %0, -1, 0\n\tv_mbcnt_hi_u32_b32 %0, -1, %0" : "=v"(l));
  return (w << 6) | l;
}
#endif
#endif
DI f4 mfma16(h8 a, h8 b, f4 c) { return __builtin_amdgcn_mfma_f32_16x16x32_f16(a, b, c, 0, 0, 0); }
DI f4 mfma16_i8(h8 a, h8 b, f4 c) { return __builtin_bit_cast(f4, __builtin_amdgcn_mfma_i32_16x16x64_i8(__builtin_bit_cast(i4, a), __builtin_bit_cast(i4, b), __builtin_bit_cast(i4, c), 0, 0, 0)); }
#ifdef EMU
DI void wave_sync() { int z = 0, r; emu_collective(&z, 4, &r, 4, [](EmuWave*) {}); }
DI void gmem_wave_sync() { wave_sync(); }
#else
DI void wave_sync() { __builtin_amdgcn_fence(__ATOMIC_RELEASE, "wavefront"); __builtin_amdgcn_wave_barrier(); __builtin_amdgcn_fence(__ATOMIC_ACQUIRE, "wavefront"); }
DI void gmem_wave_sync() { __builtin_amdgcn_fence(__ATOMIC_SEQ_CST, "workgroup"); __builtin_amdgcn_wave_barrier(); }
#endif
#ifdef EMU
DI unsigned ld_relaxed_agent(unsigned* p) { return *(volatile unsigned*)p; }
DI void add_relaxed_agent(unsigned* p, unsigned v) { *p += v; }
DI void fence_release_agent() {}
DI void fence_acquire_agent() {}
DI void drain_stores() {}
DI void spin_pause() { emu_yield(); }
#else
DI unsigned ld_relaxed_agent(unsigned* p) { return __hip_atomic_load(p, __ATOMIC_RELAXED, __HIP_MEMORY_SCOPE_AGENT); }
DI void add_relaxed_agent(unsigned* p, unsigned v) { (void)__hip_atomic_fetch_add(p, v, __ATOMIC_RELAXED, __HIP_MEMORY_SCOPE_AGENT); }
DI void fence_release_agent() { __builtin_amdgcn_fence(__ATOMIC_RELEASE, "agent"); asm volatile("s_waitcnt vmcnt(0)" ::: "memory"); }
DI void fence_acquire_agent() { __builtin_amdgcn_fence(__ATOMIC_ACQUIRE, "agent"); asm volatile("s_waitcnt vmcnt(0)" ::: "memory"); }
DI void drain_stores() { asm volatile("s_waitcnt vmcnt(0)" ::: "memory"); }
DI void spin_pause() { __builtin_amdgcn_s_sleep(8); }
#endif
DI float wave_sum(float v) { for (int m = 32; m >= 1; m >>= 1) v += __shfl_xor(v, m); return v; }
DI int wave_sum_i(int v) { for (int m = 32; m >= 1; m >>= 1) v += __shfl_xor(v, m); return v; }
DI float sigmoidf_(float x) { return 1.0f / (1.0f + __expf(-x)); }
DI float siluf_(float x) { return x / (1.0f + __expf(-x)); }
DI float softplusf_(float x) { return x > 20.f ? x : log1pf(__expf(x)); }
DI unsigned f2ord(float f) { unsigned u = __builtin_bit_cast(unsigned, f); return (u & 0x80000000u) ? ~u : (u | 0x80000000u); }
DI float ord2f(unsigned k) { unsigned u = (k & 0x80000000u) ? (k & 0x7fffffffu) : ~k; return __builtin_bit_cast(float, u); }
DI h8 cat44(h4 a, h4 b) { h8 r; r[0] = a[0]; r[1] = a[1]; r[2] = a[2]; r[3] = a[3]; r[4] = b[0]; r[5] = b[1]; r[6] = b[2]; r[7] = b[3]; return r; }
DI h8 cvt_f4f4(f4 a, f4 b) { h8 r; r[0] = (hf)a[0]; r[1] = (hf)a[1]; r[2] = (hf)a[2]; r[3] = (hf)a[3]; r[4] = (hf)b[0]; r[5] = (hf)b[1]; r[6] = (hf)b[2]; r[7] = (hf)b[3]; return r; }
#ifdef EMU
DI h4 lds_read_tr16(const hf* p) {
  h4 r; const hf* pp = p;
  emu_collective(&pp, sizeof(pp), &r, sizeof(r), [&](EmuWave* w) {
    for (int l = 0; l < 64; ++l) { const int gb = l & ~15, i = l & 15; h4 o;
      for (int qq = 0; qq < 4; ++qq) { const hf* src; memcpy(&src, w->in[gb + 4 * qq + (i >> 2)], sizeof(src)); o[qq] = src[i & 3]; }
      memcpy(w->out[l], &o, sizeof(o)); }
  });
  return r;
}
#else
typedef short s4v __attribute__((ext_vector_type(4)));
DI h4 lds_read_tr16(const hf* p) {
  const s4v v = __builtin_amdgcn_ds_read_tr16_b64_v4i16((__attribute__((address_space(3))) s4v*)p);
  return __builtin_bit_cast(h4, v);
}
#endif
DI h8 relu8(h8 v) { const h8 z = h8{0, 0, 0, 0, 0, 0, 0, 0}; return __builtin_elementwise_max(v, z); }
DI h8 permload(const hf* p, int q) { return cat44(*(const h4*)(p + 4 * q), *(const h4*)(p + 16 + 4 * q)); }


#ifndef EMU
#define XB_TMO      128
#define XB_XCNT(j)  (256  + 64 * (j))
#define XB_XSUB(j)  (1280 + 64 * (j))
#define XB_XGEN(j)  (2304 + 64 * (j))
#define XB_TOP      3328
#define XB_TOPGEN   3392
#define XCD_BAR_WORDS 3456
#define XB_SPIN_CAP (1u << 22)
#define LAS __attribute__((address_space(3)))
DI unsigned xb_ld(unsigned* p) { return __hip_atomic_load(p, __ATOMIC_RELAXED, __HIP_MEMORY_SCOPE_AGENT); }
DI unsigned xb_add(unsigned* p, unsigned v) { return __hip_atomic_fetch_add(p, v, __ATOMIC_RELAXED, __HIP_MEMORY_SCOPE_AGENT); }
DI unsigned xb_xcc_id() { return (unsigned)__builtin_amdgcn_s_getreg((3 << 11) | 20) & 0xFu; }
#define XB_SPIN(cond, bar) do { unsigned _sp = 0; while (cond) { __builtin_amdgcn_s_sleep(1); \
    if ((++_sp & 255u) == 0u) { if (xb_ld(&(bar)[XB_TMO])) break; if (_sp > XB_SPIN_CAP) { atomicAdd(&(bar)[XB_TMO], 1u); break; } } } } while (0)
struct XcdBarrier { unsigned* bar; unsigned x; volatile LAS unsigned* st; };
DI XcdBarrier xcd_barrier_post(unsigned* bar, volatile LAS unsigned* st) {
  XcdBarrier b; b.bar = bar; b.x = xb_xcc_id(); b.st = st;
  if (threadIdx.x == 0) { const unsigned li = xb_add(&bar[XB_XCNT(b.x)], 1u); st[2] = b.x; st[3] = li; }
  return b;
}
DI void xcd_barrier_complete(unsigned* bar, unsigned x, unsigned& nloc, unsigned& nx) {
  const unsigned G = gridDim.x * gridDim.y * gridDim.z;
  unsigned sum, cnt, mine, sp = 0u;
  for (;;) {
    sum = 0u; cnt = 0u; mine = 0u;
#pragma unroll
    for (unsigned j = 0; j < 16; ++j) { const unsigned c = xb_ld(&bar[XB_XCNT(j)]); sum += c; cnt += (c > 0u) ? 1u : 0u; mine = (j == x) ? c : mine; }
    if (sum == G) break;
    __builtin_amdgcn_s_sleep(1);
    if ((++sp & 255u) == 0u) { if (xb_ld(&bar[XB_TMO])) break; if (sp > XB_SPIN_CAP) { atomicAdd(&bar[XB_TMO], 1u); break; } }
  }
  nloc = mine > 0u ? mine : 1u; nx = cnt > 0u ? cnt : 1u;
}
DI void xcd_barrier(const XcdBarrier& b) {
  asm volatile("s_waitcnt vmcnt(0)" ::: "memory");
  __syncthreads();
  if (threadIdx.x == 0) {
    unsigned* bar = b.bar;
    __builtin_amdgcn_s_waitcnt(0);
    unsigned nloc = b.st[0], nx = b.st[1];
    if (nloc == 0u) { xcd_barrier_complete(bar, b.x, nloc, nx); b.st[0] = nloc; b.st[1] = nx; }
    const unsigned old = xb_add(&bar[XB_XSUB(b.x)], 1u);
    const unsigned gen = old / nloc;
    if (old + 1u == (gen + 1u) * nloc) {
      __builtin_amdgcn_fence(__ATOMIC_RELEASE, "agent");
      asm volatile("s_waitcnt vmcnt(0)" ::: "memory");
      const unsigned og = xb_add(&bar[XB_TOP], 1u);
      const unsigned tg = og / nx;
      if (og + 1u == (tg + 1u) * nx) xb_add(&bar[XB_TOPGEN], 1u);
      else XB_SPIN(xb_ld(&bar[XB_TOPGEN]) == tg, bar);
      __builtin_amdgcn_fence(__ATOMIC_ACQUIRE, "agent");
      xb_add(&bar[XB_XGEN(b.x)], 1u);
      asm volatile("s_waitcnt vmcnt(0)" ::: "memory");
    } else {
      XB_SPIN(xb_ld(&bar[XB_XGEN(b.x)]) == gen, bar);
      __builtin_amdgcn_fence(__ATOMIC_ACQUIRE, "agent");
      asm volatile("s_waitcnt vmcnt(0)" ::: "memory");
    }
  }
  __syncthreads();
}
#endif

DI size_t pr32_off(int row, int k, int K) { return ((size_t)(row >> 1) * (K / 32) + (k >> 5)) * 64 + (row & 1) * 32 + (k & 31); }

constexpr int GBK_MAX = 128;
template <int BM, int GBK = 128, bool PR = false, bool I8 = false>
DI void gemm_mainloop(f4 (&acc)[BM / 32][4], const hf* __restrict__ A, int lda, const hf* __restrict__ Bt, int ldb, int K, int m0, int n0, char* smem, int krot = 0) {
  constexpr int GLD = GBK + 8, MT = BM / 32, CPR = GBK / 8, ACH = BM * CPR / 256, BCH = 128 * CPR / 256;
  hf* sA = (hf*)smem; hf* sB = sA + BM * GLD;
  const int tid = get_tid(), lane = tid & 63, wave = tid >> 6, wm = wave >> 1, wn = wave & 1;
  h8 ra[ACH], rb[BCH];
#pragma unroll
  for (int i = 0; i < ACH; ++i) { int idx = tid + i * 256, r = idx / CPR, c = idx % CPR; ra[i] = *(const h8*)(PR ? (A + pr32_off(m0 + r, c * 8, K)) : (A + (size_t)(m0 + r) * lda + krot + c * 8)); }
#pragma unroll
  for (int i = 0; i < BCH; ++i) { int idx = tid + i * 256, r = idx / CPR, c = idx % CPR; rb[i] = *(const h8*)(PR ? (Bt + pr32_off(n0 + r, c * 8, K)) : (Bt + (size_t)(n0 + r) * ldb + krot + c * 8)); }
  for (int k0 = 0; k0 < K; k0 += GBK) {
    __syncthreads();
#pragma unroll
    for (int i = 0; i < ACH; ++i) { int idx = tid + i * 256, r = idx / CPR, c = idx % CPR; *(h8*)(sA + r * GLD + c * 8) = ra[i]; }
#pragma unroll
    for (int i = 0; i < BCH; ++i) { int idx = tid + i * 256, r = idx / CPR, c = idx % CPR; *(h8*)(sB + r * GLD + c * 8) = rb[i]; }
    __syncthreads();
    if (k0 + GBK < K) {
      int kn = k0 + GBK + krot; kn = kn >= K ? kn - K : kn;
#pragma unroll
      for (int i = 0; i < ACH; ++i) { int idx = tid + i * 256, r = idx / CPR, c = idx % CPR; ra[i] = *(const h8*)(PR ? (A + pr32_off(m0 + r, kn + c * 8, K)) : (A + (size_t)(m0 + r) * lda + kn + c * 8)); }
#pragma unroll
      for (int i = 0; i < BCH; ++i) { int idx = tid + i * 256, r = idx / CPR, c = idx % CPR; rb[i] = *(const h8*)(PR ? (Bt + pr32_off(n0 + r, kn + c * 8, K)) : (Bt + (size_t)(n0 + r) * ldb + kn + c * 8)); }
    }
#pragma unroll
    for (int ks = 0; ks < GBK / 32; ++ks) {
      h8 af[MT], bf[4];
#pragma unroll
      for (int mt = 0; mt < MT; ++mt) af[mt] = *(const h8*)(sA + (wm * (BM / 2) + mt * 16 + (lane & 15)) * GLD + ks * 32 + (lane >> 4) * 8);
#pragma unroll
      for (int nt = 0; nt < 4; ++nt) bf[nt] = *(const h8*)(sB + (wn * 64 + nt * 16 + (lane & 15)) * GLD + ks * 32 + (lane >> 4) * 8);
#pragma unroll
      for (int mt = 0; mt < MT; ++mt)
#pragma unroll
        for (int nt = 0; nt < 4; ++nt) acc[mt][nt] = I8 ? mfma16_i8(af[mt], bf[nt], acc[mt][nt]) : mfma16(af[mt], bf[nt], acc[mt][nt]);
    }
  }
}
template <int BM, bool I8>
DI void gemm_mainloop_2set(f4 (&acc)[BM / 32][4], const hf* __restrict__ A, const hf* __restrict__ Bt, int K, int m0, int n0, char* smem) {
  constexpr int GBK = 32, GLD = GBK + 8, MT = BM / 32, CPR = GBK / 8, ACH = BM * CPR / 256, BCH = 128 * CPR / 256;
  hf* sA = (hf*)smem; hf* sB = sA + BM * GLD;
  const int tid = get_tid(), lane = tid & 63, wave = tid >> 6, wm = wave >> 1, wn = wave & 1;
  h8 ra[ACH], ra2[ACH], rb[BCH];
  const unsigned voff = (unsigned)(((tid >> 3) * (K / 32)) * 64 + ((tid >> 2) & 1) * 32 + (tid & 3) * 8) * 2u;
#ifndef EMU
  m0 = __builtin_amdgcn_readfirstlane(m0); n0 = __builtin_amdgcn_readfirstlane(n0);
#endif
  const char* Ab = (const char*)(A + (size_t)(m0 >> 1) * (K / 32) * 64);
  const char* Bb = (const char*)(Bt + (size_t)(n0 >> 1) * (K / 32) * 64);
  const size_t chunk_b = (size_t)32 * (K / 32) * 64 * 2;
#ifdef EMU
#define G2LDA(RA, kk) { _Pragma("unroll") for (int i = 0; i < ACH; ++i) RA[i] = *(const h8*)(Ab + i * chunk_b + (size_t)((kk) >> 5) * 128 + voff); }
#define G2LDB(kk) { _Pragma("unroll") for (int i = 0; i < BCH; ++i) rb[i] = *(const h8*)(Bb + i * chunk_b + (size_t)((kk) >> 5) * 128 + voff); }
#else
  const __amdgpu_buffer_rsrc_t rsA = __builtin_amdgcn_make_buffer_rsrc((void*)Ab, 0, 0x7fffffff, 0x00020000);
  const __amdgpu_buffer_rsrc_t rsB = __builtin_amdgcn_make_buffer_rsrc((void*)Bb, 0, 0x7fffffff, 0x00020000);
#define G2LDA(RA, kk) { _Pragma("unroll") for (int i = 0; i < ACH; ++i) RA[i] = __builtin_bit_cast(h8, __builtin_amdgcn_raw_buffer_load_b128(rsA, (int)voff, (int)(i * chunk_b) + ((kk) >> 5) * 128, 0)); }
#define G2LDB(kk) { _Pragma("unroll") for (int i = 0; i < BCH; ++i) rb[i] = __builtin_bit_cast(h8, __builtin_amdgcn_raw_buffer_load_b128(rsB, (int)voff, (int)(i * chunk_b) + ((kk) >> 5) * 128, 0)); }
#endif
#define G2STEP(RA, kb_next, ka_next, LDB_, LDA_) { __syncthreads(); \
    _Pragma("unroll") for (int i = 0; i < ACH; ++i) { const int idx = tid + i * 256, r = idx / CPR, c = idx % CPR; *(h8*)(sA + r * GLD + c * 8) = RA[i]; } \
    _Pragma("unroll") for (int i = 0; i < BCH; ++i) { const int idx = tid + i * 256, r = idx / CPR, c = idx % CPR; *(h8*)(sB + r * GLD + c * 8) = rb[i]; } \
    __syncthreads(); \
    if (LDB_) G2LDB(kb_next) \
    if (LDA_) G2LDA(RA, ka_next) \
    { h8 bf[4]; \
      _Pragma("unroll") for (int nt = 0; nt < 4; ++nt) bf[nt] = *(const h8*)(sB + (wn * 64 + nt * 16 + (lane & 15)) * GLD + (lane >> 4) * 8); \
      _Pragma("unroll") for (int mh = 0; mh < MT / 4; ++mh) { h8 af[4]; \
        _Pragma("unroll") for (int mt = 0; mt < 4; ++mt) af[mt] = *(const h8*)(sA + (wm * (BM / 2) + (mh * 4 + mt) * 16 + (lane & 15)) * GLD + (lane >> 4) * 8); \
        _Pragma("unroll") for (int mt = 0; mt < 4; ++mt) _Pragma("unroll") for (int nt = 0; nt < 4; ++nt) acc[mh * 4 + mt][nt] = I8 ? mfma16_i8(af[mt], bf[nt], acc[mh * 4 + mt][nt]) : mfma16(af[mt], bf[nt], acc[mh * 4 + mt][nt]); } } }
  G2LDB(0) G2LDA(ra, 0) G2LDA(ra2, GBK)
  for (int k0 = 0; k0 < K - 2 * GBK; k0 += 2 * GBK) {
    G2STEP(ra, k0 + GBK, k0 + 2 * GBK, true, true)
    G2STEP(ra2, k0 + 2 * GBK, k0 + 3 * GBK, true, true)
  }
  G2STEP(ra, K - GBK, 0, true, false)
  G2STEP(ra2, 0, 0, false, false)
#undef G2LDA
#undef G2LDB
#undef G2STEP
}
template <int BM, bool I8 = false>
DI void gemm_mainloop_r3(f4 (&acc)[BM / 32][4], const hf* __restrict__ A, int lda, const hf* __restrict__ Bt, int ldb, int K, int m0, int n0, char* smem) {
  constexpr int GLD = 72, MT = BM / 32, ACH = BM * 8 / 256;
  hf* sA = (hf*)smem; hf* sB = sA + BM * GLD;
  const int tid = get_tid(), lane = tid & 63, wave = tid >> 6, wm = wave >> 1, wn = wave & 1;
  const int nk = K / 64;
  h8 a0[ACH], b0[4], a1[ACH], b1[4], a2[ACH], b2[4];
  const hf* Ap = A + (size_t)(m0 + (tid >> 3)) * lda + (tid & 7) * 8;
  const hf* Bp = Bt + (size_t)(n0 + (tid >> 3)) * ldb + (tid & 7) * 8;
#define GL(ra, rb, kt) { const int kk_ = ((kt) < nk ? (kt) : nk - 1) * 64; \
    _Pragma("unroll") for (int i = 0; i < ACH; ++i) ra[i] = *(const h8*)(Ap + (size_t)(i * 32) * lda + kk_); \
    _Pragma("unroll") for (int i = 0; i < 4; ++i) rb[i] = *(const h8*)(Bp + (size_t)(i * 32) * ldb + kk_); }
#define GSTEP(ra, rb, knext) { __syncthreads(); \
    _Pragma("unroll") for (int i = 0; i < ACH; ++i) *(h8*)(sA + ((tid >> 3) + i * 32) * GLD + (tid & 7) * 8) = ra[i]; \
    _Pragma("unroll") for (int i = 0; i < 4; ++i) *(h8*)(sB + ((tid >> 3) + i * 32) * GLD + (tid & 7) * 8) = rb[i]; \
    __syncthreads(); \
    GL(ra, rb, knext) \
    _Pragma("unroll") for (int ks = 0; ks < 2; ++ks) { h8 af[MT], bf[4]; \
      _Pragma("unroll") for (int mt = 0; mt < MT; ++mt) af[mt] = *(const h8*)(sA + (wm * (BM / 2) + mt * 16 + (lane & 15)) * GLD + ks * 32 + (lane >> 4) * 8); \
      _Pragma("unroll") for (int nt = 0; nt < 4; ++nt) bf[nt] = *(const h8*)(sB + (wn * 64 + nt * 16 + (lane & 15)) * GLD + ks * 32 + (lane >> 4) * 8); \
      _Pragma("unroll") for (int mt = 0; mt < MT; ++mt) _Pragma("unroll") for (int nt = 0; nt < 4; ++nt) acc[mt][nt] = I8 ? mfma16_i8(af[mt], bf[nt], acc[mt][nt]) : mfma16(af[mt], bf[nt], acc[mt][nt]); } }
  GL(a0, b0, 0) GL(a1, b1, 1) GL(a2, b2, 2)
  for (int kt = 0; kt < nk; kt += 3) {
    GSTEP(a0, b0, kt + 3)
    if (kt + 1 < nk) GSTEP(a1, b1, kt + 4)
    if (kt + 2 < nk) GSTEP(a2, b2, kt + 5)
  }
#undef GL
#undef GSTEP
}
constexpr int TLD = 136;
template <int MT> DI void zero_acc(f4 (&acc)[MT][4]) {
#pragma unroll
  for (int i = 0; i < MT; ++i)
#pragma unroll
    for (int j = 0; j < 4; ++j) acc[i][j] = f4{0.f, 0.f, 0.f, 0.f};
}


DI const volatile unsigned* xcd_words(char* smem);
struct TileSched { int s, step, total, rp0, ntn, sr; };
DI TileSched tile_begin(int NTM_, int NTN_, const void* g_bar = nullptr, const volatile unsigned* g_st = nullptr) {
  const int G = (int)gridDim.x;
  const int ng = (G % 8 == 0 && NTM_ % 8 == 0) ? 8 : ((G % 4 == 0 && NTM_ % 4 == 0) ? 4 : 1);
  int x = (int)blockIdx.x % ng, li = (int)blockIdx.x / ng; const int rpg = NTM_ / ng;
#ifndef EMU
  if (ng == 8) {
    const unsigned* bar = (const unsigned*)g_bar; bool ok = true;
#pragma unroll
    for (int j = 0; j < 8; ++j) ok = ok && (__hip_atomic_load(&bar[XB_XCNT(j)], __ATOMIC_RELAXED, __HIP_MEMORY_SCOPE_AGENT) == (unsigned)(G / 8));
    if (ok) { x = (int)g_st[2]; li = (int)g_st[3]; }
  }
  x = __builtin_amdgcn_readfirstlane(x); li = __builtin_amdgcn_readfirstlane(li);
#endif
  TileSched t; t.s = li; t.step = G / ng; t.total = rpg * NTN_; t.rp0 = x * rpg; t.ntn = NTN_; t.sr = (rpg % 8 == 0) ? 8 : ((rpg % 4 == 0) ? 4 : ((rpg % 2 == 0) ? 2 : 1));
  return t;
}
DI bool tile_next(TileSched& t, int& tm, int& tn) {
  if (t.s >= t.total) return false;
  const int SC = 8;
  const int per_rg = t.sr * t.ntn, rg = t.s / per_rg, rem = t.s % per_rg, nfull = t.ntn / SC, fullsz = nfull * t.sr * SC;
  int r, c, cg;
  if (rem < fullsz) { cg = rem / (t.sr * SC); const int loc = rem % (t.sr * SC); r = loc / SC; c = loc % SC; }
  else { const int loc = rem - fullsz, w = t.ntn - nfull * SC; cg = nfull; r = loc / w; c = loc % w; }
  tm = t.rp0 + rg * t.sr + r; tn = cg * SC + c; t.s += t.step;
  return true;
}

DI int win_colmap(int c) {
  if (c < 1872) return c;
  if (c < 1880) return 3920 + (c - 1872);
  if (c < 1888) return 3928 + (c - 1880);
  if (c < 1920) return -1;
  if (c < 3968) return 1872 + (c - 1920);
  return 3936 + (c - 3968);
}
DI void transpose_tile(const float* src, int lds_, hf* dst, int K, int k0, int n0, bool use_map, char* smem, bool pr = false) {
  float* t = (float*)smem;
  const int tid = get_tid(), c = tid & 63, r0 = tid >> 6;
  int sc = use_map ? win_colmap(n0 + c) : (n0 + c);
  __syncthreads();
  float tv[16];
#pragma unroll
  for (int i = 0; i < 16; ++i) { int r = i * 4 + r0; tv[i] = sc >= 0 ? src[(size_t)(k0 + r) * lds_ + sc] : 0.f; }
#pragma unroll
  for (int i = 0; i < 16; ++i) t[c * 65 + i * 4 + r0] = tv[i];
  __syncthreads();
#pragma unroll 4
  for (int i = 0; i < 16; ++i) { int r = i * 4 + r0; dst[pr ? pr32_off(n0 + r, k0 + c, K) : ((size_t)(n0 + r) * K + k0 + c)] = (hf)t[r * 65 + c]; }
}
DI void phase_A(const Params& p, char* smem) {
  float* mod = (float*)(p.ws + O_MOD);
  const int tid = get_tid(), lane = tid & 63, wave = tid >> 6;
  constexpr int N_MOD = 6 * DM / 64;
  constexpr int N_WIN = (NP / 64) * (DM / 64), N_WPA = (DM / 64) * 8, N_WO = (DM / 64) * (DM / 64), N_WQ = 16 * (DM / 64);
  constexpr int N_SUBK = 8, N_CS = NTOK / 256;
  constexpr int T1 = N_MOD, T2 = T1 + N_WIN, T3 = T2 + N_WPA, T4 = T3 + N_WPA, T5 = T4 + N_WO, T6 = T5 + N_WQ, T7 = T6 + N_SUBK, T8 = T7 + N_CS;
  if (blockIdx.x == 0) { if (tid < 64) ((int*)(p.ws + O_CNT))[tid] = 0; for (int i = tid; i < 4096; i += 256) ((unsigned*)(p.ws + O_BAR))[i] = 0u; }
  for (int it = blockIdx.x; it < T8; it += gridDim.x) {
    if (it < T1) {
      float* sil = (float*)smem;
      float* red = sil + BATCH * DM;
      __syncthreads();
      for (int i = tid; i < BATCH * DM; i += 256) sil[i] = siluf_(p.c[i]);
      __syncthreads();
      const int j = it * 64 + lane;
      float a[BATCH];
#pragma unroll
      for (int b = 0; b < BATCH; ++b) a[b] = 0.f;
      for (int k = wave * (DM / 4); k < (wave + 1) * (DM / 4); ++k) {
        float w = p.w_ada[(size_t)k * 6 * DM + j];
#pragma unroll
        for (int b = 0; b < BATCH; ++b) a[b] += sil[b * DM + k] * w;
      }
#pragma unroll
      for (int b = 0; b < BATCH; ++b) red[(wave * BATCH + b) * 64 + lane] = a[b];
      __syncthreads();
      if (wave == 0) {
#pragma unroll
        for (int b = 0; b < BATCH; ++b) {
          float s = red[(0 * BATCH + b) * 64 + lane] + red[(1 * BATCH + b) * 64 + lane] + red[(2 * BATCH + b) * 64 + lane] + red[(3 * BATCH + b) * 64 + lane];
          mod[(size_t)b * 6 * DM + j] = s + p.b_ada[j];
        }
      }
    } else if (it < T2) { int t = it - T1; transpose_tile(p.w_in, IN_W, (hf*)(p.ws + O_WIN), DM, (t % (DM / 64)) * 64, (t / (DM / 64)) * 64, true, smem, true); }
    else if (it < T3) { int t = it - T2; transpose_tile(p.w_pa, DM, (hf*)(p.ws + O_WPA), 512, (t % 8) * 64, (t / 8) * 64, false, smem); }
    else if (it < T4) { int t = it - T3; transpose_tile(p.w_pb, DM, (hf*)(p.ws + O_WPB), 512, (t % 8) * 64, (t / 8) * 64, false, smem); }
    else if (it < T5) { int t = it - T4; transpose_tile(p.w_o, DM, (hf*)(p.ws + O_WO), DM, (t % (DM / 64)) * 64, (t / (DM / 64)) * 64, false, smem, true); }
    else if (it < T6) { int t = it - T5; transpose_tile(p.wq, 1024, (hf*)(p.ws + O_WQ), DM, (t % (DM / 64)) * 64, (t / (DM / 64)) * 64, false, smem); }
    else if (it < T7) { int t = it - T6; hf* d = (hf*)(p.ws + O_SUBK); for (int i = tid; i < 16384; i += 256) d[t * 16384 + i] = (hf)p.subk[t * 16384 + i]; }
    else {
      int tok = (it - T7) * 256 + tid;
      float* cs = (float*)(p.ws + O_CS) + (size_t)tok * 16;
      float pos = (float)p.pos[tok];
#pragma unroll
      for (int i = 0; i < 8; ++i) { float inv = powf(500000.0f, -(float)i * 0.125f); float ang = pos * inv; cs[i] = cosf(ang); cs[8 + i] = sinf(ang); }
    }
  }
}

DI void adaln_rows(const float* src, hf* dst, const float* mod, int sh_off, int sc_off, bool pr) {
  const int tid = get_tid(), lane = tid & 63, wave = tid >> 6;
  for (int row = blockIdx.x * 4 + wave; row < NTOK; row += gridDim.x * 4) {
    const float* xr = src + (size_t)row * DM; const int b = row / SEQ;
    float v[DM / 64]; float ss = 0.f;
#pragma unroll
    for (int i = 0; i < DM / 256; ++i) { f4 t = *(const f4*)(xr + i * 256 + lane * 4); v[4 * i] = t[0]; v[4 * i + 1] = t[1]; v[4 * i + 2] = t[2]; v[4 * i + 3] = t[3]; ss += t[0] * t[0] + t[1] * t[1] + t[2] * t[2] + t[3] * t[3]; }
    ss = wave_sum(ss);
    float rstd = rsqrtf(ss * (1.0f / DM) + EPSN);
    const float* mb = mod + (size_t)b * 6 * DM;
#pragma unroll
    for (int i = 0; i < DM / 256; ++i) {
      int d = i * 256 + lane * 4; h4 o;
#pragma unroll
      for (int j = 0; j < 4; ++j) o[j] = (hf)(v[4 * i + j] * rstd * (1.0f + mb[sc_off + d + j]) + mb[sh_off + d + j]);
      *(h4*)(dst + (pr ? pr32_off(row, d, DM) : ((size_t)row * DM + d))) = o;
    }
  }
}

constexpr size_t Q_W8 = 0, Q_SB = al256((size_t)NP * DM), Q_N1 = al256(Q_SB + (size_t)NP * 4), Q_SA = Q_N1 + (size_t)NTOK * DM;
static_assert(Q_SA + (size_t)NTOK * 4 <= DSCAN_BYTES, "scan scratch too small for the int8 in-projection operands");
#ifndef TN_I8
#define TN_I8 0
#endif
static_assert(TN_I8 == 0, "the query scale is folded into the int8 dequant scale: every in-projection tile must take the int8 path");
DI size_t pr64b_off(int row, int k, int K) { return ((size_t)(row >> 1) * (K / 64) + (k >> 6)) * 128 + (row & 1) * 64 + (k & 63); }
DI void phase_B(const Params& p) {
  const int tid = get_tid(), lane = tid & 63, wave = tid >> 6;
  const float* mod = (const float*)(p.ws + O_MOD);
  signed char* n1q = (signed char*)(TN_I8 > 0 ? p.dscan + Q_N1 : p.ws + O_R); float* sa = (float*)(TN_I8 > 0 ? p.dscan + Q_SA : p.ws + O_R + (size_t)NTOK * DM); hf* n1h = (hf*)(p.ws + O_R);
  signed char* w8 = (signed char*)(p.ws + O_W8); float* sb = (float*)(p.ws + O_SB8);
  for (int row = blockIdx.x * 4 + wave; row < NTOK; row += gridDim.x * 4) {
    const float* xr = p.x + (size_t)row * DM; const int b = row / SEQ;
    float v[DM / 64]; float ss = 0.f;
#pragma unroll
    for (int i = 0; i < DM / 256; ++i) { f4 t = *(const f4*)(xr + i * 256 + lane * 4); v[4 * i] = t[0]; v[4 * i + 1] = t[1]; v[4 * i + 2] = t[2]; v[4 * i + 3] = t[3]; ss += t[0] * t[0] + t[1] * t[1] + t[2] * t[2] + t[3] * t[3]; }
    ss = wave_sum(ss);
    const float rstd = rsqrtf(ss * (1.0f / DM) + EPSN);
    const float* mb = mod + (size_t)b * 6 * DM;
    float mx = 0.f;
#pragma unroll
    for (int i = 0; i < DM / 256; ++i)
#pragma unroll
      for (int j = 0; j < 4; ++j) { const int d = i * 256 + lane * 4 + j; v[4 * i + j] = v[4 * i + j] * rstd * (1.0f + mb[DM + d]) + mb[d]; mx = fmaxf(mx, fabsf(v[4 * i + j])); }
    if (TN_I8 > 0) {
#pragma unroll
      for (int i = 0; i < DM / 256; ++i) { h4 o; o[0] = (hf)v[4 * i]; o[1] = (hf)v[4 * i + 1]; o[2] = (hf)v[4 * i + 2]; o[3] = (hf)v[4 * i + 3]; *(h4*)(n1h + pr32_off(row, i * 256 + lane * 4, DM)) = o; }
    }
#pragma unroll
    for (int m = 32; m >= 1; m >>= 1) mx = fmaxf(mx, __shfl_xor(mx, m));
    const float sc = mx > 0.f ? mx * (1.0f / 127.0f) : 1.0f, inv = 1.0f / sc;
#pragma unroll
    for (int i = 0; i < DM / 256; ++i) {
      unsigned w = 0;
#pragma unroll
      for (int j = 0; j < 4; ++j) { int qv = (int)rintf(v[4 * i + j] * inv); qv = qv > 127 ? 127 : (qv < -127 ? -127 : qv); w |= ((unsigned)qv & 255u) << (8 * j); }
      *(unsigned*)(n1q + pr64b_off(row, i * 256 + lane * 4, DM)) = w;
    }
    if (lane == 0) sa[row] = sc;
  }
  const hf* WinT = (const hf*)(p.ws + O_WIN);
  for (int n = blockIdx.x * 4 + wave; n < NP; n += gridDim.x * 4) {
    constexpr int EPL = DM / 64;
    const hf* wr = WinT + pr32_off(n, lane * EPL, DM);
    float v[EPL]; float mx = 0.f;
#pragma unroll
    for (int i = 0; i < EPL; ++i) { v[i] = (float)wr[i]; mx = fmaxf(mx, fabsf(v[i])); }
#pragma unroll
    for (int m = 32; m >= 1; m >>= 1) mx = fmaxf(mx, __shfl_xor(mx, m));
    const float sc = mx > 0.f ? mx * (1.0f / 127.0f) : 1.0f, inv = 1.0f / sc;
#pragma unroll
    for (int i4_ = 0; i4_ < EPL / 4; ++i4_) {
      unsigned w = 0;
#pragma unroll
      for (int j = 0; j < 4; ++j) { int qv = (int)rintf(v[4 * i4_ + j] * inv); qv = qv > 127 ? 127 : (qv < -127 ? -127 : qv); w |= ((unsigned)qv & 255u) << (8 * j); }
      *(unsigned*)(w8 + pr64b_off(n, lane * EPL + 4 * i4_, DM)) = w;
    }
    if (lane == 0) sb[n] = sc;
  }
  const hf* WqT = (const hf*)(p.ws + O_WQ); signed char* wq8 = (signed char*)(p.ws + O_WQ8); float* sq8 = (float*)(p.ws + O_SQ8);
  for (int n = blockIdx.x * 4 + wave; n < 1024; n += gridDim.x * 4) {
    constexpr int EPL = DM / 64;
    const hf* wr = WqT + (size_t)n * DM + lane * EPL;
    float v[EPL]; float mx = 0.f;
#pragma unroll
    for (int i = 0; i < EPL; ++i) { v[i] = (float)wr[i]; mx = fmaxf(mx, fabsf(v[i])); }
#pragma unroll
    for (int m = 32; m >= 1; m >>= 1) mx = fmaxf(mx, __shfl_xor(mx, m));
    const float sc = mx > 0.f ? mx * (1.0f / 127.0f) : 1.0f, inv = 1.0f / sc;
#pragma unroll
    for (int i4_ = 0; i4_ < EPL / 4; ++i4_) {
      unsigned w = 0;
#pragma unroll
      for (int j = 0; j < 4; ++j) { int qv = (int)rintf(v[4 * i4_ + j] * inv); qv = qv > 127 ? 127 : (qv < -127 ? -127 : qv); w |= ((unsigned)qv & 255u) << (8 * j); }
      *(unsigned*)(wq8 + (size_t)n * DM + lane * EPL + 4 * i4_) = w;
    }
    if (lane == 0) sq8[n] = sc;
  }
}
DI void phase_C(const Params& p, char* smem) {
  const hf* n1h = (const hf*)(p.ws + O_R); const hf* WinT = (const hf*)(p.ws + O_WIN);
  const hf* n1q = (const hf*)(TN_I8 > 0 ? p.dscan + Q_N1 : p.ws + O_R); const hf* W8 = (const hf*)(p.ws + O_W8);
  const float* sa = (const float*)(TN_I8 > 0 ? p.dscan + Q_SA : p.ws + O_R + (size_t)NTOK * DM); const float* sb = (const float*)(p.ws + O_SB8);
  hf* P1 = (hf*)(p.ws + O_P1); hf* P2 = (hf*)(p.ws + O_P2); hf* P3 = (hf*)(p.ws + O_P3); hf* P4 = (hf*)(p.ws + O_P4);
  float* aux = (float*)(p.ws + O_AUX); const float* cs = (const float*)(p.ws + O_CS);
  constexpr int CBM = 256, CMT = CBM / 32, NTN = NP / 128, NTM = NTOK / CBM;
  TileSched ts = tile_begin(NTM, NTN, p.ws + O_BAR, xcd_words(smem)); int tm, tn;
  while (tile_next(ts, tm, tn)) {
    const int m0 = tm * CBM, n0 = tn * 128;
    f4 acc[CMT][4];
    for (int rep_ = 0; rep_ < REP_CMAIN; ++rep_) { zero_acc<CMT>(acc);
    if (TN_I8 == 0 || tn >= TN_I8) gemm_mainloop_2set<CBM, true>(acc, n1q, W8, DM / 2, m0, n0, smem);
    else gemm_mainloop<CBM, 32, true, false>(acc, n1h, DM, WinT, DM, DM, m0, n0, smem); }
    const int tid_e = get_tid();
    const int lane = tid_e & 63, wave = tid_e >> 6, wm = wave >> 1, wn = wave & 1, q = lane >> 4, cl = lane & 15;
    const bool rope = (tn <= 4) || (tn >= 6 && tn <= 14);
    hf* tileS = (hf*)smem;
    for (int repe_ = 0; repe_ < REP_CEPI; ++repe_) {
    __syncthreads();
#pragma unroll
    for (int mt = 0; mt < CMT; ++mt) {
#pragma unroll
      for (int nt = 0; nt < 4; ++nt) {
        const int lrow = wm * (CBM / 2) + mt * 16 + q * 4, lcol = wn * 64 + nt * 16 + cl;
        const int rbase = m0 + lrow;
        f4 v = acc[mt][nt];
        if (TN_I8 == 0 || tn >= TN_I8) { const i4 ai = __builtin_bit_cast(i4, acc[mt][nt]); const float sbn = sb[n0 + lcol] * ((tn < 4) ? 0.125f : 1.0f); const f4 sa4 = *(const f4*)(sa + rbase);
#pragma unroll
          for (int r = 0; r < 4; ++r) v[r] = (float)ai[r] * (sa4[r] * sbn); }
        if (rope && nt == 0 && !(tn == 14 && wn == 1)) {
#pragma unroll
          for (int r = 0; r < 4; ++r) {
            float pv = __shfl_xor(v[r], 8);
            const float* c2 = cs + (size_t)(rbase + r) * 16; float co = c2[cl & 7], si = c2[8 + (cl & 7)];
            v[r] = (cl < 8) ? (v[r] * co - pv * si) : (v[r] * co + pv * si);
          }
        }
        if (tn == 14 && wn == 1) {
          const int lc = nt * 16 + cl;
          if (lc < 32) {
            const int hh = lc & 7;
#pragma unroll
            for (int r = 0; r < 4; ++r) {
              float o;
              if (lc < 16) o = v[r] * (0.25f * 0.125f);
              else if (lc < 24) o = sigmoidf_(v[r]);
              else o = -__expf(p.a_log[hh]) * softplusf_(v[r] + p.dt_bias[hh]);
              aux[(size_t)(rbase + r) * 32 + lc] = o;
            }
          }
        } else {
          if (tn >= 31) {
#pragma unroll
            for (int r = 0; r < 4; ++r) v[r] = sigmoidf_(v[r]);
          }
#pragma unroll
          for (int r = 0; r < 4; ++r) tileS[(lrow + r) * TLD + lcol] = (hf)v[r];
        }
      }
    }
    __syncthreads();
    {
      hf* dst; int ld, nch = 16;
      if (tn < 15) { dst = P1 + n0; ld = LP1; if (tn == 14) nch = 8; }
      else if (tn < 27) { dst = P2 + (n0 - C_QB); ld = LP2; }
      else if (tn < 31) { dst = P3 + (n0 - C_ZB); ld = LP3; }
      else { dst = P4 + (n0 - C_GA); ld = LP4; }
      const int tid = get_tid();
#pragma unroll
      for (int i = 0; i < CBM / 16; ++i) {
        const int idx = tid + i * 256, row = idx >> 4, ch = idx & 15;
        if (ch < nch) *(h8*)(dst + (size_t)(m0 + row) * ld + ch * 8) = *(const h8*)(tileS + row * TLD + ch * 8);
      }
    }
    }
  }
}

DI void phase_D1(const Params& p, char* smem) {
  const hf* P2 = (const hf*)(p.ws + O_P2); const float* aux = (const float*)(p.ws + O_AUX);
  hf* Qs = (hf*)smem;
  hf* Ks = Qs + 64 * 72;
  float* RHS = (float*)(Ks + 64 * 72);
  float* Lm = RHS + 64 * 128;
  float* gcs = Lm + 64 * 64;
  float* bts = gcs + 64;
  const int tid = get_tid(), lane = tid & 63, wave = tid >> 6, q = lane >> 4, cl = lane & 15;
  constexpr size_t MSZ = (size_t)NTOK * 512;
  hf* uT = (hf*)p.dscan; hf* wm_ = uT + MSZ; hf* qg = wm_ + MSZ; hf* kdT = qg + MSZ; hf* intra = (hf*)(p.ws + O_INTRA);
  float* eg = (float*)(p.ws + O_EG);
  for (int it = blockIdx.x; it < BATCH * 8 * NCHK; it += gridDim.x) {
    const int c = it % NCHK, h = (it / NCHK) % 8, b = it / (NCHK * 8);
    const size_t cbase = (size_t)it * 4096;
    const int tk = tid >> 2, qq = tid & 3, t0 = c * 64;
    const size_t grow = (size_t)b * SEQ + t0 + tk;
    __syncthreads();
    float g = aux[grow * 32 + 24 + h], beta = aux[grow * 32 + 16 + h];
    if (qq == 0) { gcs[tk] = g; bts[tk] = beta; }
    float val[3][16];
#pragma unroll
    for (int m = 0; m < 3; ++m) {
      const int ch0 = m * 512 + h * 64 + qq * 16;
#pragma unroll
      for (int e = 0; e < 16; ++e) val[m][e] = 0.f;
#pragma unroll
      for (int i = 0; i < 4; ++i) {
        const int tt = t0 + tk - 3 + i;
        if (tt >= 0) {
          const hf* src = P2 + ((size_t)b * SEQ + tt) * LP2 + ch0;
          h8 x0 = *(const h8*)src, x1 = *(const h8*)(src + 8);
          const float* wv = p.conv_w + (size_t)i * 1536 + ch0;
#pragma unroll
          for (int e = 0; e < 8; ++e) { val[m][e] += (float)x0[e] * wv[e]; val[m][8 + e] += (float)x1[e] * wv[8 + e]; }
        }
      }
#pragma unroll
      for (int e = 0; e < 16; ++e) val[m][e] = siluf_(val[m][e]);
    }
    float sq = 0.f, sk = 0.f;
#pragma unroll
    for (int e = 0; e < 16; ++e) { sq += val[0][e] * val[0][e]; sk += val[1][e] * val[1][e]; }
    sq += __shfl_xor(sq, 1); sq += __shfl_xor(sq, 2); sk += __shfl_xor(sk, 1); sk += __shfl_xor(sk, 2);
    const float nq = rsqrtf(sq + EPSN) * 0.125f, nk = rsqrtf(sk + EPSN);
    __syncthreads();
    if (wave == 0) { float v = gcs[lane];
#pragma unroll
      for (int d = 1; d < 64; d <<= 1) { const float y = __shfl(v, lane - d); if (lane >= d) v += y; }
      gcs[lane] = v; }
    __syncthreads();
    const float gc = gcs[tk], glast = gcs[63];
    const float egc = __expf(gc), ekd = __expf(glast - gc);
    if (tid == 0) eg[it] = __expf(glast);
#pragma unroll
    for (int e = 0; e < 16; ++e) {
      const int ch = qq * 16 + e;
      const float qv = val[0][e] * nq, kv = val[1][e] * nk, vv = val[2][e];
      Qs[tk * 72 + ch] = (hf)qv; Ks[tk * 72 + ch] = (hf)kv;
      RHS[tk * 128 + ch] = vv * beta; RHS[tk * 128 + 64 + ch] = kv * beta * egc;
      qg[cbase + tk * 64 + ch] = (hf)(qv * egc);
      kdT[cbase + ch * 64 + tk] = (hf)(kv * ekd);
    }
    __syncthreads();
    {
      f4 akk[4], aqk[4];
#pragma unroll
      for (int nt = 0; nt < 4; ++nt) { akk[nt] = f4{0, 0, 0, 0}; aqk[nt] = f4{0, 0, 0, 0}; }
#pragma unroll
      for (int ks = 0; ks < 2; ++ks) {
        h8 ak = *(const h8*)(Ks + (wave * 16 + cl) * 72 + ks * 32 + q * 8);
        h8 aq = *(const h8*)(Qs + (wave * 16 + cl) * 72 + ks * 32 + q * 8);
#pragma unroll
        for (int nt = 0; nt < 4; ++nt) {
          h8 bk = *(const h8*)(Ks + (nt * 16 + cl) * 72 + ks * 32 + q * 8);
          akk[nt] = mfma16(ak, bk, akk[nt]); aqk[nt] = mfma16(aq, bk, aqk[nt]);
        }
      }
#pragma unroll
      for (int nt = 0; nt < 4; ++nt) {
        const int j = nt * 16 + cl; const float gj = gcs[j];
#pragma unroll
        for (int r = 0; r < 4; ++r) {
          const int i = wave * 16 + q * 4 + r;
          const float dec = (i >= j) ? __expf(gcs[i] - gj) : 0.f;
          Lm[i * 64 + j] = (i > j) ? bts[i] * akk[nt][r] * dec : 0.f;
          intra[cbase + i * 64 + j] = (hf)(aqk[nt][r] * dec);
        }
      }
    }
    __syncthreads();
    if (wave < 2) {
      float xr[64];
#pragma unroll
      for (int i = 0; i < 64; ++i) xr[i] = 0.f;
#pragma unroll
      for (int i = 0; i < 64; ++i) {
        float s0 = 0.f, s1 = 0.f, s2 = 0.f, s3 = 0.f;
#pragma unroll
        for (int j4 = 0; j4 < (i + 3) / 4; ++j4) {
          f4 l4 = *(const f4*)(Lm + i * 64 + j4 * 4);
          s0 += l4[0] * xr[j4 * 4]; s1 += l4[1] * xr[j4 * 4 + 1]; s2 += l4[2] * xr[j4 * 4 + 2]; s3 += l4[3] * xr[j4 * 4 + 3];
        }
        xr[i] = RHS[i * 128 + wave * 64 + lane] - ((s0 + s1) + (s2 + s3));
      }
      if (wave == 0) {
#pragma unroll
        for (int i8 = 0; i8 < 8; ++i8) { h8 o;
#pragma unroll
          for (int e = 0; e < 8; ++e) o[e] = (hf)xr[i8 * 8 + e];
          *(h8*)(uT + cbase + lane * 64 + i8 * 8) = o; }
      } else {
#pragma unroll
        for (int i = 0; i < 64; ++i) wm_[cbase + i * 64 + lane] = (hf)xr[i];
      }
    }
  }
}

constexpr int E1_MAT = 64 * 72;
constexpr int LDS_E1 = 2 * 4 * E1_MAT * 2;
DI void phase_E1(const Params& p, char* smem) {
  const int tid = get_tid(), lane = tid & 63, wave = tid >> 6, q = lane >> 4, cl = lane & 15;
  constexpr size_t MSZ = (size_t)NTOK * 512;
  const hf* uT = (const hf*)p.dscan; const hf* intra = (const hf*)(p.ws + O_INTRA);
  const hf* mats[4] = {uT + MSZ, uT + 2 * MSZ, intra, uT + 3 * MSZ};
  const float* eg = (const float*)(p.ws + O_EG);
  hf* ob = (hf*)(p.ws + O_OB);
  hf* lbuf = (hf*)smem;
  for (int bh = blockIdx.x; bh < BATCH * 8; bh += gridDim.x) {
    const int b = bh / 8, h = bh % 8, e0 = wave * 16;
    f4 S[4];
#pragma unroll
    for (int i = 0; i < 4; ++i) S[i] = f4{0, 0, 0, 0};
    h8 st[8]; h4 un[4];
    {
      const size_t cbase = (size_t)bh * NCHK * 4096;
#pragma unroll
      for (int i = 0; i < 8; ++i) { const int idx = tid + i * 256, m = idx >> 9, r = (idx >> 3) & 63, c8 = idx & 7; st[i] = *(const h8*)(mats[m] + cbase + r * 64 + c8 * 8); }
#pragma unroll
      for (int mt = 0; mt < 4; ++mt) un[mt] = *(const h4*)(uT + cbase + (e0 + cl) * 64 + mt * 16 + q * 4);
      __syncthreads();
#pragma unroll
      for (int i = 0; i < 8; ++i) { const int idx = tid + i * 256, m = idx >> 9, r = (idx >> 3) & 63, c8 = idx & 7; *(h8*)(lbuf + m * E1_MAT + r * 72 + c8 * 8) = st[i]; }
      __syncthreads();
    }
    for (int c = 0; c < NCHK; ++c) {
      const hf* L = lbuf + (c & 1) * 4 * E1_MAT;
      const hf* Lw = L, *Lq = L + E1_MAT, *Li = L + 2 * E1_MAT, *Lk = L + 3 * E1_MAT;
      h4 uc[4];
#pragma unroll
      for (int mt = 0; mt < 4; ++mt) uc[mt] = un[mt];
      if (c + 1 < NCHK) {
        const size_t cb2 = ((size_t)bh * NCHK + c + 1) * 4096;
#pragma unroll
        for (int i = 0; i < 8; ++i) { const int idx = tid + i * 256, m = idx >> 9, r = (idx >> 3) & 63, c8 = idx & 7; st[i] = *(const h8*)(mats[m] + cb2 + r * 64 + c8 * 8); }
#pragma unroll
        for (int mt = 0; mt < 4; ++mt) un[mt] = *(const h4*)(uT + cb2 + (e0 + cl) * 64 + mt * 16 + q * 4);
      }
      const float egl = eg[bh * NCHK + c];
      h8 Sb[2]; Sb[0] = cvt_f4f4(S[0], S[1]); Sb[1] = cvt_f4f4(S[2], S[3]);
      f4 vn[4];
#pragma unroll
      for (int mt = 0; mt < 4; ++mt) {
        f4 a = f4{0, 0, 0, 0};
#pragma unroll
        for (int ks = 0; ks < 2; ++ks) a = mfma16(permload(Lw + (mt * 16 + cl) * 72 + ks * 32, q), Sb[ks], a);
#pragma unroll
        for (int r = 0; r < 4; ++r) vn[mt][r] = (float)uc[mt][r] - a[r];
      }
      h8 Vb[2]; Vb[0] = cvt_f4f4(vn[0], vn[1]); Vb[1] = cvt_f4f4(vn[2], vn[3]);
#pragma unroll
      for (int mt = 0; mt < 4; ++mt) {
        f4 o = f4{0, 0, 0, 0};
#pragma unroll
        for (int ks = 0; ks < 2; ++ks) {
          o = mfma16(permload(Lq + (mt * 16 + cl) * 72 + ks * 32, q), Sb[ks], o);
          o = mfma16(permload(Li + (mt * 16 + cl) * 72 + ks * 32, q), Vb[ks], o);
        }
#pragma unroll
        for (int r = 0; r < 4; ++r) ob[((size_t)b * SEQ + c * 64 + mt * 16 + q * 4 + r) * 512 + h * 64 + e0 + cl] = (hf)o[r];
      }
#pragma unroll
      for (int mt = 0; mt < 4; ++mt) {
        f4 sacc = S[mt] * egl;
#pragma unroll
        for (int ks = 0; ks < 2; ++ks) sacc = mfma16(permload(Lk + (mt * 16 + cl) * 72 + ks * 32, q), Vb[ks], sacc);
        S[mt] = sacc;
      }
      if (c + 1 < NCHK) {
        hf* Ln = lbuf + ((c + 1) & 1) * 4 * E1_MAT;
#pragma unroll
        for (int i = 0; i < 8; ++i) { const int idx = tid + i * 256, m = idx >> 9, r = (idx >> 3) & 63, c8 = idx & 7; *(h8*)(Ln + m * E1_MAT + r * 72 + c8 * 8) = st[i]; }
      }
      __syncthreads();
    }
    drain_stores();
    __syncthreads();
    if (tid == 0) { fence_release_agent(); add_relaxed_agent((unsigned*)(p.ws + O_CNT) + 48, 1u); }
  }
}

DI void obnorm_pass(const Params& p) {
  hf* ob = (hf*)(p.ws + O_OB); const hf* P3 = (const hf*)(p.ws + O_P3);
  const int lane = get_tid() & 63, wave = get_tid() >> 6;
  for (int row = blockIdx.x * 4 + wave; row < NTOK; row += gridDim.x * 4) {
    h8 v = *(const h8*)(ob + (size_t)row * 512 + lane * 8);
    h8 z = *(const h8*)(P3 + (size_t)row * 512 + lane * 8);
    float f[8], ss = 0.f;
#pragma unroll
    for (int e = 0; e < 8; ++e) { f[e] = (float)v[e]; ss += f[e] * f[e]; }
    ss += __shfl_xor(ss, 1); ss += __shfl_xor(ss, 2); ss += __shfl_xor(ss, 4);
    const float rstd = rsqrtf(ss * (1.0f / 64.0f) + EPSN);
    h8 o;
#pragma unroll
    for (int e = 0; e < 8; ++e) o[e] = (hf)(f[e] * rstd * p.norm_b_w[(lane & 7) * 8 + e] * siluf_((float)z[e]));
    *(h8*)(ob + (size_t)row * 512 + lane * 8) = o;
  }
}

constexpr int SELN = TOPK + 64;
constexpr int CAPC = 128;
constexpr int E2_WAVE_LDS = SELN * 4 + SELN * 8 * 4 + 256 * 4 + CAPC * 8;
DI int bin_of(float v, float vmin, float sc) { int bq = (int)((v - vmin) * sc); return bq > 255 ? 255 : (bq < 0 ? 0 : bq); }
DI void attn_token(const Params& p, int b, int t, float* srow, int* sel, float* Sb, hf* Vt1, int lane, bool dry) {
  unsigned* hist = (unsigned*)(Sb + SELN * 8); unsigned* candk = hist + 256; int* candi = (int*)(candk + CAPC);
  hf* P1 = (hf*)(p.ws + O_P1);
#ifndef EMU
  asm volatile("" : "+v"(lane));
#endif
  const int q = lane >> 4, cl = lane & 15;
  const int n = t + 1;
  int cnt;
  for (int rep_ = 0; rep_ < REP_SEL; ++rep_) {
  if (n <= TOPK) {
    cnt = n;
    for (int i = lane; i < SELN; i += 64) sel[i] = (i < n) ? i : 0;
  } else {
    cnt = TOPK;
    float val[SEQ / 64];
    {
      const hf* pb = (const hf*)srow + lane;
#pragma unroll
      for (int jg = 0; jg < SEQ / 64 / 8; ++jg) {
#ifndef EMU
        asm volatile("" : "+v"(pb));
#endif
#pragma unroll
        for (int jj = 0; jj < 8; ++jj) { const int j = jg * 8 + jj; const float v = (float)pb[jj * 64]; val[j] = (j * 64 + lane < n) ? v : -INFINITY; }
        pb += 512;
      }
    }
    float vmin = INFINITY, vmax = -INFINITY;
#pragma unroll
    for (int j = 0; j < SEQ / 64; ++j) { vmax = fmaxf(vmax, val[j]); vmin = fminf(vmin, (j * 64 + lane < n) ? val[j] : INFINITY); }
#pragma unroll
    for (int m = 32; m >= 1; m >>= 1) { vmax = fmaxf(vmax, __shfl_xor(vmax, m)); vmin = fminf(vmin, __shfl_xor(vmin, m)); }
    const float bscale = 255.99f / (vmax - vmin);
    for (int i = lane; i < 256; i += 64) hist[i] = 0u;
    wave_sync();
#pragma unroll
    for (int j = 0; j < SEQ / 64; ++j) { if (j * 64 + lane < n) atomicAdd(&hist[bin_of(val[j], vmin, bscale)], 1u); }
    wave_sync();
    int tb, ca, nc;
    {
      const unsigned h0 = hist[4 * lane], h1 = hist[4 * lane + 1], h2 = hist[4 * lane + 2], h3 = hist[4 * lane + 3];
      const int sL = (int)(h0 + h1 + h2 + h3);
      int tt = sL;
#pragma unroll
      for (int d = 1; d < 64; d <<= 1) { const int y = __shfl(tt, lane + d); if (lane + d < 64) tt += y; }
      const int above = tt - sL;
      const int c3 = above + (int)h3, c2 = c3 + (int)h2, c1 = c2 + (int)h1, c0 = c1 + (int)h0;
      int tb_ = -1, ca_ = 0, nc_ = 0;
      if (above < TOPK && c0 >= TOPK) {
        if (c3 >= TOPK) { tb_ = 4 * lane + 3; ca_ = above; nc_ = (int)h3; }
        else if (c2 >= TOPK) { tb_ = 4 * lane + 2; ca_ = c3; nc_ = (int)h2; }
        else if (c1 >= TOPK) { tb_ = 4 * lane + 1; ca_ = c2; nc_ = (int)h1; }
        else { tb_ = 4 * lane; ca_ = c1; nc_ = (int)h0; }
      }
      const unsigned long long bm = __ballot(tb_ >= 0);
      const int src = bm ? (int)__builtin_ctzll(bm) : 0;
      tb = __shfl(tb_, src); ca = __shfl(ca_, src); nc = __shfl(nc_, src);
      if (bm == 0ull) nc = CAPC + 1;
    }
    const unsigned long long lt = (lane == 0) ? 0ull : (~0ull >> (64 - lane));
    if (nc <= CAPC) {
      int base_gt = 0, base_c = 0;
#pragma unroll
      for (int j = 0; j < SEQ / 64; ++j) {
        const bool valid = j * 64 + lane < n;
        const int bn = valid ? bin_of(val[j], vmin, bscale) : -1;
        const bool mg = bn > tb, me = bn == tb;
        const unsigned long long bg = __ballot(mg), be = __ballot(me);
        if (mg) sel[base_gt + __popcll(bg & lt)] = j * 64 + lane;
        if (me) { const int pos = base_c + __popcll(be & lt); candk[pos] = f2ord(val[j]); candi[pos] = j * 64 + lane; }
        base_gt += __popcll(bg); base_c += __popcll(be);
      }
      wave_sync();
      const int need = TOPK - ca;
      int base = ca;
#pragma unroll
      for (int hb = 0; hb < CAPC / 64; ++hb) {
        const int my = hb * 64 + lane;
        bool pick = false; int myi = 0;
        if (my < nc) {
          const unsigned mk = candk[my]; myi = candi[my];
          int rank = 0;
          for (int c2 = 0; c2 < nc; ++c2) { const unsigned ok = candk[c2]; const int oi = candi[c2]; rank += (ok > mk || (ok == mk && oi < myi)) ? 1 : 0; }
          pick = rank < need;
        }
        const unsigned long long bp = __ballot(pick);
        if (pick) sel[base + __popcll(bp & lt)] = myi;
        base += __popcll(bp);
      }
    } else {
      unsigned T = 0;
      for (int bit = 31; bit >= 0; --bit) {
        const unsigned cand = T | (1u << bit);
        int cl_ = 0;
#pragma unroll
        for (int j = 0; j < SEQ / 64; ++j) cl_ += (f2ord(val[j]) >= cand) ? 1 : 0;
        const int tot = wave_sum_i(cl_);
        if (tot >= TOPK) T = cand;
        if (tot == TOPK) { T = cand - 1u; break; }
      }
      int cgt = 0;
#pragma unroll
      for (int j = 0; j < SEQ / 64; ++j) cgt += (f2ord(val[j]) > T) ? 1 : 0;
      cgt = wave_sum_i(cgt);
      int base_gt = 0, base_eq = cgt;
#pragma unroll
      for (int j = 0; j < SEQ / 64; ++j) {
        const unsigned kj = f2ord(val[j]);
        const bool mg = kj > T, me = kj == T;
        const unsigned long long bg = __ballot(mg), be = __ballot(me);
        if (mg) sel[base_gt + __popcll(bg & lt)] = j * 64 + lane;
        if (me) { int pos = base_eq + __popcll(be & lt); if (pos < TOPK) sel[pos] = j * 64 + lane; }
        base_gt += __popcll(bg); base_eq += __popcll(be);
      }
    }
    sel[TOPK + lane] = 0;
  }
  wave_sync();
  }
  const int ng = (cnt + 63) / 64;
  const size_t trow = (size_t)b * SEQ + t;
  const hf* kvb = P1 + (size_t)b * SEQ * LP1;
  const int k8 = lane >> 3, dch = lane & 7;
  h8 vc[8], vn[8];
#pragma unroll
  for (int j = 0; j < 4; ++j) { const hf* vr = kvb + (size_t)sel[j * 8 + k8] * LP1 + C_VA + dch * 8; vc[j] = *(const h8*)vr; vc[4 + j] = *(const h8*)(vr + 64); }
  hf* P16 = (hf*)Sb;
  hf* Vt = (hf*)Sb + 8 * SELN;
  {
    constexpr int NG = TOPK / 64;
    const h8 z8 = h8{0, 0, 0, 0, 0, 0, 0, 0};
    h8 qb[4];
#pragma unroll
    for (int s = 0; s < 4; ++s) {
      const h8 v = *(const h8*)(P1 + trow * LP1 + C_QA + (cl & 7) * 64 + 32 * (s & 1) + 8 * q);
      qb[s] = (cl < 8 && (cl >> 2) == (s >> 1)) ? v : z8;
    }
    f4 S[NG * 4];
    h8 kc[4][4], kn[4][4];
#pragma unroll
    for (int u = 0; u < 4; ++u) { const hf* kr = kvb + (size_t)sel[u * 16 + cl] * LP1 + C_KA + 8 * q;
#pragma unroll
      for (int s = 0; s < 4; ++s) kc[u][s] = *(const h8*)(kr + 32 * s); }
#pragma unroll
    for (int gg = 0; gg < NG; ++gg) {
      if (gg < ng) {
        if (gg + 1 < NG) {
          const int g2 = (gg + 1 < ng) ? gg + 1 : gg;
#pragma unroll
          for (int u = 0; u < 4; ++u) { const hf* kr = kvb + (size_t)sel[g2 * 64 + u * 16 + cl] * LP1 + C_KA + 8 * q;
#pragma unroll
            for (int s = 0; s < 4; ++s) kn[u][s] = *(const h8*)(kr + 32 * s); }
        }
#pragma unroll
        for (int u = 0; u < 4; ++u) {
          f4 acc = f4{0, 0, 0, 0};
#pragma unroll
          for (int s = 0; s < 4; ++s) acc = mfma16(kc[u][s], qb[s], acc);
#pragma unroll
          for (int r = 0; r < 4; ++r) if (gg * 64 + u * 16 + 4 * q + r >= cnt) acc[r] = -INFINITY;
          S[gg * 4 + u] = acc;
        }
        if (gg + 1 < NG) {
#pragma unroll
          for (int u = 0; u < 4; ++u)
#pragma unroll
            for (int s = 0; s < 4; ++s) kc[u][s] = kn[u][s];
        }
      } else {
#pragma unroll
        for (int u = 0; u < 4; ++u) S[gg * 4 + u] = f4{-INFINITY, -INFINITY, -INFINITY, -INFINITY};
      }
    }
    float mx = -INFINITY;
#pragma unroll
    for (int j = 0; j < NG * 4; ++j)
#pragma unroll
      for (int r = 0; r < 4; ++r) mx = fmaxf(mx, S[j][r]);
    mx = fmaxf(mx, __shfl_xor(mx, 16)); mx = fmaxf(mx, __shfl_xor(mx, 32));
    float sm = 0.f;
#pragma unroll
    for (int j = 0; j < NG * 4; ++j)
#pragma unroll
      for (int r = 0; r < 4; ++r) { const float e = __expf(S[j][r] - mx); S[j][r] = e; sm += e; }
    sm += __shfl_xor(sm, 16); sm += __shfl_xor(sm, 32);
    const float inv = 1.0f / sm;
    if (cl < 8) {
#pragma unroll
      for (int j = 0; j < NG * 4; ++j) if (j < ng * 4) {
        h4 pv; pv[0] = (hf)(S[j][0] * inv); pv[1] = (hf)(S[j][1] * inv); pv[2] = (hf)(S[j][2] * inv); pv[3] = (hf)(S[j][3] * inv);
        *(h4*)(P16 + cl * SELN + j * 16 + 4 * q) = pv;
      }
    }
  }
  wave_sync();
  {
    f4 O[2][4];
#pragma unroll
    for (int g = 0; g < 2; ++g)
#pragma unroll
      for (int nt = 0; nt < 4; ++nt) O[g][nt] = f4{0, 0, 0, 0};
    const int nst = ng * 2;
    for (int st = 0; st < nst; ++st) {
      {
        const int st2 = (st + 1 < nst) ? st + 1 : st;
#pragma unroll
        for (int j = 0; j < 4; ++j) { const hf* vr = kvb + (size_t)sel[st2 * 32 + j * 8 + k8] * LP1 + C_VA + dch * 8; vn[j] = *(const h8*)vr; vn[4 + j] = *(const h8*)(vr + 64); }
      }
      wave_sync();
#pragma unroll
      for (int j = 0; j < 4; ++j) { *(h8*)(Vt + (j * 8 + k8) * 72 + dch * 8) = vc[j]; *(h8*)(Vt1 + (j * 8 + k8) * 72 + dch * 8) = vc[4 + j]; }
      wave_sync();
#pragma unroll
      for (int g = 0; g < 2; ++g) {
        h8 pa;
        if (cl < 4) pa = *(const h8*)(P16 + (g * 4 + cl) * SELN + st * 32 + q * 8); else pa = h8{0, 0, 0, 0, 0, 0, 0, 0};
        const hf* vt = g ? Vt1 : Vt;
#pragma unroll
        for (int nt = 0; nt < 4; ++nt) {
          const hf* tp = vt + (q * 8 + (cl >> 2)) * 72 + nt * 16 + (cl & 3) * 4;
          const h4 lo = lds_read_tr16(tp), hi = lds_read_tr16(tp + 4 * 72);
          O[g][nt] = mfma16(pa, cat44(lo, hi), O[g][nt]);
        }
      }
#pragma unroll
      for (int j = 0; j < 8; ++j) vc[j] = vn[j];
    }
    if (q == 0) {
#pragma unroll
      for (int g = 0; g < 2; ++g)
#pragma unroll
        for (int nt = 0; nt < 4; ++nt)
#pragma unroll
          for (int r = 0; r < 4; ++r) {
            hf* dst = dry ? ((hf*)srow + (g * 4 + r) * 64 + nt * 16 + cl) : (P1 + trow * LP1 + C_QA + (g * 4 + r) * 64 + nt * 16 + cl);
            *dst = (hf)O[g][nt][r];
          }
    }
  }
  wave_sync();
}

DI void phase_E2(const Params& p, char* smem, bool dry) {
  const hf* P1 = (const hf*)(p.ws + O_P1); const float* aux = (const float*)(p.ws + O_AUX);
  int* cnt = (int*)(p.ws + O_CNT) + (dry ? 1 : 0);
  const int tid = get_tid(), lane = tid & 63, wave = tid >> 6;
  float* scr = (float*)(p.ws + O_SCR) + (size_t)blockIdx.x * QBT * SEQ;
  int* item_s = (int*)smem;
  char* wl = smem + 16 + wave * E2_WAVE_LDS;
  int* sel = (int*)wl; float* Sb = (float*)(wl + SELN * 4);
  constexpr int NQB = SEQ / QBT;
#ifdef EMU
  const int xq = (int)blockIdx.x % BATCH;
#else
  const int xq = (int)(xcd_words(smem)[2] % (unsigned)BATCH);
#endif
  int dq = 0;
  for (;;) {
    __syncthreads();
    const int bq = (xq + dq) % BATCH;
    if (tid == 0) item_s[0] = atomicAdd(cnt + 2 * bq, 1);
    __syncthreads();
    const int item = item_s[0];
    if (item >= NQB) { if (++dq >= BATCH) break; continue; }
    const int b = bq, qb = NQB - 1 - item;
    int lane_i = lane;
#ifndef EMU
    asm volatile("" : "+v"(lane_i));
#endif
    const int q = lane_i >> 4, cl = lane_i & 15;
    const int tw0 = qb * QBT + wave * 4;
    h8 aq[4][2]; h8 wA01, wA23;
    {
      f4 wv[4];
#pragma unroll
      for (int i = 0; i < 4; ++i) {
        const size_t row = (size_t)b * SEQ + tw0 + i;
        const hf* qp = P1 + row * LP1 + C_QI + cl * 64 + q * 8;
        aq[i][0] = *(const h8*)qp; aq[i][1] = *(const h8*)(qp + 32);
        wv[i] = *(const f4*)(aux + row * 32 + q * 4);
      }
      const f4 z4 = f4{0, 0, 0, 0};
      wA01 = cvt_f4f4(cl == 0 ? wv[0] : z4, cl == 4 ? wv[1] : z4);
      wA23 = cvt_f4f4(cl == 8 ? wv[2] : z4, cl == 12 ? wv[3] : z4);
    }
    const int ngrp = (tw0 + 3) / 64 + 1;
    const int ngrp_blk = (qb * QBT + QBT - 1) / 64 + 1;
    hf* kst = (hf*)(smem + 16 + 4 * E2_WAVE_LDS);
    const int tid_s = get_tid();
    const int skey = tid_s >> 3, sch = tid_s & 7;
    const hf* ksrc = P1 + ((size_t)b * SEQ + skey) * LP1 + C_KI + sch * 8;
    hf* scr_q = (hf*)(scr + (size_t)(wave * 4 + q) * SEQ) + cl;
    h8 sr0 = *(const h8*)ksrc, sr1 = *(const h8*)(ksrc + (size_t)32 * LP1);
    *(h8*)(kst + skey * 72 + sch * 8) = sr0; *(h8*)(kst + (skey + 32) * 72 + sch * 8) = sr1;
    { const int g1 = ngrp_blk > 1 ? 1 : 0; sr0 = *(const h8*)(ksrc + (size_t)(g1 * 64) * LP1); sr1 = *(const h8*)(ksrc + (size_t)(g1 * 64 + 32) * LP1); }
    h8 sq0, sq1;
    { const int g2 = ngrp_blk > 2 ? 2 : ngrp_blk - 1; sq0 = *(const h8*)(ksrc + (size_t)(g2 * 64) * LP1); sq1 = *(const h8*)(ksrc + (size_t)(g2 * 64 + 32) * LP1); }
    __syncthreads();
#define IDX_COMPUTE(STG, G) if ((G) < ngrp) { const hf* ks = kst + (STG) * (64 * 72); \
        _Pragma("unroll") for (int u = 0; u < 4; ++u) { \
          const h8 b0 = *(const h8*)(ks + (u * 16 + cl) * 72 + q * 8), b1 = *(const h8*)(ks + (u * 16 + cl) * 72 + 32 + q * 8); \
          f4 c4[4]; \
          _Pragma("unroll") for (int i = 0; i < 4; ++i) { f4 t4 = f4{0, 0, 0, 0}; t4 = mfma16(aq[i][0], b0, t4); t4 = mfma16(aq[i][1], b1, t4); c4[i] = t4; } \
          f4 sc = f4{0, 0, 0, 0}; sc = mfma16(wA01, relu8(cvt_f4f4(c4[0], c4[1])), sc); sc = mfma16(wA23, relu8(cvt_f4f4(c4[2], c4[3])), sc); \
          scr_q[(G) * 64 + u * 16] = (hf)sc[0]; } }
#define IDX_STAGE(R0, R1, STG, GNEXT) { hf* kn = kst + (STG) * (64 * 72); \
        *(h8*)(kn + skey * 72 + sch * 8) = R0; *(h8*)(kn + (skey + 32) * 72 + sch * 8) = R1; \
        const int gn_ = ((GNEXT) < ngrp_blk) ? (GNEXT) : ngrp_blk - 1; \
        R0 = *(const h8*)(ksrc + (size_t)(gn_ * 64) * LP1); R1 = *(const h8*)(ksrc + (size_t)(gn_ * 64 + 32) * LP1); }
    for (int grp = 0; grp < ngrp_blk; grp += 2) {
      IDX_COMPUTE(0, grp)
      if (grp + 1 < ngrp_blk) IDX_STAGE(sr0, sr1, 1, grp + 3)
      __syncthreads();
      if (grp + 1 >= ngrp_blk) break;
      IDX_COMPUTE(1, grp + 1)
      if (grp + 2 < ngrp_blk) IDX_STAGE(sq0, sq1, 0, grp + 4)
      __syncthreads();
    }
#undef IDX_COMPUTE
#undef IDX_STAGE
    gmem_wave_sync();
#pragma unroll 1
    for (int i = 0; i < 4; ++i) attn_token(p, b, tw0 + i, scr + (size_t)(wave * 4 + i) * SEQ, sel, Sb, kst + wave * (32 * 72), lane, dry);
  }
  if (!dry) {
    unsigned* e1done = (unsigned*)(p.ws + O_CNT) + 48;
    if (get_tid() == 0) {
      unsigned spins = 0;
      while (ld_relaxed_agent(e1done) < (unsigned)(BATCH * 8)) { spin_pause(); if (++spins > (1u << 26)) break; }
      fence_acquire_agent();
    }
    __syncthreads();
    obnorm_pass(p);
  }
}

DI void phase_F1(const Params& p, char* smem) {
  const hf* P1 = (const hf*)(p.ws + O_P1); const hf* ob = (const hf*)(p.ws + O_OB); const hf* P4 = (const hf*)(p.ws + O_P4);
  const hf* WpaT = (const hf*)(p.ws + O_WPA); const hf* WpbT = (const hf*)(p.ws + O_WPB);
  hf* merged = (hf*)(p.ws + O_MERGED);
  const int lane = get_tid() & 63, wave = get_tid() >> 6, wm = wave >> 1, wn = wave & 1, q = lane >> 4, cl = lane & 15;
  constexpr int NTN = DM / 128, NTM = NTOK / 128;
  TileSched ts = tile_begin(NTM, NTN, p.ws + O_BAR, xcd_words(smem)); int tm, tn;
  while (tile_next(ts, tm, tn)) {
    const int m0 = tm * 128, n0 = tn * 128;
    f4 a1[4][4], a2[4][4]; zero_acc<4>(a1); zero_acc<4>(a2);
    gemm_mainloop<128, 64>(a1, P1 + C_QA, LP1, WpaT, 512, 512, m0, n0, smem);
    gemm_mainloop<128, 64>(a2, ob, 512, WpbT, 512, 512, m0, n0, smem);
    hf* t1 = (hf*)smem; hf* t2 = t1 + 128 * TLD;
    __syncthreads();
#pragma unroll
    for (int mt = 0; mt < 4; ++mt)
#pragma unroll
      for (int nt = 0; nt < 4; ++nt)
#pragma unroll
        for (int r = 0; r < 4; ++r) {
          const int lrow = wm * 64 + mt * 16 + q * 4 + r, lcol = wn * 64 + nt * 16 + cl;
          t1[lrow * TLD + lcol] = (hf)a1[mt][nt][r]; t2[lrow * TLD + lcol] = (hf)a2[mt][nt][r];
        }
    __syncthreads();
    {
      const int tid = get_tid();
#pragma unroll
      for (int i = 0; i < 8; ++i) {
        const int idx = tid + i * 256, row = idx >> 4, ch = idx & 15;
        const size_t grow = (size_t)(m0 + row);
        const h8 v1 = *(const h8*)(t1 + row * TLD + ch * 8), v2 = *(const h8*)(t2 + row * TLD + ch * 8);
        const h8 sa = *(const h8*)(P4 + grow * LP4 + n0 + ch * 8), sb = *(const h8*)(P4 + grow * LP4 + DM + n0 + ch * 8);
        h8 o;
#pragma unroll
        for (int e = 0; e < 8; ++e) o[e] = (hf)((float)sa[e] * (float)v1[e] + (float)sb[e] * (float)v2[e]);
        *(h8*)(merged + pr32_off((int)grow, n0 + ch * 8, DM)) = o;
      }
    }
  }
}
DI void phase_F2(const Params& p, char* smem) {
  const hf* merged = (const hf*)(p.ws + O_MERGED); const hf* WoT = (const hf*)(p.ws + O_WO); const float* mod = (const float*)(p.ws + O_MOD);
  const int lane = get_tid() & 63, wave = get_tid() >> 6, wm = wave >> 1, wn = wave & 1, q = lane >> 4, cl = lane & 15;
  constexpr int CBM = 256, CMT = CBM / 32, NTN = DM / 128, NTM = NTOK / CBM;
  TileSched ts = tile_begin(NTM, NTN, p.ws + O_BAR, xcd_words(smem)); int tm, tn;
  while (tile_next(ts, tm, tn)) {
    const int m0 = tm * CBM, n0 = tn * 128;
    f4 acc[CMT][4]; zero_acc<CMT>(acc);
    gemm_mainloop_2set<CBM, false>(acc, merged, WoT, DM, m0, n0, smem);
    hf* t1 = (hf*)smem;
    __syncthreads();
#pragma unroll
    for (int mt = 0; mt < CMT; ++mt)
#pragma unroll
      for (int nt = 0; nt < 4; ++nt)
#pragma unroll
        for (int r = 0; r < 4; ++r) t1[(wm * (CBM / 2) + mt * 16 + q * 4 + r) * TLD + wn * 64 + nt * 16 + cl] = (hf)acc[mt][nt][r];
    __syncthreads();
    {
      const int tid = get_tid();
#pragma unroll
      for (int i = 0; i < CBM / 16; ++i) {
        const int idx = tid + i * 256, row = idx >> 4, ch = idx & 15;
        const size_t grow = (size_t)(m0 + row); const int b = (int)(grow / SEQ), col = n0 + ch * 8;
        const h8 y = *(const h8*)(t1 + row * TLD + ch * 8);
        const float* xp = p.x + grow * DM + col; const float* gp = mod + (size_t)b * 6 * DM + 2 * DM + col; hf* op = (hf*)(p.ws + O_H16) + grow * DM + col;
        const f4 x0 = *(const f4*)xp, x1 = *(const f4*)(xp + 4), g0 = *(const f4*)gp, g1 = *(const f4*)(gp + 4);
        h8 o;
#pragma unroll
        for (int e = 0; e < 4; ++e) { o[e] = (hf)(x0[e] + g0[e] * (float)y[e]); o[4 + e] = (hf)(x1[e] + g1[e] * (float)y[4 + e]); }
        *(h8*)op = o;
      }
    }
  }
}
DI float quant_row_store(const float (&v)[DM / 64], unsigned char* dst, int lane, int bias) {
  float mx = 0.f;
#pragma unroll
  for (int i = 0; i < DM / 64; ++i) mx = fmaxf(mx, fabsf(v[i]));
#pragma unroll
  for (int m = 32; m >= 1; m >>= 1) mx = fmaxf(mx, __shfl_xor(mx, m));
  const float sc = mx > 0.f ? mx * (1.0f / 127.0f) : 1.0f, inv = 1.0f / sc;
#pragma unroll
  for (int i = 0; i < DM / 256; ++i) {
    unsigned w = 0;
#pragma unroll
    for (int j = 0; j < 4; ++j) { int qv = (int)rintf(v[4 * i + j] * inv); qv = qv > 127 ? 127 : (qv < -127 ? -127 : qv); w |= ((unsigned)(qv + bias) & 255u) << (8 * j); }
    *(unsigned*)(dst + i * 256 + lane * 4) = w;
  }
  return sc;
}
template <int MODE> DI void quant4_row_store(const float (&v)[DM / 64], unsigned char* dst, int lane, float& sc_o, float& mn_o) {
  float mx = v[0], mn = v[0];
#pragma unroll
  for (int i = 1; i < DM / 64; ++i) { mx = fmaxf(mx, v[i]); mn = fminf(mn, v[i]); }
#pragma unroll
  for (int m = 32; m >= 1; m >>= 1) { mx = fmaxf(mx, __shfl_xor(mx, m)); mn = fminf(mn, __shfl_xor(mn, m)); }
  {
    float s1 = 0.f, s2 = 0.f;
#pragma unroll
    for (int i = 0; i < DM / 64; ++i) { s1 += v[i]; s2 += v[i] * v[i]; }
    s1 = wave_sum(s1); s2 = wave_sum(s2);
    const float mean = s1 * (1.0f / DM), sd = sqrtf(fmaxf(s2 * (1.0f / DM) - mean * mean, 0.f));
    mn = fmaxf(mn, mean - 2.514f * sd); mx = fminf(mx, mean + 2.514f * sd);
  }
  const float sc = mx > mn ? (mx - mn) * (1.0f / 15.0f) : 1.0f, inv = 1.0f / sc;
#pragma unroll
  for (int i = 0; i < DM / 256; ++i) {
    unsigned nq = 0;
#pragma unroll
    for (int j = 0; j < 4; ++j) { int qv = (int)rintf((v[4 * i + j] - mn) * inv); qv = qv > 15 ? 15 : (qv < 0 ? 0 : qv);
      if (MODE == 0) nq |= (unsigned)qv << (8 * j);
      else { const int t = 4 * (lane & 1) + j; nq |= (unsigned)qv << (4 * ((t & 1) * 4 + (t >> 1))); } }
    const unsigned pn = __shfl_xor(nq, 1);
    if ((lane & 1) == 0) *(unsigned*)(dst + (i * 32 + (lane >> 1)) * 4) = (MODE == 0) ? (nq | (pn << 4)) : (nq | pn);
  }
  sc_o = sc; mn_o = mn;
}
DI void phase_F3(const Params& p) {
  const int tid = get_tid(), lane = tid & 63, wave = tid >> 6;
  const float* mod = (const float*)(p.ws + O_MOD);
  unsigned char* u8 = (unsigned char*)(p.uv + UV_U8); unsigned char* v8 = (unsigned char*)(p.uv + UV_V8); unsigned char* n2q = (unsigned char*)(p.uv + UV_N2Q);
  float* su = (float*)(p.uv + UV_SU); float* sv = (float*)(p.uv + UV_SV); float* sn = (float*)(p.uv + UV_SN);
  for (int row = blockIdx.x * 4 + wave; row < NTOK + 2 * NEXP; row += gridDim.x * 4) {
    float v[DM / 64];
    if (row < NTOK) {
      const hf* xr = (const hf*)(p.ws + O_H16) + (size_t)row * DM; const int b = row / SEQ; float ss = 0.f;
#pragma unroll
      for (int i = 0; i < DM / 256; ++i) { const h4 t4 = *(const h4*)(xr + i * 256 + lane * 4); f4 t = {(float)t4[0], (float)t4[1], (float)t4[2], (float)t4[3]}; v[4 * i] = t[0]; v[4 * i + 1] = t[1]; v[4 * i + 2] = t[2]; v[4 * i + 3] = t[3]; ss += t[0] * t[0] + t[1] * t[1] + t[2] * t[2] + t[3] * t[3]; }
      ss = wave_sum(ss);
      const float rstd = rsqrtf(ss * (1.0f / DM) + EPSN);
      const float* mb = mod + (size_t)b * 6 * DM;
#pragma unroll
      for (int i = 0; i < DM / 256; ++i) {
        const int d = i * 256 + lane * 4;
#pragma unroll
        for (int j = 0; j < 4; ++j) v[4 * i + j] = v[4 * i + j] * rstd * (1.0f + mb[4 * DM + d + j]) + mb[3 * DM + d + j];
      }
      const float sc = quant_row_store(v, n2q + (size_t)row * DM, lane, 0);
      if (lane == 0) sn[row] = sc;
    } else {
      const bool isu = row < NTOK + NEXP; const int e = isu ? row - NTOK : row - NTOK - NEXP;
      const float* xr = (isu ? p.pu : p.pv) + (size_t)e * DM;
#pragma unroll
      for (int i = 0; i < DM / 256; ++i) { f4 t = *(const f4*)(xr + i * 256 + lane * 4); v[4 * i] = t[0]; v[4 * i + 1] = t[1]; v[4 * i + 2] = t[2]; v[4 * i + 3] = t[3]; }
      float sc, mn;
      if (isu) { quant4_row_store<0>(v, u8 + (size_t)e * (DM / 2), lane, sc, mn); if (lane == 0) { su[2 * e] = sc; su[2 * e + 1] = mn; } }
      else { quant4_row_store<1>(v, v8 + (size_t)e * (DM / 2), lane, sc, mn); if (lane == 0) { sv[2 * e] = sc; sv[2 * e + 1] = mn; } }
    }
  }
}
DI void cmpx_desc(unsigned& hi, unsigned& lo) { const unsigned x = hi, y = lo; hi = x > y ? x : y; lo = x > y ? y : x; }
DI void bitonic_merge16(unsigned (&v)[16]) {
#pragma unroll
  for (int j = 8; j > 0; j >>= 1)
#pragma unroll
    for (int i = 0; i < 16; ++i) { const int l = i ^ j; if (l > i) cmpx_desc(v[i], v[l]); }
}
DI void bitonic_sort16(unsigned (&v)[16]) {
#pragma unroll
  for (int k = 2; k <= 16; k <<= 1)
#pragma unroll
    for (int j = k >> 1; j > 0; j >>= 1)
#pragma unroll
      for (int i = 0; i < 16; ++i) { const int l = i ^ j; if (l > i) { if ((i & k) == 0) cmpx_desc(v[i], v[l]); else cmpx_desc(v[l], v[i]); } }
}
DI void phase_G1(const Params& p, char* smem) {
  const hf* subk = (const hf*)(p.ws + O_SUBK);
  int* experts = (int*)(p.ws + O_P4); float* gates = (float*)(p.ws + O_P4 + (size_t)NTOK * 128 * 4);
  const float* sn_ = (const float*)(p.uv + UV_SN); const float* sq8 = (const float*)(p.ws + O_SQ8);
  const int tid = get_tid(), lane = tid & 63, wave = tid >> 6, wm = wave >> 1, wn = wave & 1, q = lane >> 4, cl = lane & 15;
  constexpr int NTM = NTOK / 128;
  hf* qt = (hf*)smem;
  float* sb = (float*)smem;
  unsigned* tl = (unsigned*)(smem + 2 * 64 * 129 * 4);
  TileSched ts = tile_begin(NTM, 8, p.ws + O_BAR, xcd_words(smem)); int tm, tn;
  while (tile_next(ts, tm, tn)) {
    const int hh = tn, mbase = tm * 128, n0 = hh * 128;
    f4 acc[4][4]; zero_acc<4>(acc);
    gemm_mainloop_r3<128, true>(acc, (const hf*)(p.uv + UV_N2Q), DM / 2, (const hf*)(p.ws + O_WQ8), DM / 2, DM / 2, mbase, n0, smem);
    for (int half = 0; half < 2; ++half) {
    const int m0 = mbase + half * 64;
    __syncthreads();
    if (wm == half) {
#pragma unroll
      for (int mt = 0; mt < 4; ++mt)
#pragma unroll
        for (int nt = 0; nt < 4; ++nt)
#pragma unroll
          for (int r = 0; r < 4; ++r) { const int row = mt * 16 + q * 4 + r, col = wn * 64 + nt * 16 + cl; const i4 ai = __builtin_bit_cast(i4, acc[mt][nt]);
            qt[row * 136 + col] = (hf)((float)ai[r] * (sn_[m0 + row] * sq8[n0 + col])); }
    }
    __syncthreads();
    const int pp = wave & 1, mh = wave >> 1;
    h8 af[2][2];
#pragma unroll
    for (int mt = 0; mt < 2; ++mt)
#pragma unroll
      for (int ks = 0; ks < 2; ++ks) af[mt][ks] = *(const h8*)(qt + (mh * 32 + mt * 16 + cl) * 136 + pp * 64 + ks * 32 + q * 8);
    __syncthreads();
    const hf* skp = subk + (size_t)(hh * 2 + pp) * 128 * 64;
#pragma unroll
    for (int nt = 0; nt < 8; ++nt) {
      h8 b0 = *(const h8*)(skp + (nt * 16 + cl) * 64 + q * 8), b1 = *(const h8*)(skp + (nt * 16 + cl) * 64 + 32 + q * 8);
#pragma unroll
      for (int mt = 0; mt < 2; ++mt) {
        f4 s = f4{0, 0, 0, 0};
        s = mfma16(af[mt][0], b0, s); s = mfma16(af[mt][1], b1, s);
#pragma unroll
        for (int r = 0; r < 4; ++r) sb[(pp * 64 + mh * 32 + mt * 16 + q * 4 + r) * 129 + nt * 16 + cl] = s[r];
      }
    }
    __syncthreads();
    {
      const int rp = tid >> 1, sub = tid & 1;
      const float* sr = sb + rp * 129 + sub * 64;
      unsigned top[16];
#pragma unroll
      for (int g = 0; g < 4; ++g) {
        unsigned v[16];
#pragma unroll
        for (int i = 0; i < 16; ++i) { const int n = sub * 64 + g * 16 + i; v[i] = (f2ord(sr[g * 16 + i]) & ~127u) | (unsigned)(127 - n); }
        bitonic_sort16(v);
        if (g == 0) {
#pragma unroll
          for (int i = 0; i < 16; ++i) top[i] = v[i];
        } else {
#pragma unroll
          for (int i = 0; i < 16; ++i) top[i] = top[i] > v[15 - i] ? top[i] : v[15 - i];
          bitonic_merge16(top);
        }
      }
      unsigned oth[16];
#pragma unroll
      for (int i = 0; i < 16; ++i) oth[i] = __shfl_xor(top[i], 1);
#pragma unroll
      for (int i = 0; i < 16; ++i) top[i] = top[i] > oth[15 - i] ? top[i] : oth[15 - i];
      bitonic_merge16(top);
      if (sub == 0) {
#pragma unroll
        for (int i = 0; i < 16; ++i) tl[rp * 16 + i] = top[i];
      }
    }
    __syncthreads();
    {
      const int tid2 = get_tid();
      const int rp = tid2 >> 2, sub = tid2 & 3;
      constexpr unsigned long long PT0 = 0x7060504030201000ull;
      constexpr unsigned long long PT1 = 0xf0e0d0c0b0a09080ull;
      constexpr unsigned long long PT2 = 0x7161514131211101ull;
      constexpr unsigned long long PT3 = 0x2313034232221202ull;
      constexpr unsigned long long PT4 = 0x1606150524140433ull;
      constexpr unsigned long long PT5 = 0x0d0c0b0a09081707ull;
      constexpr unsigned long long PT6 = 0xffffffffffff0f0eull;
      constexpr unsigned long long PT7 = 0xffffffffffffffffull;
      const unsigned long long wlo = sub == 0 ? PT0 : sub == 1 ? PT2 : sub == 2 ? PT4 : PT6;
      const unsigned long long whi = sub == 0 ? PT1 : sub == 1 ? PT3 : sub == 2 ? PT5 : PT7;
      const unsigned* t1 = tl + rp * 16; const unsigned* t2 = tl + (64 + rp) * 16;
      unsigned top[16];
#pragma unroll
      for (int s = 0; s < 16; ++s) {
        const unsigned e = (unsigned)(((s < 8 ? wlo : whi) >> (8 * (s & 7))) & 255ull);
        const int i = e & 15, j = (e >> 4) & 15;
        const float v = ord2f(t1[i] & ~127u) + ord2f(t2[j] & ~127u);
        top[s] = (e == 255u) ? 0u : ((f2ord(v) & ~255u) | (unsigned)(255 - (i * 16 + j)));
      }
      bitonic_sort16(top);
#pragma unroll
      for (int x = 1; x <= 2; x <<= 1) {
        unsigned oth[16];
#pragma unroll
        for (int i = 0; i < 16; ++i) oth[i] = __shfl_xor(top[i], x);
#pragma unroll
        for (int i = 0; i < 16; ++i) top[i] = top[i] > oth[15 - i] ? top[i] : oth[15 - i];
        bitonic_merge16(top);
      }
      float vals[16], sm = 0.f;
#pragma unroll
      for (int s = 0; s < 16; ++s) vals[s] = ord2f(top[s] & ~255u);
      const float mx = vals[0];
#pragma unroll
      for (int s = 0; s < 16; ++s) { vals[s] = __expf(vals[s] - mx); sm += vals[s]; }
      const float inv = 1.0f / sm;
      i4 eo; f4 go;
#pragma unroll
      for (int t = 0; t < 4; ++t) {
        const unsigned k = sub == 0 ? top[t] : sub == 1 ? top[4 + t] : sub == 2 ? top[8 + t] : top[12 + t];
        const float g = sub == 0 ? vals[t] : sub == 1 ? vals[4 + t] : sub == 2 ? vals[8 + t] : vals[12 + t];
        const int ci = 255 - (int)(k & 255u);
        const int e1 = 127 - (int)(t1[ci >> 4] & 127u), e2 = 127 - (int)(t2[ci & 15] & 127u);
        eo[t] = e1 * 128 + e2; go[t] = g * inv;
      }
      const size_t ob_ = ((size_t)(m0 + rp) * 8 + hh) * 16 + sub * 4;
      *(i4*)(experts + ob_) = eo; *(f4*)(gates + ob_) = go;
    }
  }
  }
}
#ifdef EMU
DI h2 pkfma(h2 a, h2 b, h2 c) { return a * b + c; }
#else
DI h2 pkfma(h2 a, h2 b, h2 c) { return __builtin_elementwise_fma(a, b, c); }
#endif
constexpr int VPL = DM / 64;
constexpr int G2_WAVE_LDS = 128 * 8 + 128 * 4;
DI void phase_G2(const Params& p, char* smem, bool dry) {
  const unsigned char* u8 = (const unsigned char*)(p.uv + UV_U8); const unsigned char* v8 = (const unsigned char*)(p.uv + UV_V8); const unsigned char* n2q = (const unsigned char*)(p.uv + UV_N2Q);
  const float* su = (const float*)(p.uv + UV_SU); const float* sv = (const float*)(p.uv + UV_SV); const float* sn = (const float*)(p.uv + UV_SN);
  const int* experts = (const int*)(p.ws + O_P4); const float* gates = (const float*)(p.ws + O_P4 + (size_t)NTOK * 128 * 4);
  const float* mod = (const float*)(p.ws + O_MOD);
  const int tid = get_tid(), lane = tid & 63, wave = tid >> 6, half = lane >> 5, li = lane & 31;
  char* wl = smem + wave * G2_WAVE_LDS;
  unsigned* coef2 = (unsigned*)wl; int* eix = (int*)(wl + 1024);
  constexpr int DW = VPL / 4;
  const int tok0 = blockIdx.x * 4 + wave;
  int e0n = 0, e1n = 0; float sntn = 0.f; int xqn[2 * DW];
  { const int tc = tok0 < NTOK ? tok0 : NTOK - 1;
    e0n = experts[(size_t)tc * 128 + lane]; e1n = experts[(size_t)tc * 128 + 64 + lane]; sntn = sn[tc];
#pragma unroll
    for (int w = 0; w < 2 * DW; ++w) xqn[w] = ((const int*)(n2q + (size_t)tc * DM + li * (8 * DW)))[w]; }
  for (int tok = tok0; tok < NTOK; tok += gridDim.x * 4) {
    const int b = tok / SEQ;
    wave_sync();
    eix[lane] = e0n; eix[64 + lane] = e1n;
    const float snt = sntn;
    int xq[2 * DW];
#pragma unroll
    for (int w = 0; w < 2 * DW; ++w) xq[w] = xqn[w];
    int sxq = 0;
#pragma unroll
    for (int w = 0; w < 2 * DW; ++w) sxq = __builtin_amdgcn_sdot4(xq[w], 0x01010101, sxq, false);
#pragma unroll
    for (int m = 16; m >= 1; m >>= 1) sxq += __shfl_xor(sxq, m);
    const float fsx = (float)sxq;
    wave_sync();
    float cmn = 0.f;
    for (int eb = 0; eb < 2; ++eb) {
      int part[32];
      const int em = eb * 64 + lane; const int eim = eix[em];
      const float su_e = su[2 * eim], mu_e = su[2 * eim + 1], sv_e = sv[2 * eim], mv_e = sv[2 * eim + 1], g_e = gates[(size_t)tok * 128 + em];
#pragma unroll
      for (int e = 0; e < 32; ++e) {
        const unsigned* ur = (const unsigned*)(u8 + (size_t)eix[eb * 64 + half * 32 + e] * (DM / 2) + li * (4 * DW));
        int acc = 0;
#pragma unroll
        for (int k = 0; k < DW; ++k) { const unsigned w = ur[k];
          acc = __builtin_amdgcn_sdot4((int)(w & 0x0F0F0F0Fu), xq[2 * k], acc, false);
          acc = __builtin_amdgcn_sdot4((int)((w >> 4) & 0x0F0F0F0Fu), xq[2 * k + 1], acc, false); }
        part[e] = acc;
      }
      const bool b4 = (lane & 16) != 0, b3 = (lane & 8) != 0, b2 = (lane & 4) != 0, b1 = (lane & 2) != 0, b0 = (lane & 1) != 0;
      int r16[16], r8[8], r4[4], r2[2];
#pragma unroll
      for (int i = 0; i < 16; ++i) { const int snd = b4 ? part[i] : part[16 + i], kp = b4 ? part[16 + i] : part[i]; r16[i] = kp + __shfl_xor(snd, 16); }
#pragma unroll
      for (int i = 0; i < 8; ++i) { const int snd = b3 ? r16[i] : r16[8 + i], kp = b3 ? r16[8 + i] : r16[i]; r8[i] = kp + __shfl_xor(snd, 8); }
#pragma unroll
      for (int i = 0; i < 4; ++i) { const int snd = b2 ? r8[i] : r8[4 + i], kp = b2 ? r8[4 + i] : r8[i]; r4[i] = kp + __shfl_xor(snd, 4); }
#pragma unroll
      for (int i = 0; i < 2; ++i) { const int snd = b1 ? r4[i] : r4[2 + i], kp = b1 ? r4[2 + i] : r4[i]; r2[i] = kp + __shfl_xor(snd, 2); }
      const int r1 = (b0 ? r2[1] : r2[0]) + __shfl_xor(b0 ? r2[0] : r2[1], 1);
      { const float av = ((float)r1 * su_e + fsx * mu_e) * snt;
        const float cr = 0.5f * av * (1.0f + erff(av * 0.70710678118654752f)) * g_e, cs = cr * sv_e;
        cmn += cr * mv_e;
        const hf ca = (hf)(cs * 16384.0f), cb = (hf)(cs * 1024.0f);
        h2 pa = {ca, ca}, pb = {cb, cb};
        coef2[2 * em] = __builtin_bit_cast(unsigned, pa); coef2[2 * em + 1] = __builtin_bit_cast(unsigned, pb); }
    }
    wave_sync();
    { const int tn = tok + gridDim.x * 4; const int tc = tn < NTOK ? tn : NTOK - 1;
      e0n = experts[(size_t)tc * 128 + lane]; e1n = experts[(size_t)tc * 128 + 64 + lane]; sntn = sn[tc];
#pragma unroll
      for (int w = 0; w < 2 * DW; ++w) xqn[w] = ((const int*)(n2q + (size_t)tc * DM + li * (8 * DW)))[w]; }
    const int dbase = li * (8 * DW) + half * (4 * DW);
    float hres[VPL], mg[VPL];
#pragma unroll
    for (int i = 0; i < VPL; ++i) { hres[i] = (float)((const hf*)(p.ws + O_H16))[(size_t)tok * DM + dbase + i]; mg[i] = mod[(size_t)b * 6 * DM + 5 * DM + dbase + i]; }
    cmn = wave_sum(cmn);
    h2 ya[4 * DW];
#pragma unroll
    for (int i = 0; i < 4 * DW; ++i) ya[i] = (h2){(hf)0.f, (hf)0.f};
#pragma unroll 8
    for (int e = 0; e < 64; ++e) {
      const int row = 2 * e + half;
      const unsigned* vr = (const unsigned*)(v8 + (size_t)eix[row] * (DM / 2) + li * (4 * DW));
      const h2 ca = __builtin_bit_cast(h2, coef2[2 * row]), cb = __builtin_bit_cast(h2, coef2[2 * row + 1]);
#pragma unroll
      for (int k = 0; k < DW; ++k) { const unsigned w = vr[k], w8 = w >> 8;
        ya[4 * k + 0] = pkfma(__builtin_bit_cast(h2, w & 0x000F000Fu), ca, ya[4 * k + 0]);
        ya[4 * k + 1] = pkfma(__builtin_bit_cast(h2, w & 0x00F000F0u), cb, ya[4 * k + 1]);
        ya[4 * k + 2] = pkfma(__builtin_bit_cast(h2, w8 & 0x000F000Fu), ca, ya[4 * k + 2]);
        ya[4 * k + 3] = pkfma(__builtin_bit_cast(h2, w8 & 0x00F000F0u), cb, ya[4 * k + 3]); }
    }
    float y[VPL];
#pragma unroll
    for (int i = 0; i < 2 * DW; ++i) {
      const unsigned snd = __builtin_bit_cast(unsigned, half ? ya[i] : ya[2 * DW + i]);
      const h2 oth = __builtin_bit_cast(h2, (unsigned)__shfl_xor((int)snd, 32));
      const h2 mine = half ? ya[2 * DW + i] : ya[i];
      y[2 * i] = ((float)mine[0] + (float)oth[0]) * 1024.0f + cmn; y[2 * i + 1] = ((float)mine[1] + (float)oth[1]) * 1024.0f + cmn;
    }
    float hv[VPL]; float ss = 0.f;
#pragma unroll
    for (int i = 0; i < VPL; ++i) { const float v = hres[i] + mg[i] * y[i]; hv[i] = v; ss += v * v; }
    ss = wave_sum(ss);
    const float rstd = rsqrtf(ss * (1.0f / DM) + EPSN);
#pragma unroll
    for (int i = 0; i < VPL; ++i) { const int d = dbase + i; const float o = hv[i] * rstd * p.fnw[d];
      if (dry) ((hf*)(p.ws + O_MERGED))[(size_t)tok * DM + d] = (hf)o; else p.out[(size_t)tok * DM + d] = o; }
  }
}

constexpr int cmax(int a, int b) { return a > b ? a : b; }
constexpr int LDS_GEMM = cmax(cmax((128 + 128) * (GBK_MAX + 8) * 2, 2 * 128 * TLD * 2), 256 * TLD * 2);
constexpr int LDS_A = cmax(64 * 65 * 4, (BATCH * DM + 4 * BATCH * 64) * 4);
constexpr int LDS_D1 = 2 * 64 * 72 * 2 + 64 * 128 * 4 + 64 * 64 * 4 + 512;
constexpr int LDS_E2 = 16 + 4 * E2_WAVE_LDS + 2 * 64 * 72 * 2;
constexpr int LDS_G1 = 2 * 64 * 129 * 4 + 2 * 64 * 16 * 4;
constexpr int LDS_G2 = 4 * G2_WAVE_LDS;
constexpr int SMEM_BYTES = cmax(cmax(cmax(LDS_GEMM, LDS_A), cmax(LDS_D1, LDS_E2)), cmax(cmax(LDS_G1, LDS_G2), LDS_E1));
constexpr int NPHASE = 11;
DI const volatile unsigned* xcd_words(char* smem) { return (const volatile unsigned*)(smem + SMEM_BYTES); }

DI void run_phase(const Params& p, int ph, char* smem, bool dry) {
  switch (ph) {
    case 0: phase_A(p, smem); break;
    case 1: phase_B(p); break;
    case 2: phase_C(p, smem); break;
    case 3: phase_D1(p, smem); break;
    case 4: if (!dry) phase_E1(p, smem); phase_E2(p, smem, dry); break;
    case 5: break;
    case 6: phase_F1(p, smem); break;
    case 7: phase_F2(p, smem); break;
    case 8: phase_F3(p); break;
    case 9: phase_G1(p, smem); break;
    case 10: phase_G2(p, smem, dry); break;
  }
}

#ifdef EMU
static void emu_kernel_all(void* arg) {
  const Params& p = *(const Params*)arg; char* smem = emu_cur->blk->smem;
  for (int ph = 0; ph < NPHASE; ++ph) { run_phase(p, ph, smem, false); emu_grid_sync(); }
}
#else
template <int PH> __global__ void __launch_bounds__(256, 2) phase_kernel(Params p) {
  __shared__ __attribute__((aligned(16))) char smem[SMEM_BYTES + 16];
  run_phase(p, PH, smem, false);
}
#if !MULTI_LAUNCH
#ifndef PROBE_DUP
#define PROBE_DUP 0
#endif
__global__ void __launch_bounds__(256, 2) mega_kernel(Params p) {
  __shared__ __attribute__((aligned(16))) char smem[SMEM_BYTES + 16];
  cooperative_groups::grid_group grid = cooperative_groups::this_grid();
  volatile LAS unsigned* st = (volatile LAS unsigned*)(smem + SMEM_BYTES);
  g_wtab[hw_wave_key()] = (unsigned char)(threadIdx.x >> 6);
  if (threadIdx.x == 0) { st[0] = 0u; st[1] = 0u; }
  __syncthreads();
  if (PROBE_DUP & 1) run_phase(p, 0, smem, false);
  run_phase(p, 0, smem, false);
  grid.sync();
  XcdBarrier xb = xcd_barrier_post((unsigned*)(p.ws + O_BAR), st);
#define XBAR() { xcd_barrier(xb); if (PROBE_BAR2) xcd_barrier(xb); }
#define PH(k) { if (PROBE_DUP & (1 << (k))) { run_phase(p, (k), smem, true); xcd_barrier(xb); } run_phase(p, (k), smem, false); }
  PH(1); XBAR(); PH(2); XBAR(); PH(3); XBAR(); PH(4); XBAR();
  PH(6); XBAR(); PH(7); XBAR(); PH(8); XBAR(); PH(9); XBAR(); PH(10);
#undef PH
}
#endif
#endif

extern "C" void kernel_launch(void* const* d_in, const int* in_sizes, int n_in, void* d_out, int out_size, void* d_ws, size_t ws_size, hipStream_t stream) {
  Params p{};
  p.x = (const float*)d_in[0]; p.c = (const float*)d_in[1]; p.pos = (const int*)d_in[2]; p.w_ada = (const float*)d_in[3]; p.b_ada = (const float*)d_in[4];
  p.w_in = (const float*)d_in[5]; p.conv_w = (const float*)d_in[6]; p.a_log = (const float*)d_in[7]; p.dt_bias = (const float*)d_in[8]; p.norm_b_w = (const float*)d_in[9];
  p.w_pa = (const float*)d_in[10]; p.w_pb = (const float*)d_in[11]; p.w_o = (const float*)d_in[12]; p.wq = (const float*)d_in[13]; p.subk = (const float*)d_in[14];
  p.pu = (const float*)d_in[15]; p.pv = (const float*)d_in[16]; p.fnw = (const float*)d_in[17];
  p.out = (float*)d_out; p.ws = (char*)d_ws;
#ifdef EMU
  const int grid = 4;
  p.dscan = p.ws + WS_TOTAL; p.uv = p.ws + WS_TOTAL + DSCAN_BYTES;
  if (WS_TOTAL + DSCAN_BYTES + UV_BYTES > ws_size) { fprintf(stderr, "ws too small\n"); exit(2); }
  if (O_SCR + (size_t)grid * QBT * SEQ * 4 > O_OB) { fprintf(stderr, "scratch overflow\n"); exit(2); }
  fprintf(stderr, "emu: SMEM_BYTES=%d WS_TOTAL=%zu\n", SMEM_BYTES, WS_TOTAL);
  emu_launch(emu_kernel_all, &p, grid, 256, SMEM_BYTES);
#else
  static_assert((size_t)NTOK * DM * 4 >= DSCAN_BYTES, "d_out too small for scan scratch");
  static_assert(UV_BYTES <= (size_t)NTOK * LP1 * 2, "P1 too small for expert tables");
  p.dscan = (char*)d_out; p.uv = p.ws + O_P1;
  static int grid = 0;
  if (!grid) {
    int dev = 0, cus = 0, per_cu = 0;
    hipGetDevice(&dev); hipDeviceGetAttribute(&cus, hipDeviceAttributeMultiprocessorCount, dev);
#if MULTI_LAUNCH
    hipOccupancyMaxActiveBlocksPerMultiprocessor(&per_cu, phase_kernel<5>, 256, 0);
#else
    hipOccupancyMaxActiveBlocksPerMultiprocessor(&per_cu, mega_kernel, 256, 0);
#endif
    if (per_cu > 2) per_cu = 2;
    if (per_cu < 1) per_cu = 1;
    grid = cus * per_cu;
    if (grid > 512) grid = 512;
  }
  if (WS_TOTAL > ws_size) { fprintf(stderr, "workspace too small: need %zu have %zu\n", WS_TOTAL, ws_size); return; }
#if MULTI_LAUNCH
  hipLaunchKernelGGL(phase_kernel<0>, dim3(grid), dim3(256), 0, stream, p);
  hipLaunchKernelGGL(phase_kernel<1>, dim3(grid), dim3(256), 0, stream, p);
  hipLaunchKernelGGL(phase_kernel<2>, dim3(grid), dim3(256), 0, stream, p);
  hipLaunchKernelGGL(phase_kernel<3>, dim3(grid), dim3(256), 0, stream, p);
  hipLaunchKernelGGL(phase_kernel<4>, dim3(grid), dim3(256), 0, stream, p);
  hipLaunchKernelGGL(phase_kernel<5>, dim3(grid), dim3(256), 0, stream, p);
  hipLaunchKernelGGL(phase_kernel<6>, dim3(grid), dim3(256), 0, stream, p);
  hipLaunchKernelGGL(phase_kernel<7>, dim3(grid), dim3(256), 0, stream, p);
  hipLaunchKernelGGL(phase_kernel<8>, dim3(grid), dim3(256), 0, stream, p);
  hipLaunchKernelGGL(phase_kernel<9>, dim3(grid), dim3(256), 0, stream, p);
  hipLaunchKernelGGL(phase_kernel<10>, dim3(grid), dim3(256), 0, stream, p);
#else
  void* args[] = {&p};
  hipError_t e = hipLaunchCooperativeKernel((void*)mega_kernel, dim3(grid), dim3(256), args, 0, stream);
  if (e != hipSuccess) fprintf(stderr, "cooperative launch failed: %s (grid %d)\n", hipGetErrorString(e), grid);
#endif
#endif
}
```

```cpp
#ifdef EMU
#include "hip_emu.h"
#else
#include <hip/hip_runtime.h>
#include <hip/hip_cooperative_groups.h>
#include <cstdio>
#include <cstdint>
#endif

#ifndef PROBE_BAR2
#define PROBE_BAR2 0
#endif
#ifndef REP_CEPI
#define REP_CEPI 1
#endif
#ifndef REP_CMAIN
#define REP_CMAIN 1
#endif
#ifndef REP_IDX
#define REP_IDX 1
#endif
#ifndef REP_SEL
#define REP_SEL 1
#endif
#ifndef REP_QK
#define REP_QK 1
#endif
#ifndef REP_PV
#define REP_PV 1
#endif
#ifndef MULTI_LAUNCH
#define MULTI_LAUNCH 0
#endif

#ifdef EMU
#ifndef EMU_B
#define EMU_B 2
#endif
#ifndef EMU_S
#define EMU_S 512
#endif
#ifndef EMU_D
#define EMU_D 256
#endif
constexpr int BATCH = EMU_B, SEQ = EMU_S, DM = EMU_D;
#else
constexpr int BATCH = 8, SEQ = 4096, DM = 1024;
#endif
constexpr int NTOK = BATCH * SEQ;
constexpr int TOPK = (SEQ / 4 < 256) ? SEQ / 4 : 256;
constexpr int NCHK = SEQ / 64;
constexpr int NEXP = 16384;
constexpr int C_QA = 0, C_KA = 512, C_VA = 640, C_QI = 768, C_KI = 1792, C_WI = 1856, C_BB = 1872, C_AB = 1880;
constexpr int C_QB = 1920, C_ZB = 3456, C_GA = 3968;
constexpr int NP = 3968 + 2 * DM;
constexpr int IN_W = 3936 + 2 * DM;
constexpr int LP1 = 1920, LP2 = 1536, LP3 = 512, LP4 = 2 * DM;
constexpr int QBT = 16;
constexpr float EPSN = 1e-6f;

typedef _Float16 hf;
typedef _Float16 h8 __attribute__((ext_vector_type(8)));
typedef _Float16 h4 __attribute__((ext_vector_type(4)));
typedef _Float16 h2 __attribute__((ext_vector_type(2)));
typedef float f4 __attribute__((ext_vector_type(4)));
typedef int i4 __attribute__((ext_vector_type(4)));
#define DI __device__ __forceinline__
#ifdef EMU
#define NTLD4(p_) (*(const f4*)(p_))
#else
#define NTLD4(p_) __builtin_nontemporal_load((const f4*)(p_))
#endif

constexpr size_t al256(size_t x) { return (x + 255) & ~size_t(255); }
constexpr size_t O_MOD = 0;
constexpr size_t O_CNT = O_MOD + al256((size_t)BATCH * 6 * DM * 4);
constexpr size_t O_BAR = O_CNT + 256;
constexpr size_t O_CS = O_BAR + 16384;
constexpr size_t O_AUX = O_CS + al256((size_t)NTOK * 16 * 4);
constexpr size_t O_WIN = O_AUX + al256((size_t)NTOK * 32 * 4);
constexpr size_t O_WPA = O_WIN + al256((size_t)NP * DM * 2);
constexpr size_t O_WPB = O_WPA + al256((size_t)DM * 512 * 2);
constexpr size_t O_WO = O_WPB + al256((size_t)DM * 512 * 2);
constexpr size_t O_WQ = O_WO + al256((size_t)DM * DM * 2);
constexpr size_t O_SUBK = O_WQ + al256((size_t)1024 * DM * 2);
constexpr size_t O_EG = O_SUBK + al256((size_t)8 * 2 * 128 * 64 * 2);
constexpr size_t O_P1 = O_EG + al256((size_t)BATCH * 8 * NCHK * 4);
constexpr size_t O_P3 = O_P1 + al256((size_t)NTOK * LP1 * 2);
constexpr size_t O_P4 = O_P3 + al256((size_t)NTOK * LP3 * 2);
constexpr size_t R_BYTES = ((size_t)NTOK * DM * 2 > (size_t)NTOK * 1024) ? (size_t)NTOK * DM * 2 : (size_t)NTOK * 1024;
constexpr size_t O_R = O_P4 + al256((size_t)NTOK * LP4 * 2);
constexpr size_t O_P2 = O_R + al256(R_BYTES);
constexpr size_t O_OB = O_P2 + al256((size_t)NTOK * LP2 * 2);
constexpr size_t O_W8 = O_OB + al256((size_t)NTOK * 512 * 2);
constexpr size_t O_SB8 = O_W8 + al256((size_t)NP * DM);
constexpr size_t O_WQ8 = O_SB8 + al256((size_t)NP * 4);
constexpr size_t O_SQ8 = O_WQ8 + al256((size_t)1024 * DM);
constexpr size_t WS_TOTAL = O_SQ8 + al256((size_t)1024 * 4);
constexpr size_t O_INTRA = O_R;
constexpr size_t O_SCR = O_R + (size_t)NTOK * 1024;
constexpr size_t O_MERGED = O_R;
constexpr size_t O_N2H = O_R + (size_t)NTOK * DM * 2;
constexpr size_t O_H16 = O_P2;
static_assert((size_t)NTOK * DM * 2 <= (size_t)NTOK * LP2 * 2, "P2 too small for h");
constexpr size_t DSCAN_BYTES = (size_t)NTOK * 4096;
constexpr size_t UV_U8 = 0, UV_V8 = (size_t)NEXP * DM, UV_N2Q = (size_t)2 * NEXP * DM, UV_SU = UV_N2Q + (size_t)NTOK * DM, UV_SV = UV_SU + (size_t)NEXP * 8, UV_SN = UV_SV + (size_t)NEXP * 8;
constexpr size_t UV_BYTES = UV_SN + (size_t)NTOK * 4;

struct Params {
  const float *x, *c; const int* pos;
  const float *w_ada, *b_ada, *w_in, *conv_w, *a_log, *dt_bias, *norm_b_w, *w_pa, *w_pb, *w_o, *wq, *subk, *pu, *pv, *fnw;
  float* out; char* ws; char* dscan; char* uv;
};

#ifdef EMU
DI int get_tid() { return (int)threadIdx.x; }
#else
#if MULTI_LAUNCH
DI int get_tid() { int t = threadIdx.x; asm volatile("" : "+v"(t)); return t; }
#else
__shared__ unsigned char g_wtab[64];
DI int hw_wave_key() { return (int)(__builtin_amdgcn_s_getreg(0x2804) & 63u); }
DI int get_tid() {
  const int w = __builtin_amdgcn_readfirstlane((int)g_wtab[hw_wave_key()]);
  int l;
  asm volatile("v_mbcnt_lo_u32_b32 %0, -1, 0\n\tv_mbcnt_hi_u32_b32 %0, -1, %0" : "=v"(l));
  return (w << 6) | l;
}
#endif
#endif
DI f4 mfma16(h8 a, h8 b, f4 c) { return __builtin_amdgcn_mfma_f32_16x16x32_f16(a, b, c, 0, 0, 0); }
DI f4 mfma16_i8(h8 a, h8 b, f4 c) { return __builtin_bit_cast(f4, __builtin_amdgcn_mfma_i32_16x16x64_i8(__builtin_bit_cast(i4, a), __builtin_bit_cast(i4, b), __builtin_bit_cast(i4, c), 0, 0, 0)); }
#ifdef EMU
DI void wave_sync() { int z = 0, r; emu_collective(&z, 4, &r, 4, [](EmuWave*) {}); }
DI void gmem_wave_sync() { wave_sync(); }
#else
DI void wave_sync() { __builtin_amdgcn_fence(__ATOMIC_RELEASE, "wavefront"); __builtin_amdgcn_wave_barrier(); __builtin_amdgcn_fence(__ATOMIC_ACQUIRE, "wavefront"); }
DI void gmem_wave_sync() { __builtin_amdgcn_fence(__ATOMIC_SEQ_CST, "workgroup"); __builtin_amdgcn_wave_barrier(); }
#endif
#ifdef EMU
DI unsigned ld_relaxed_agent(unsigned* p) { return *(volatile unsigned*)p; }
DI void add_relaxed_agent(unsigned* p, unsigned v) { *p += v; }
DI void fence_release_agent() {}
DI void fence_acquire_agent() {}
DI void drain_stores() {}
DI void spin_pause() { emu_yield(); }
#else
DI unsigned ld_relaxed_agent(unsigned* p) { return __hip_atomic_load(p, __ATOMIC_RELAXED, __HIP_MEMORY_SCOPE_AGENT); }
DI void add_relaxed_agent(unsigned* p, unsigned v) { (void)__hip_atomic_fetch_add(p, v, __ATOMIC_RELAXED, __HIP_MEMORY_SCOPE_AGENT); }
DI void fence_release_agent() { __builtin_amdgcn_fence(__ATOMIC_RELEASE, "agent"); asm volatile("s_waitcnt vmcnt(0)" ::: "memory"); }
DI void fence_acquire_agent() { __builtin_amdgcn_fence(__ATOMIC_ACQUIRE, "agent"); asm volatile("s_waitcnt vmcnt(0)" ::: "memory"); }
DI void drain_stores() { asm volatile("s_waitcnt vmcnt(0)" ::: "memory"); }
DI void spin_pause() { __builtin_amdgcn_s_sleep(8); }
#endif
DI float wave_sum(float v) { for (int m = 32; m >= 1; m >>= 1) v += __shfl_xor(v, m); return v; }
DI int wave_sum_i(int v) { for (int m = 32; m >= 1; m >>= 1) v += __shfl_xor(v, m); return v; }
DI float sigmoidf_(float x) { return 1.0f / (1.0f + __expf(-x)); }
DI float siluf_(float x) { return x / (1.0f + __expf(-x)); }
DI float softplusf_(float x) { return x > 20.f ? x : log1pf(__expf(x)); }
DI unsigned f2ord(float f) { unsigned u = __builtin_bit_cast(unsigned, f); return (u & 0x80000000u) ? ~u : (u | 0x80000000u); }
DI float ord2f(unsigned k) { unsigned u = (k & 0x80000000u) ? (k & 0x7fffffffu) : ~k; return __builtin_bit_cast(float, u); }
DI h8 cat44(h4 a, h4 b) { h8 r; r[0] = a[0]; r[1] = a[1]; r[2] = a[2]; r[3] = a[3]; r[4] = b[0]; r[5] = b[1]; r[6] = b[2]; r[7] = b[3]; return r; }
DI h8 cvt_f4f4(f4 a, f4 b) { h8 r; r[0] = (hf)a[0]; r[1] = (hf)a[1]; r[2] = (hf)a[2]; r[3] = (hf)a[3]; r[4] = (hf)b[0]; r[5] = (hf)b[1]; r[6] = (hf)b[2]; r[7] = (hf)b[3]; return r; }
#ifdef EMU
DI h4 lds_read_tr16(const hf* p) {
  h4 r; const hf* pp = p;
  emu_collective(&pp, sizeof(pp), &r, sizeof(r), [&](EmuWave* w) {
    for (int l = 0; l < 64; ++l) { const int gb = l & ~15, i = l & 15; h4 o;
      for (int qq = 0; qq < 4; ++qq) { const hf* src; memcpy(&src, w->in[gb + 4 * qq + (i >> 2)], sizeof(src)); o[qq] = src[i & 3]; }
      memcpy(w->out[l], &o, sizeof(o)); }
  });
  return r;
}
#else
typedef short s4v __attribute__((ext_vector_type(4)));
DI h4 lds_read_tr16(const hf* p) {
  const s4v v = __builtin_amdgcn_ds_read_tr16_b64_v4i16((__attribute__((address_space(3))) s4v*)p);
  return __builtin_bit_cast(h4, v);
}
#endif
DI h8 relu8(h8 v) { const h8 z = h8{0, 0, 0, 0, 0, 0, 0, 0}; return __builtin_elementwise_max(v, z); }
DI h8 permload(const hf* p, int q) { return cat44(*(const h4*)(p + 4 * q), *(const h4*)(p + 16 + 4 * q)); }


#ifndef EMU
#define XB_TMO      128
#define XB_XCNT(j)  (256  + 64 * (j))
#define XB_XSUB(j)  (1280 + 64 * (j))
#define XB_XGEN(j)  (2304 + 64 * (j))
#define XB_TOP      3328
#define XB_TOPGEN   3392
#define XCD_BAR_WORDS 3456
#define XB_SPIN_CAP (1u << 22)
#define LAS __attribute__((address_space(3)))
DI unsigned xb_ld(unsigned* p) { return __hip_atomic_load(p, __ATOMIC_RELAXED, __HIP_MEMORY_SCOPE_AGENT); }
DI unsigned xb_add(unsigned* p, unsigned v) { return __hip_atomic_fetch_add(p, v, __ATOMIC_RELAXED, __HIP_MEMORY_SCOPE_AGENT); }
DI unsigned xb_xcc_id() { return (unsigned)__builtin_amdgcn_s_getreg((3 << 11) | 20) & 0xFu; }
#define XB_SPIN(cond, bar) do { unsigned _sp = 0; while (cond) { __builtin_amdgcn_s_sleep(1); \
    if ((++_sp & 255u) == 0u) { if (xb_ld(&(bar)[XB_TMO])) break; if (_sp > XB_SPIN_CAP) { atomicAdd(&(bar)[XB_TMO], 1u); break; } } } } while (0)
struct XcdBarrier { unsigned* bar; unsigned x; volatile LAS unsigned* st; };
DI XcdBarrier xcd_barrier_post(unsigned* bar, volatile LAS unsigned* st) {
  XcdBarrier b; b.bar = bar; b.x = xb_xcc_id(); b.st = st;
  if (threadIdx.x == 0) { const unsigned li = xb_add(&bar[XB_XCNT(b.x)], 1u); st[2] = b.x; st[3] = li; }
  return b;
}
DI void xcd_barrier_complete(unsigned* bar, unsigned x, unsigned& nloc, unsigned& nx) {
  const unsigned G = gridDim.x * gridDim.y * gridDim.z;
  unsigned sum, cnt, mine, sp = 0u;
  for (;;) {
    sum = 0u; cnt = 0u; mine = 0u;
#pragma unroll
    for (unsigned j = 0; j < 16; ++j) { const unsigned c = xb_ld(&bar[XB_XCNT(j)]); sum += c; cnt += (c > 0u) ? 1u : 0u; mine = (j == x) ? c : mine; }
    if (sum == G) break;
    __builtin_amdgcn_s_sleep(1);
    if ((++sp & 255u) == 0u) { if (xb_ld(&bar[XB_TMO])) break; if (sp > XB_SPIN_CAP) { atomicAdd(&bar[XB_TMO], 1u); break; } }
  }
  nloc = mine > 0u ? mine : 1u; nx = cnt > 0u ? cnt : 1u;
}
DI void xcd_barrier(const XcdBarrier& b) {
  asm volatile("s_waitcnt vmcnt(0)" ::: "memory");
  __syncthreads();
  if (threadIdx.x == 0) {
    unsigned* bar = b.bar;
    __builtin_amdgcn_s_waitcnt(0);
    unsigned nloc = b.st[0], nx = b.st[1];
    if (nloc == 0u) { xcd_barrier_complete(bar, b.x, nloc, nx); b.st[0] = nloc; b.st[1] = nx; }
    const unsigned old = xb_add(&bar[XB_XSUB(b.x)], 1u);
    const unsigned gen = old / nloc;
    if (old + 1u == (gen + 1u) * nloc) {
      __builtin_amdgcn_fence(__ATOMIC_RELEASE, "agent");
      asm volatile("s_waitcnt vmcnt(0)" ::: "memory");
      const unsigned og = xb_add(&bar[XB_TOP], 1u);
      const unsigned tg = og / nx;
      if (og + 1u == (tg + 1u) * nx) xb_add(&bar[XB_TOPGEN], 1u);
      else XB_SPIN(xb_ld(&bar[XB_TOPGEN]) == tg, bar);
      __builtin_amdgcn_fence(__ATOMIC_ACQUIRE, "agent");
      xb_add(&bar[XB_XGEN(b.x)], 1u);
      asm volatile("s_waitcnt vmcnt(0)" ::: "memory");
    } else {
      XB_SPIN(xb_ld(&bar[XB_XGEN(b.x)]) == gen, bar);
      __builtin_amdgcn_fence(__ATOMIC_ACQUIRE, "agent");
      asm volatile("s_waitcnt vmcnt(0)" ::: "memory");
    }
  }
  __syncthreads();
}
#endif

DI size_t pr32_off(int row, int k, int K) { return ((size_t)(row >> 1) * (K / 32) + (k >> 5)) * 64 + (row & 1) * 32 + (k & 31); }

constexpr int GBK_MAX = 128;
template <int BM, int GBK = 128, bool PR = false, bool I8 = false>
DI void gemm_mainloop(f4 (&acc)[BM / 32][4], const hf* __restrict__ A, int lda, const hf* __restrict__ Bt, int ldb, int K, int m0, int n0, char* smem, int krot = 0) {
  constexpr int GLD = GBK + 8, MT = BM / 32, CPR = GBK / 8, ACH = BM * CPR / 256, BCH = 128 * CPR / 256;
  hf* sA = (hf*)smem; hf* sB = sA + BM * GLD;
  const int tid = get_tid(), lane = tid & 63, wave = tid >> 6, wm = wave >> 1, wn = wave & 1;
  h8 ra[ACH], rb[BCH];
#pragma unroll
  for (int i = 0; i < ACH; ++i) { int idx = tid + i * 256, r = idx / CPR, c = idx % CPR; ra[i] = *(const h8*)(PR ? (A + pr32_off(m0 + r, c * 8, K)) : (A + (size_t)(m0 + r) * lda + krot + c * 8)); }
#pragma unroll
  for (int i = 0; i < BCH; ++i) { int idx = tid + i * 256, r = idx / CPR, c = idx % CPR; rb[i] = *(const h8*)(PR ? (Bt + pr32_off(n0 + r, c * 8, K)) : (Bt + (size_t)(n0 + r) * ldb + krot + c * 8)); }
  for (int k0 = 0; k0 < K; k0 += GBK) {
    __syncthreads();
#pragma unroll
    for (int i = 0; i < ACH; ++i) { int idx = tid + i * 256, r = idx / CPR, c = idx % CPR; *(h8*)(sA + r * GLD + c * 8) = ra[i]; }
#pragma unroll
    for (int i = 0; i < BCH; ++i) { int idx = tid + i * 256, r = idx / CPR, c = idx % CPR; *(h8*)(sB + r * GLD + c * 8) = rb[i]; }
    __syncthreads();
    if (k0 + GBK < K) {
      int kn = k0 + GBK + krot; kn = kn >= K ? kn - K : kn;
#pragma unroll
      for (int i = 0; i < ACH; ++i) { int idx = tid + i * 256, r = idx / CPR, c = idx % CPR; ra[i] = *(const h8*)(PR ? (A + pr32_off(m0 + r, kn + c * 8, K)) : (A + (size_t)(m0 + r) * lda + kn + c * 8)); }
#pragma unroll
      for (int i = 0; i < BCH; ++i) { int idx = tid + i * 256, r = idx / CPR, c = idx % CPR; rb[i] = *(const h8*)(PR ? (Bt + pr32_off(n0 + r, kn + c * 8, K)) : (Bt + (size_t)(n0 + r) * ldb + kn + c * 8)); }
    }
#pragma unroll
    for (int ks = 0; ks < GBK / 32; ++ks) {
      h8 af[MT], bf[4];
#pragma unroll
      for (int mt = 0; mt < MT; ++mt) af[mt] = *(const h8*)(sA + (wm * (BM / 2) + mt * 16 + (lane & 15)) * GLD + ks * 32 + (lane >> 4) * 8);
#pragma unroll
      for (int nt = 0; nt < 4; ++nt) bf[nt] = *(const h8*)(sB + (wn * 64 + nt * 16 + (lane & 15)) * GLD + ks * 32 + (lane >> 4) * 8);
#pragma unroll
      for (int mt = 0; mt < MT; ++mt)
#pragma unroll
        for (int nt = 0; nt < 4; ++nt) acc[mt][nt] = I8 ? mfma16_i8(af[mt], bf[nt], acc[mt][nt]) : mfma16(af[mt], bf[nt], acc[mt][nt]);
    }
  }
}
template <int BM, bool I8>
DI void gemm_mainloop_2set(f4 (&acc)[BM / 32][4], const hf* __restrict__ A, const hf* __restrict__ Bt, int K, int m0, int n0, char* smem) {
  constexpr int GBK = 32, GLD = GBK + 8, MT = BM / 32, CPR = GBK / 8, ACH = BM * CPR / 256, BCH = 128 * CPR / 256;
  hf* sA = (hf*)smem; hf* sB = sA + BM * GLD;
  const int tid = get_tid(), lane = tid & 63, wave = tid >> 6, wm = wave >> 1, wn = wave & 1;
  h8 ra[ACH], ra2[ACH], rb[BCH];
  const unsigned voff = (unsigned)(((tid >> 3) * (K / 32)) * 64 + ((tid >> 2) & 1) * 32 + (tid & 3) * 8) * 2u;
#ifndef EMU
  m0 = __builtin_amdgcn_readfirstlane(m0); n0 = __builtin_amdgcn_readfirstlane(n0);
#endif
  const char* Ab = (const char*)(A + (size_t)(m0 >> 1) * (K / 32) * 64);
  const char* Bb = (const char*)(Bt + (size_t)(n0 >> 1) * (K / 32) * 64);
  const size_t chunk_b = (size_t)32 * (K / 32) * 64 * 2;
#ifdef EMU
#define G2LDA(RA, kk) { _Pragma("unroll") for (int i = 0; i < ACH; ++i) RA[i] = *(const h8*)(Ab + i * chunk_b + (size_t)((kk) >> 5) * 128 + voff); }
#define G2LDB(kk) { _Pragma("unroll") for (int i = 0; i < BCH; ++i) rb[i] = *(const h8*)(Bb + i * chunk_b + (size_t)((kk) >> 5) * 128 + voff); }
#else
  const __amdgpu_buffer_rsrc_t rsA = __builtin_amdgcn_make_buffer_rsrc((void*)Ab, 0, 0x7fffffff, 0x00020000);
  const __amdgpu_buffer_rsrc_t rsB = __builtin_amdgcn_make_buffer_rsrc((void*)Bb, 0, 0x7fffffff, 0x00020000);
#define G2LDA(RA, kk) { _Pragma("unroll") for (int i = 0; i < ACH; ++i) RA[i] = __builtin_bit_cast(h8, __builtin_amdgcn_raw_buffer_load_b128(rsA, (int)voff, (int)(i * chunk_b) + ((kk) >> 5) * 128, 0)); }
#define G2LDB(kk) { _Pragma("unroll") for (int i = 0; i < BCH; ++i) rb[i] = __builtin_bit_cast(h8, __builtin_amdgcn_raw_buffer_load_b128(rsB, (int)voff, (int)(i * chunk_b) + ((kk) >> 5) * 128, 0)); }
#endif
#define G2STEP(RA, kb_next, ka_next, LDB_, LDA_) { __syncthreads(); \
    _Pragma("unroll") for (int i = 0; i < ACH; ++i) { const int idx = tid + i * 256, r = idx / CPR, c = idx % CPR; *(h8*)(sA + r * GLD + c * 8) = RA[i]; } \
    _Pragma("unroll") for (int i = 0; i < BCH; ++i) { const int idx = tid + i * 256, r = idx / CPR, c = idx % CPR; *(h8*)(sB + r * GLD + c * 8) = rb[i]; } \
    __syncthreads(); \
    if (LDB_) G2LDB(kb_next) \
    if (LDA_) G2LDA(RA, ka_next) \
    { h8 bf[4]; \
      _Pragma("unroll") for (int nt = 0; nt < 4; ++nt) bf[nt] = *(const h8*)(sB + (wn * 64 + nt * 16 + (lane & 15)) * GLD + (lane >> 4) * 8); \
      _Pragma("unroll") for (int mh = 0; mh < MT / 4; ++mh) { h8 af[4]; \
        _Pragma("unroll") for (int mt = 0; mt < 4; ++mt) af[mt] = *(const h8*)(sA + (wm * (BM / 2) + (mh * 4 + mt) * 16 + (lane & 15)) * GLD + (lane >> 4) * 8); \
        _Pragma("unroll") for (int mt = 0; mt < 4; ++mt) _Pragma("unroll") for (int nt = 0; nt < 4; ++nt) acc[mh * 4 + mt][nt] = I8 ? mfma16_i8(af[mt], bf[nt], acc[mh * 4 + mt][nt]) : mfma16(af[mt], bf[nt], acc[mh * 4 + mt][nt]); } } }
  G2LDB(0) G2LDA(ra, 0) G2LDA(ra2, GBK)
  for (int k0 = 0; k0 < K - 2 * GBK; k0 += 2 * GBK) {
    G2STEP(ra, k0 + GBK, k0 + 2 * GBK, true, true)
    G2STEP(ra2, k0 + 2 * GBK, k0 + 3 * GBK, true, true)
  }
  G2STEP(ra, K - GBK, 0, true, false)
  G2STEP(ra2, 0, 0, false, false)
#undef G2LDA
#undef G2LDB
#undef G2STEP
}
template <int BM, bool I8 = false>
DI void gemm_mainloop_r3(f4 (&acc)[BM / 32][4], const hf* __restrict__ A, int lda, const hf* __restrict__ Bt, int ldb, int K, int m0, int n0, char* smem) {
  constexpr int GLD = 72, MT = BM / 32, ACH = BM * 8 / 256;
  hf* sA = (hf*)smem; hf* sB = sA + BM * GLD;
  const int tid = get_tid(), lane = tid & 63, wave = tid >> 6, wm = wave >> 1, wn = wave & 1;
  const int nk = K / 64;
  h8 a0[ACH], b0[4], a1[ACH], b1[4], a2[ACH], b2[4];
  const hf* Ap = A + (size_t)(m0 + (tid >> 3)) * lda + (tid & 7) * 8;
  const hf* Bp = Bt + (size_t)(n0 + (tid >> 3)) * ldb + (tid & 7) * 8;
#define GL(ra, rb, kt) { const int kk_ = ((kt) < nk ? (kt) : nk - 1) * 64; \
    _Pragma("unroll") for (int i = 0; i < ACH; ++i) ra[i] = *(const h8*)(Ap + (size_t)(i * 32) * lda + kk_); \
    _Pragma("unroll") for (int i = 0; i < 4; ++i) rb[i] = *(const h8*)(Bp + (size_t)(i * 32) * ldb + kk_); }
#define GSTEP(ra, rb, knext) { __syncthreads(); \
    _Pragma("unroll") for (int i = 0; i < ACH; ++i) *(h8*)(sA + ((tid >> 3) + i * 32) * GLD + (tid & 7) * 8) = ra[i]; \
    _Pragma("unroll") for (int i = 0; i < 4; ++i) *(h8*)(sB + ((tid >> 3) + i * 32) * GLD + (tid & 7) * 8) = rb[i]; \
    __syncthreads(); \
    GL(ra, rb, knext) \
    _Pragma("unroll") for (int ks = 0; ks < 2; ++ks) { h8 af[MT], bf[4]; \
      _Pragma("unroll") for (int mt = 0; mt < MT; ++mt) af[mt] = *(const h8*)(sA + (wm * (BM / 2) + mt * 16 + (lane & 15)) * GLD + ks * 32 + (lane >> 4) * 8); \
      _Pragma("unroll") for (int nt = 0; nt < 4; ++nt) bf[nt] = *(const h8*)(sB + (wn * 64 + nt * 16 + (lane & 15)) * GLD + ks * 32 + (lane >> 4) * 8); \
      _Pragma("unroll") for (int mt = 0; mt < MT; ++mt) _Pragma("unroll") for (int nt = 0; nt < 4; ++nt) acc[mt][nt] = I8 ? mfma16_i8(af[mt], bf[nt], acc[mt][nt]) : mfma16(af[mt], bf[nt], acc[mt][nt]); } }
  GL(a0, b0, 0) GL(a1, b1, 1) GL(a2, b2, 2)
  for (int kt = 0; kt < nk; kt += 3) {
    GSTEP(a0, b0, kt + 3)
    if (kt + 1 < nk) GSTEP(a1, b1, kt + 4)
    if (kt + 2 < nk) GSTEP(a2, b2, kt + 5)
  }
#undef GL
#undef GSTEP
}
constexpr int TLD = 136;
template <int MT> DI void zero_acc(f4 (&acc)[MT][4]) {
#pragma unroll
  for (int i = 0; i < MT; ++i)
#pragma unroll
    for (int j = 0; j < 4; ++j) acc[i][j] = f4{0.f, 0.f, 0.f, 0.f};
}


DI const volatile unsigned* xcd_words(char* smem);
struct TileSched { int s, step, total, rp0, ntn, sr; };
DI TileSched tile_begin(int NTM_, int NTN_, const void* g_bar = nullptr, const volatile unsigned* g_st = nullptr) {
  const int G = (int)gridDim.x;
  const int ng = (G % 8 == 0 && NTM_ % 8 == 0) ? 8 : ((G % 4 == 0 && NTM_ % 4 == 0) ? 4 : 1);
  int x = (int)blockIdx.x % ng, li = (int)blockIdx.x / ng; const int rpg = NTM_ / ng;
#ifndef EMU
  if (ng == 8) {
    const unsigned* bar = (const unsigned*)g_bar; bool ok = true;
#pragma unroll
    for (int j = 0; j < 8; ++j) ok = ok && (__hip_atomic_load(&bar[XB_XCNT(j)], __ATOMIC_RELAXED, __HIP_MEMORY_SCOPE_AGENT) == (unsigned)(G / 8));
    if (ok) { x = (int)g_st[2]; li = (int)g_st[3]; }
  }
  x = __builtin_amdgcn_readfirstlane(x); li = __builtin_amdgcn_readfirstlane(li);
#endif
  TileSched t; t.s = li; t.step = G / ng; t.total = rpg * NTN_; t.rp0 = x * rpg; t.ntn = NTN_; t.sr = (rpg % 8 == 0) ? 8 : ((rpg % 4 == 0) ? 4 : ((rpg % 2 == 0) ? 2 : 1));
  return t;
}
DI bool tile_next(TileSched& t, int& tm, int& tn) {
  if (t.s >= t.total) return false;
  const int SC = 8;
  const int per_rg = t.sr * t.ntn, rg = t.s / per_rg, rem = t.s % per_rg, nfull = t.ntn / SC, fullsz = nfull * t.sr * SC;
  int r, c, cg;
  if (rem < fullsz) { cg = rem / (t.sr * SC); const int loc = rem % (t.sr * SC); r = loc / SC; c = loc % SC; }
  else { const int loc = rem - fullsz, w = t.ntn - nfull * SC; cg = nfull; r = loc / w; c = loc % w; }
  tm = t.rp0 + rg * t.sr + r; tn = cg * SC + c; t.s += t.step;
  return true;
}

DI int win_colmap(int c) {
  if (c < 1872) return c;
  if (c < 1880) return 3920 + (c - 1872);
  if (c < 1888) return 3928 + (c - 1880);
  if (c < 1920) return -1;
  if (c < 3968) return 1872 + (c - 1920);
  return 3936 + (c - 3968);
}
DI void transpose_tile(const float* src, int lds_, hf* dst, int K, int k0, int n0, bool use_map, char* smem, bool pr = false) {
  float* t = (float*)smem;
  const int tid = get_tid(), c = tid & 63, r0 = tid >> 6;
  int sc = use_map ? win_colmap(n0 + c) : (n0 + c);
  __syncthreads();
  float tv[16];
#pragma unroll
  for (int i = 0; i < 16; ++i) { int r = i * 4 + r0; tv[i] = sc >= 0 ? src[(size_t)(k0 + r) * lds_ + sc] : 0.f; }
#pragma unroll
  for (int i = 0; i < 16; ++i) t[c * 65 + i * 4 + r0] = tv[i];
  __syncthreads();
#pragma unroll 4
  for (int i = 0; i < 16; ++i) { int r = i * 4 + r0; dst[pr ? pr32_off(n0 + r, k0 + c, K) : ((size_t)(n0 + r) * K + k0 + c)] = (hf)t[r * 65 + c]; }
}
DI void phase_A(const Params& p, char* smem) {
  float* mod = (float*)(p.ws + O_MOD);
  const int tid = get_tid(), lane = tid & 63, wave = tid >> 6;
  constexpr int N_MOD = 6 * DM / 64;
  constexpr int N_WIN = (NP / 64) * (DM / 64), N_WPA = (DM / 64) * 8, N_WO = (DM / 64) * (DM / 64), N_WQ = 16 * (DM / 64);
  constexpr int N_SUBK = 8, N_CS = NTOK / 256;
  constexpr int T1 = N_MOD, T2 = T1 + N_WIN, T3 = T2 + N_WPA, T4 = T3 + N_WPA, T5 = T4 + N_WO, T6 = T5 + N_WQ, T7 = T6 + N_SUBK, T8 = T7 + N_CS;
  if (blockIdx.x == 0) { if (tid < 64) ((int*)(p.ws + O_CNT))[tid] = 0; for (int i = tid; i < 4096; i += 256) ((unsigned*)(p.ws + O_BAR))[i] = 0u; }
  for (int it = blockIdx.x; it < T8; it += gridDim.x) {
    if (it < T1) {
      float* sil = (float*)smem;
      float* red = sil + BATCH * DM;
      __syncthreads();
      for (int i = tid; i < BATCH * DM; i += 256) sil[i] = siluf_(p.c[i]);
      __syncthreads();
      const int j = it * 64 + lane;
      float a[BATCH];
#pragma unroll
      for (int b = 0; b < BATCH; ++b) a[b] = 0.f;
      for (int k = wave * (DM / 4); k < (wave + 1) * (DM / 4); ++k) {
        float w = p.w_ada[(size_t)k * 6 * DM + j];
#pragma unroll
        for (int b = 0; b < BATCH; ++b) a[b] += sil[b * DM + k] * w;
      }
#pragma unroll
      for (int b = 0; b < BATCH; ++b) red[(wave * BATCH + b) * 64 + lane] = a[b];
      __syncthreads();
      if (wave == 0) {
#pragma unroll
        for (int b = 0; b < BATCH; ++b) {
          float s = red[(0 * BATCH + b) * 64 + lane] + red[(1 * BATCH + b) * 64 + lane] + red[(2 * BATCH + b) * 64 + lane] + red[(3 * BATCH + b) * 64 + lane];
          mod[(size_t)b * 6 * DM + j] = s + p.b_ada[j];
        }
      }
    } else if (it < T2) { int t = it - T1; transpose_tile(p.w_in, IN_W, (hf*)(p.ws + O_WIN), DM, (t % (DM / 64)) * 64, (t / (DM / 64)) * 64, true, smem, true); }
    else if (it < T3) { int t = it - T2; transpose_tile(p.w_pa, DM, (hf*)(p.ws + O_WPA), 512, (t % 8) * 64, (t / 8) * 64, false, smem); }
    else if (it < T4) { int t = it - T3; transpose_tile(p.w_pb, DM, (hf*)(p.ws + O_WPB), 512, (t % 8) * 64, (t / 8) * 64, false, smem); }
    else if (it < T5) { int t = it - T4; transpose_tile(p.w_o, DM, (hf*)(p.ws + O_WO), DM, (t % (DM / 64)) * 64, (t / (DM / 64)) * 64, false, smem, true); }
    else if (it < T6) { int t = it - T5; transpose_tile(p.wq, 1024, (hf*)(p.ws + O_WQ), DM, (t % (DM / 64)) * 64, (t / (DM / 64)) * 64, false, smem); }
    else if (it < T7) { int t = it - T6; hf* d = (hf*)(p.ws + O_SUBK); for (int i = tid; i < 16384; i += 256) d[t * 16384 + i] = (hf)p.subk[t * 16384 + i]; }
    else {
      int tok = (it - T7) * 256 + tid;
      float* cs = (float*)(p.ws + O_CS) + (size_t)tok * 16;
      float pos = (float)p.pos[tok];
#pragma unroll
      for (int i = 0; i < 8; ++i) { float inv = powf(500000.0f, -(float)i * 0.125f); float ang = pos * inv; cs[i] = cosf(ang); cs[8 + i] = sinf(ang); }
    }
  }
}

DI void adaln_rows(const float* src, hf* dst, const float* mod, int sh_off, int sc_off, bool pr) {
  const int tid = get_tid(), lane = tid & 63, wave = tid >> 6;
  for (int row = blockIdx.x * 4 + wave; row < NTOK; row += gridDim.x * 4) {
    const float* xr = src + (size_t)row * DM; const int b = row / SEQ;
    float v[DM / 64]; float ss = 0.f;
#pragma unroll
    for (int i = 0; i < DM / 256; ++i) { f4 t = *(const f4*)(xr + i * 256 + lane * 4); v[4 * i] = t[0]; v[4 * i + 1] = t[1]; v[4 * i + 2] = t[2]; v[4 * i + 3] = t[3]; ss += t[0] * t[0] + t[1] * t[1] + t[2] * t[2] + t[3] * t[3]; }
    ss = wave_sum(ss);
    float rstd = rsqrtf(ss * (1.0f / DM) + EPSN);
    const float* mb = mod + (size_t)b * 6 * DM;
#pragma unroll
    for (int i = 0; i < DM / 256; ++i) {
      int d = i * 256 + lane * 4; h4 o;
#pragma unroll
      for (int j = 0; j < 4; ++j) o[j] = (hf)(v[4 * i + j] * rstd * (1.0f + mb[sc_off + d + j]) + mb[sh_off + d + j]);
      *(h4*)(dst + (pr ? pr32_off(row, d, DM) : ((size_t)row * DM + d))) = o;
    }
  }
}

constexpr size_t Q_W8 = 0, Q_SB = al256((size_t)NP * DM), Q_N1 = al256(Q_SB + (size_t)NP * 4), Q_SA = Q_N1 + (size_t)NTOK * DM;
static_assert(Q_SA + (size_t)NTOK * 4 <= DSCAN_BYTES, "scan scratch too small for the int8 in-projection operands");
#ifndef TN_I8
#define TN_I8 0
#endif
static_assert(TN_I8 == 0, "the query scale is folded into the int8 dequant scale: every in-projection tile must take the int8 path");
DI size_t pr64b_off(int row, int k, int K) { return ((size_t)(row >> 1) * (K / 64) + (k >> 6)) * 128 + (row & 1) * 64 + (k & 63); }
DI void phase_B(const Params& p) {
  const int tid = get_tid(), lane = tid & 63, wave = tid >> 6;
  const float* mod = (const float*)(p.ws + O_MOD);
  signed char* n1q = (signed char*)(TN_I8 > 0 ? p.dscan + Q_N1 : p.ws + O_R); float* sa = (float*)(TN_I8 > 0 ? p.dscan + Q_SA : p.ws + O_R + (size_t)NTOK * DM); hf* n1h = (hf*)(p.ws + O_R);
  signed char* w8 = (signed char*)(p.ws + O_W8); float* sb = (float*)(p.ws + O_SB8);
  for (int row = blockIdx.x * 4 + wave; row < NTOK; row += gridDim.x * 4) {
    const float* xr = p.x + (size_t)row * DM; const int b = row / SEQ;
    float v[DM / 64]; float ss = 0.f;
#pragma unroll
    for (int i = 0; i < DM / 256; ++i) { f4 t = NTLD4(xr + i * 256 + lane * 4); v[4 * i] = t[0]; v[4 * i + 1] = t[1]; v[4 * i + 2] = t[2]; v[4 * i + 3] = t[3]; ss += t[0] * t[0] + t[1] * t[1] + t[2] * t[2] + t[3] * t[3]; }
    ss = wave_sum(ss);
    const float rstd = rsqrtf(ss * (1.0f / DM) + EPSN);
    const float* mb = mod + (size_t)b * 6 * DM;
    float mx = 0.f;
#pragma unroll
    for (int i = 0; i < DM / 256; ++i)
#pragma unroll
      for (int j = 0; j < 4; ++j) { const int d = i * 256 + lane * 4 + j; v[4 * i + j] = v[4 * i + j] * rstd * (1.0f + mb[DM + d]) + mb[d]; mx = fmaxf(mx, fabsf(v[4 * i + j])); }
    if (TN_I8 > 0) {
#pragma unroll
      for (int i = 0; i < DM / 256; ++i) { h4 o; o[0] = (hf)v[4 * i]; o[1] = (hf)v[4 * i + 1]; o[2] = (hf)v[4 * i + 2]; o[3] = (hf)v[4 * i + 3]; *(h4*)(n1h + pr32_off(row, i * 256 + lane * 4, DM)) = o; }
    }
#pragma unroll
    for (int m = 32; m >= 1; m >>= 1) mx = fmaxf(mx, __shfl_xor(mx, m));
    const float sc = mx > 0.f ? mx * (1.0f / 127.0f) : 1.0f, inv = 1.0f / sc;
#pragma unroll
    for (int i = 0; i < DM / 256; ++i) {
      unsigned w = 0;
#pragma unroll
      for (int j = 0; j < 4; ++j) { int qv = (int)rintf(v[4 * i + j] * inv); qv = qv > 127 ? 127 : (qv < -127 ? -127 : qv); w |= ((unsigned)qv & 255u) << (8 * j); }
      *(unsigned*)(n1q + pr64b_off(row, i * 256 + lane * 4, DM)) = w;
    }
    if (lane == 0) sa[row] = sc;
  }
  const hf* WinT = (const hf*)(p.ws + O_WIN);
  for (int n = blockIdx.x * 4 + wave; n < NP; n += gridDim.x * 4) {
    constexpr int EPL = DM / 64;
    const hf* wr = WinT + pr32_off(n, lane * EPL, DM);
    float v[EPL]; float mx = 0.f;
#pragma unroll
    for (int i = 0; i < EPL; ++i) { v[i] = (float)wr[i]; mx = fmaxf(mx, fabsf(v[i])); }
#pragma unroll
    for (int m = 32; m >= 1; m >>= 1) mx = fmaxf(mx, __shfl_xor(mx, m));
    const float sc = mx > 0.f ? mx * (1.0f / 127.0f) : 1.0f, inv = 1.0f / sc;
#pragma unroll
    for (int i4_ = 0; i4_ < EPL / 4; ++i4_) {
      unsigned w = 0;
#pragma unroll
      for (int j = 0; j < 4; ++j) { int qv = (int)rintf(v[4 * i4_ + j] * inv); qv = qv > 127 ? 127 : (qv < -127 ? -127 : qv); w |= ((unsigned)qv & 255u) << (8 * j); }
      *(unsigned*)(w8 + pr64b_off(n, lane * EPL + 4 * i4_, DM)) = w;
    }
    if (lane == 0) sb[n] = sc;
  }
  const hf* WqT = (const hf*)(p.ws + O_WQ); signed char* wq8 = (signed char*)(p.ws + O_WQ8); float* sq8 = (float*)(p.ws + O_SQ8);
  for (int n = blockIdx.x * 4 + wave; n < 1024; n += gridDim.x * 4) {
    constexpr int EPL = DM / 64;
    const hf* wr = WqT + (size_t)n * DM + lane * EPL;
    float v[EPL]; float mx = 0.f;
#pragma unroll
    for (int i = 0; i < EPL; ++i) { v[i] = (float)wr[i]; mx = fmaxf(mx, fabsf(v[i])); }
#pragma unroll
    for (int m = 32; m >= 1; m >>= 1) mx = fmaxf(mx, __shfl_xor(mx, m));
    const float sc = mx > 0.f ? mx * (1.0f / 127.0f) : 1.0f, inv = 1.0f / sc;
#pragma unroll
    for (int i4_ = 0; i4_ < EPL / 4; ++i4_) {
      unsigned w = 0;
#pragma unroll
      for (int j = 0; j < 4; ++j) { int qv = (int)rintf(v[4 * i4_ + j] * inv); qv = qv > 127 ? 127 : (qv < -127 ? -127 : qv); w |= ((unsigned)qv & 255u) << (8 * j); }
      *(unsigned*)(wq8 + (size_t)n * DM + lane * EPL + 4 * i4_) = w;
    }
    if (lane == 0) sq8[n] = sc;
  }
}
DI void phase_C(const Params& p, char* smem) {
  const hf* n1h = (const hf*)(p.ws + O_R); const hf* WinT = (const hf*)(p.ws + O_WIN);
  const hf* n1q = (const hf*)(TN_I8 > 0 ? p.dscan + Q_N1 : p.ws + O_R); const hf* W8 = (const hf*)(p.ws + O_W8);
  const float* sa = (const float*)(TN_I8 > 0 ? p.dscan + Q_SA : p.ws + O_R + (size_t)NTOK * DM); const float* sb = (const float*)(p.ws + O_SB8);
  hf* P1 = (hf*)(p.ws + O_P1); hf* P2 = (hf*)(p.ws + O_P2); hf* P3 = (hf*)(p.ws + O_P3); hf* P4 = (hf*)(p.ws + O_P4);
  float* aux = (float*)(p.ws + O_AUX); const float* cs = (const float*)(p.ws + O_CS);
  constexpr int CBM = 256, CMT = CBM / 32, NTN = NP / 128, NTM = NTOK / CBM;
  TileSched ts = tile_begin(NTM, NTN, p.ws + O_BAR, xcd_words(smem)); int tm, tn;
  while (tile_next(ts, tm, tn)) {
    const int m0 = tm * CBM, n0 = tn * 128;
    f4 acc[CMT][4];
    for (int rep_ = 0; rep_ < REP_CMAIN; ++rep_) { zero_acc<CMT>(acc);
    if (TN_I8 == 0 || tn >= TN_I8) gemm_mainloop_2set<CBM, true>(acc, n1q, W8, DM / 2, m0, n0, smem);
    else gemm_mainloop<CBM, 32, true, false>(acc, n1h, DM, WinT, DM, DM, m0, n0, smem); }
    const int tid_e = get_tid();
    const int lane = tid_e & 63, wave = tid_e >> 6, wm = wave >> 1, wn = wave & 1, q = lane >> 4, cl = lane & 15;
    const bool rope = (tn <= 4) || (tn >= 6 && tn <= 14);
    hf* tileS = (hf*)smem;
    for (int repe_ = 0; repe_ < REP_CEPI; ++repe_) {
    __syncthreads();
#pragma unroll
    for (int mt = 0; mt < CMT; ++mt) {
#pragma unroll
      for (int nt = 0; nt < 4; ++nt) {
        const int lrow = wm * (CBM / 2) + mt * 16 + q * 4, lcol = wn * 64 + nt * 16 + cl;
        const int rbase = m0 + lrow;
        f4 v = acc[mt][nt];
        if (TN_I8 == 0 || tn >= TN_I8) { const i4 ai = __builtin_bit_cast(i4, acc[mt][nt]); const float sbn = sb[n0 + lcol] * ((tn < 4) ? 0.125f : 1.0f); const f4 sa4 = *(const f4*)(sa + rbase);
#pragma unroll
          for (int r = 0; r < 4; ++r) v[r] = (float)ai[r] * (sa4[r] * sbn); }
        if (rope && nt == 0 && !(tn == 14 && wn == 1)) {
#pragma unroll
          for (int r = 0; r < 4; ++r) {
            float pv = __shfl_xor(v[r], 8);
            const float* c2 = cs + (size_t)(rbase + r) * 16; float co = c2[cl & 7], si = c2[8 + (cl & 7)];
            v[r] = (cl < 8) ? (v[r] * co - pv * si) : (v[r] * co + pv * si);
          }
        }
        if (tn == 14 && wn == 1) {
          const int lc = nt * 16 + cl;
          if (lc < 32) {
            const int hh = lc & 7;
#pragma unroll
            for (int r = 0; r < 4; ++r) {
              float o;
              if (lc < 16) o = v[r] * (0.25f * 0.125f);
              else if (lc < 24) o = sigmoidf_(v[r]);
              else o = -__expf(p.a_log[hh]) * softplusf_(v[r] + p.dt_bias[hh]);
              aux[(size_t)(rbase + r) * 32 + lc] = o;
            }
          }
        } else {
          if (tn >= 31) {
#pragma unroll
            for (int r = 0; r < 4; ++r) v[r] = sigmoidf_(v[r]);
          }
#pragma unroll
          for (int r = 0; r < 4; ++r) tileS[(lrow + r) * TLD + lcol] = (hf)v[r];
        }
      }
    }
    __syncthreads();
    {
      hf* dst; int ld, nch = 16;
      if (tn < 15) { dst = P1 + n0; ld = LP1; if (tn == 14) nch = 8; }
      else if (tn < 27) { dst = P2 + (n0 - C_QB); ld = LP2; }
      else if (tn < 31) { dst = P3 + (n0 - C_ZB); ld = LP3; }
      else { dst = P4 + (n0 - C_GA); ld = LP4; }
      const int tid = get_tid();
#pragma unroll
      for (int i = 0; i < CBM / 16; ++i) {
        const int idx = tid + i * 256, row = idx >> 4, ch = idx & 15;
#ifdef EMU
        if (ch < nch) *(h8*)(dst + (size_t)(m0 + row) * ld + ch * 8) = *(const h8*)(tileS + row * TLD + ch * 8);
#else
        if (ch < nch) __builtin_nontemporal_store(*(const h8*)(tileS + row * TLD + ch * 8), (h8*)(dst + (size_t)(m0 + row) * ld + ch * 8));
#endif
      }
    }
    }
  }
}

DI void phase_D1(const Params& p, char* smem) {
  const hf* P2 = (const hf*)(p.ws + O_P2); const float* aux = (const float*)(p.ws + O_AUX);
  hf* Qs = (hf*)smem;
  hf* Ks = Qs + 64 * 72;
  float* RHS = (float*)(Ks + 64 * 72);
  float* Lm = RHS + 64 * 128;
  float* gcs = Lm + 64 * 64;
  float* bts = gcs + 64;
  const int tid = get_tid(), lane = tid & 63, wave = tid >> 6, q = lane >> 4, cl = lane & 15;
  constexpr size_t MSZ = (size_t)NTOK * 512;
  hf* uT = (hf*)p.dscan; hf* wm_ = uT + MSZ; hf* qg = wm_ + MSZ; hf* kdT = qg + MSZ; hf* intra = (hf*)(p.ws + O_INTRA);
  float* eg = (float*)(p.ws + O_EG);
  for (int it = blockIdx.x; it < BATCH * 8 * NCHK; it += gridDim.x) {
    const int c = it % NCHK, h = (it / NCHK) % 8, b = it / (NCHK * 8);
    const size_t cbase = (size_t)it * 4096;
    const int tk = tid >> 2, qq = tid & 3, t0 = c * 64;
    const size_t grow = (size_t)b * SEQ + t0 + tk;
    __syncthreads();
    float g = aux[grow * 32 + 24 + h], beta = aux[grow * 32 + 16 + h];
    if (qq == 0) { gcs[tk] = g; bts[tk] = beta; }
    float val[3][16];
#pragma unroll
    for (int m = 0; m < 3; ++m) {
      const int ch0 = m * 512 + h * 64 + qq * 16;
#pragma unroll
      for (int e = 0; e < 16; ++e) val[m][e] = 0.f;
#pragma unroll
      for (int i = 0; i < 4; ++i) {
        const int tt = t0 + tk - 3 + i;
        if (tt >= 0) {
          const hf* src = P2 + ((size_t)b * SEQ + tt) * LP2 + ch0;
          h8 x0 = *(const h8*)src, x1 = *(const h8*)(src + 8);
          const float* wv = p.conv_w + (size_t)i * 1536 + ch0;
#pragma unroll
          for (int e = 0; e < 8; ++e) { val[m][e] += (float)x0[e] * wv[e]; val[m][8 + e] += (float)x1[e] * wv[8 + e]; }
        }
      }
#pragma unroll
      for (int e = 0; e < 16; ++e) val[m][e] = siluf_(val[m][e]);
    }
    float sq = 0.f, sk = 0.f;
#pragma unroll
    for (int e = 0; e < 16; ++e) { sq += val[0][e] * val[0][e]; sk += val[1][e] * val[1][e]; }
    sq += __shfl_xor(sq, 1); sq += __shfl_xor(sq, 2); sk += __shfl_xor(sk, 1); sk += __shfl_xor(sk, 2);
    const float nq = rsqrtf(sq + EPSN) * 0.125f, nk = rsqrtf(sk + EPSN);
    __syncthreads();
    if (wave == 0) { float v = gcs[lane];
#pragma unroll
      for (int d = 1; d < 64; d <<= 1) { const float y = __shfl(v, lane - d); if (lane >= d) v += y; }
      gcs[lane] = v; }
    __syncthreads();
    const float gc = gcs[tk], glast = gcs[63];
    const float egc = __expf(gc), ekd = __expf(glast - gc);
    if (tid == 0) eg[it] = __expf(glast);
#pragma unroll
    for (int e = 0; e < 16; ++e) {
      const int ch = qq * 16 + e;
      const float qv = val[0][e] * nq, kv = val[1][e] * nk, vv = val[2][e];
      Qs[tk * 72 + ch] = (hf)qv; Ks[tk * 72 + ch] = (hf)kv;
      RHS[tk * 128 + ch] = vv * beta; RHS[tk * 128 + 64 + ch] = kv * beta * egc;
      qg[cbase + tk * 64 + ch] = (hf)(qv * egc);
      kdT[cbase + ch * 64 + tk] = (hf)(kv * ekd);
    }
    __syncthreads();
    {
      f4 akk[4], aqk[4];
#pragma unroll
      for (int nt = 0; nt < 4; ++nt) { akk[nt] = f4{0, 0, 0, 0}; aqk[nt] = f4{0, 0, 0, 0}; }
#pragma unroll
      for (int ks = 0; ks < 2; ++ks) {
        h8 ak = *(const h8*)(Ks + (wave * 16 + cl) * 72 + ks * 32 + q * 8);
        h8 aq = *(const h8*)(Qs + (wave * 16 + cl) * 72 + ks * 32 + q * 8);
#pragma unroll
        for (int nt = 0; nt < 4; ++nt) {
          h8 bk = *(const h8*)(Ks + (nt * 16 + cl) * 72 + ks * 32 + q * 8);
          akk[nt] = mfma16(ak, bk, akk[nt]); aqk[nt] = mfma16(aq, bk, aqk[nt]);
        }
      }
#pragma unroll
      for (int nt = 0; nt < 4; ++nt) {
        const int j = nt * 16 + cl; const float gj = gcs[j];
#pragma unroll
        for (int r = 0; r < 4; ++r) {
          const int i = wave * 16 + q * 4 + r;
          const float dec = (i >= j) ? __expf(gcs[i] - gj) : 0.f;
          Lm[i * 64 + j] = (i > j) ? bts[i] * akk[nt][r] * dec : 0.f;
          intra[cbase + i * 64 + j] = (hf)(aqk[nt][r] * dec);
        }
      }
    }
    __syncthreads();
    if (wave < 2) {
      float xr[64];
#pragma unroll
      for (int i = 0; i < 64; ++i) xr[i] = 0.f;
#pragma unroll
      for (int i = 0; i < 64; ++i) {
        float s0 = 0.f, s1 = 0.f, s2 = 0.f, s3 = 0.f;
#pragma unroll
        for (int j4 = 0; j4 < (i + 3) / 4; ++j4) {
          f4 l4 = *(const f4*)(Lm + i * 64 + j4 * 4);
          s0 += l4[0] * xr[j4 * 4]; s1 += l4[1] * xr[j4 * 4 + 1]; s2 += l4[2] * xr[j4 * 4 + 2]; s3 += l4[3] * xr[j4 * 4 + 3];
        }
        xr[i] = RHS[i * 128 + wave * 64 + lane] - ((s0 + s1) + (s2 + s3));
      }
      if (wave == 0) {
#pragma unroll
        for (int i8 = 0; i8 < 8; ++i8) { h8 o;
#pragma unroll
          for (int e = 0; e < 8; ++e) o[e] = (hf)xr[i8 * 8 + e];
          *(h8*)(uT + cbase + lane * 64 + i8 * 8) = o; }
      } else {
#pragma unroll
        for (int i = 0; i < 64; ++i) wm_[cbase + i * 64 + lane] = (hf)xr[i];
      }
    }
  }
}

constexpr int E1_MAT = 64 * 72;
constexpr int LDS_E1 = 2 * 4 * E1_MAT * 2;
DI void phase_E1(const Params& p, char* smem) {
  const int tid = get_tid(), lane = tid & 63, wave = tid >> 6, q = lane >> 4, cl = lane & 15;
  constexpr size_t MSZ = (size_t)NTOK * 512;
  const hf* uT = (const hf*)p.dscan; const hf* intra = (const hf*)(p.ws + O_INTRA);
  const hf* mats[4] = {uT + MSZ, uT + 2 * MSZ, intra, uT + 3 * MSZ};
  const float* eg = (const float*)(p.ws + O_EG);
  hf* ob = (hf*)(p.ws + O_OB);
  hf* lbuf = (hf*)smem;
  for (int bh = blockIdx.x; bh < BATCH * 8; bh += gridDim.x) {
    const int b = bh / 8, h = bh % 8, e0 = wave * 16;
    f4 S[4];
#pragma unroll
    for (int i = 0; i < 4; ++i) S[i] = f4{0, 0, 0, 0};
    h8 st[8]; h4 un[4];
    {
      const size_t cbase = (size_t)bh * NCHK * 4096;
#pragma unroll
      for (int i = 0; i < 8; ++i) { const int idx = tid + i * 256, m = idx >> 9, r = (idx >> 3) & 63, c8 = idx & 7; st[i] = *(const h8*)(mats[m] + cbase + r * 64 + c8 * 8); }
#pragma unroll
      for (int mt = 0; mt < 4; ++mt) un[mt] = *(const h4*)(uT + cbase + (e0 + cl) * 64 + mt * 16 + q * 4);
      __syncthreads();
#pragma unroll
      for (int i = 0; i < 8; ++i) { const int idx = tid + i * 256, m = idx >> 9, r = (idx >> 3) & 63, c8 = idx & 7; *(h8*)(lbuf + m * E1_MAT + r * 72 + c8 * 8) = st[i]; }
      __syncthreads();
    }
    for (int c = 0; c < NCHK; ++c) {
      const hf* L = lbuf + (c & 1) * 4 * E1_MAT;
      const hf* Lw = L, *Lq = L + E1_MAT, *Li = L + 2 * E1_MAT, *Lk = L + 3 * E1_MAT;
      h4 uc[4];
#pragma unroll
      for (int mt = 0; mt < 4; ++mt) uc[mt] = un[mt];
      if (c + 1 < NCHK) {
        const size_t cb2 = ((size_t)bh * NCHK + c + 1) * 4096;
#pragma unroll
        for (int i = 0; i < 8; ++i) { const int idx = tid + i * 256, m = idx >> 9, r = (idx >> 3) & 63, c8 = idx & 7; st[i] = *(const h8*)(mats[m] + cb2 + r * 64 + c8 * 8); }
#pragma unroll
        for (int mt = 0; mt < 4; ++mt) un[mt] = *(const h4*)(uT + cb2 + (e0 + cl) * 64 + mt * 16 + q * 4);
      }
      const float egl = eg[bh * NCHK + c];
      h8 Sb[2]; Sb[0] = cvt_f4f4(S[0], S[1]); Sb[1] = cvt_f4f4(S[2], S[3]);
      f4 vn[4];
#pragma unroll
      for (int mt = 0; mt < 4; ++mt) {
        f4 a = f4{0, 0, 0, 0};
#pragma unroll
        for (int ks = 0; ks < 2; ++ks) a = mfma16(permload(Lw + (mt * 16 + cl) * 72 + ks * 32, q), Sb[ks], a);
#pragma unroll
        for (int r = 0; r < 4; ++r) vn[mt][r] = (float)uc[mt][r] - a[r];
      }
      h8 Vb[2]; Vb[0] = cvt_f4f4(vn[0], vn[1]); Vb[1] = cvt_f4f4(vn[2], vn[3]);
#pragma unroll
      for (int mt = 0; mt < 4; ++mt) {
        f4 o = f4{0, 0, 0, 0};
#pragma unroll
        for (int ks = 0; ks < 2; ++ks) {
          o = mfma16(permload(Lq + (mt * 16 + cl) * 72 + ks * 32, q), Sb[ks], o);
          o = mfma16(permload(Li + (mt * 16 + cl) * 72 + ks * 32, q), Vb[ks], o);
        }
#pragma unroll
        for (int r = 0; r < 4; ++r) ob[((size_t)b * SEQ + c * 64 + mt * 16 + q * 4 + r) * 512 + h * 64 + e0 + cl] = (hf)o[r];
      }
#pragma unroll
      for (int mt = 0; mt < 4; ++mt) {
        f4 sacc = S[mt] * egl;
#pragma unroll
        for (int ks = 0; ks < 2; ++ks) sacc = mfma16(permload(Lk + (mt * 16 + cl) * 72 + ks * 32, q), Vb[ks], sacc);
        S[mt] = sacc;
      }
      if (c + 1 < NCHK) {
        hf* Ln = lbuf + ((c + 1) & 1) * 4 * E1_MAT;
#pragma unroll
        for (int i = 0; i < 8; ++i) { const int idx = tid + i * 256, m = idx >> 9, r = (idx >> 3) & 63, c8 = idx & 7; *(h8*)(Ln + m * E1_MAT + r * 72 + c8 * 8) = st[i]; }
      }
      __syncthreads();
    }
    drain_stores();
    __syncthreads();
    if (tid == 0) { fence_release_agent(); add_relaxed_agent((unsigned*)(p.ws + O_CNT) + 48, 1u); }
  }
}

DI void obnorm_pass(const Params& p) {
  hf* ob = (hf*)(p.ws + O_OB); const hf* P3 = (const hf*)(p.ws + O_P3);
  const int lane = get_tid() & 63, wave = get_tid() >> 6;
  for (int row = blockIdx.x * 4 + wave; row < NTOK; row += gridDim.x * 4) {
    h8 v = *(const h8*)(ob + (size_t)row * 512 + lane * 8);
    h8 z = *(const h8*)(P3 + (size_t)row * 512 + lane * 8);
    float f[8], ss = 0.f;
#pragma unroll
    for (int e = 0; e < 8; ++e) { f[e] = (float)v[e]; ss += f[e] * f[e]; }
    ss += __shfl_xor(ss, 1); ss += __shfl_xor(ss, 2); ss += __shfl_xor(ss, 4);
    const float rstd = rsqrtf(ss * (1.0f / 64.0f) + EPSN);
    h8 o;
#pragma unroll
    for (int e = 0; e < 8; ++e) o[e] = (hf)(f[e] * rstd * p.norm_b_w[(lane & 7) * 8 + e] * siluf_((float)z[e]));
    *(h8*)(ob + (size_t)row * 512 + lane * 8) = o;
  }
}

constexpr int SELN = TOPK + 64;
constexpr int CAPC = 128;
constexpr int E2_WAVE_LDS = SELN * 4 + SELN * 8 * 4 + 256 * 4 + CAPC * 8;
DI int bin_of(float v, float vmin, float sc) { int bq = (int)((v - vmin) * sc); return bq > 255 ? 255 : (bq < 0 ? 0 : bq); }
DI void attn_token(const Params& p, int b, int t, float* srow, int* sel, float* Sb, hf* Vt1, int lane, bool dry) {
  unsigned* hist = (unsigned*)(Sb + SELN * 8); unsigned* candk = hist + 256; int* candi = (int*)(candk + CAPC);
  hf* P1 = (hf*)(p.ws + O_P1);
#ifndef EMU
  asm volatile("" : "+v"(lane));
#endif
  const int q = lane >> 4, cl = lane & 15;
  const int n = t + 1;
  int cnt;
  for (int rep_ = 0; rep_ < REP_SEL; ++rep_) {
  if (n <= TOPK) {
    cnt = n;
    for (int i = lane; i < SELN; i += 64) sel[i] = (i < n) ? i : 0;
  } else {
    cnt = TOPK;
    float val[SEQ / 64];
    {
      const hf* pb = (const hf*)srow + lane;
#pragma unroll
      for (int jg = 0; jg < SEQ / 64 / 8; ++jg) {
#ifndef EMU
        asm volatile("" : "+v"(pb));
#endif
#pragma unroll
        for (int jj = 0; jj < 8; ++jj) { const int j = jg * 8 + jj; const float v = (float)pb[jj * 64]; val[j] = (j * 64 + lane < n) ? v : -INFINITY; }
        pb += 512;
      }
    }
    float vmin = INFINITY, vmax = -INFINITY;
#pragma unroll
    for (int j = 0; j < SEQ / 64; ++j) { vmax = fmaxf(vmax, val[j]); vmin = fminf(vmin, (j * 64 + lane < n) ? val[j] : INFINITY); }
#pragma unroll
    for (int m = 32; m >= 1; m >>= 1) { vmax = fmaxf(vmax, __shfl_xor(vmax, m)); vmin = fminf(vmin, __shfl_xor(vmin, m)); }
    const float bscale = 255.99f / (vmax - vmin);
    for (int i = lane; i < 256; i += 64) hist[i] = 0u;
    wave_sync();
#pragma unroll
    for (int j = 0; j < SEQ / 64; ++j) { if (j * 64 + lane < n) atomicAdd(&hist[bin_of(val[j], vmin, bscale)], 1u); }
    wave_sync();
    int tb, ca, nc;
    {
      const unsigned h0 = hist[4 * lane], h1 = hist[4 * lane + 1], h2 = hist[4 * lane + 2], h3 = hist[4 * lane + 3];
      const int sL = (int)(h0 + h1 + h2 + h3);
      int tt = sL;
#pragma unroll
      for (int d = 1; d < 64; d <<= 1) { const int y = __shfl(tt, lane + d); if (lane + d < 64) tt += y; }
      const int above = tt - sL;
      const int c3 = above + (int)h3, c2 = c3 + (int)h2, c1 = c2 + (int)h1, c0 = c1 + (int)h0;
      int tb_ = -1, ca_ = 0, nc_ = 0;
      if (above < TOPK && c0 >= TOPK) {
        if (c3 >= TOPK) { tb_ = 4 * lane + 3; ca_ = above; nc_ = (int)h3; }
        else if (c2 >= TOPK) { tb_ = 4 * lane + 2; ca_ = c3; nc_ = (int)h2; }
        else if (c1 >= TOPK) { tb_ = 4 * lane + 1; ca_ = c2; nc_ = (int)h1; }
        else { tb_ = 4 * lane; ca_ = c1; nc_ = (int)h0; }
      }
      const unsigned long long bm = __ballot(tb_ >= 0);
      const int src = bm ? (int)__builtin_ctzll(bm) : 0;
      tb = __shfl(tb_, src); ca = __shfl(ca_, src); nc = __shfl(nc_, src);
      if (bm == 0ull) nc = CAPC + 1;
    }
    const unsigned long long lt = (lane == 0) ? 0ull : (~0ull >> (64 - lane));
    if (nc <= CAPC) {
      int base_gt = 0, base_c = 0;
#pragma unroll
      for (int j = 0; j < SEQ / 64; ++j) {
        const bool valid = j * 64 + lane < n;
        const int bn = valid ? bin_of(val[j], vmin, bscale) : -1;
        const bool mg = bn > tb, me = bn == tb;
        const unsigned long long bg = __ballot(mg), be = __ballot(me);
        if (mg) sel[base_gt + __popcll(bg & lt)] = j * 64 + lane;
        if (me) { const int pos = base_c + __popcll(be & lt); candk[pos] = f2ord(val[j]); candi[pos] = j * 64 + lane; }
        base_gt += __popcll(bg); base_c += __popcll(be);
      }
      wave_sync();
      const int need = TOPK - ca;
      int base = ca;
#pragma unroll
      for (int hb = 0; hb < CAPC / 64; ++hb) {
        const int my = hb * 64 + lane;
        bool pick = false; int myi = 0;
        if (my < nc) {
          const unsigned mk = candk[my]; myi = candi[my];
          int rank = 0;
          for (int c2 = 0; c2 < nc; ++c2) { const unsigned ok = candk[c2]; const int oi = candi[c2]; rank += (ok > mk || (ok == mk && oi < myi)) ? 1 : 0; }
          pick = rank < need;
        }
        const unsigned long long bp = __ballot(pick);
        if (pick) sel[base + __popcll(bp & lt)] = myi;
        base += __popcll(bp);
      }
    } else {
      unsigned T = 0;
      for (int bit = 31; bit >= 0; --bit) {
        const unsigned cand = T | (1u << bit);
        int cl_ = 0;
#pragma unroll
        for (int j = 0; j < SEQ / 64; ++j) cl_ += (f2ord(val[j]) >= cand) ? 1 : 0;
        const int tot = wave_sum_i(cl_);
        if (tot >= TOPK) T = cand;
        if (tot == TOPK) { T = cand - 1u; break; }
      }
      int cgt = 0;
#pragma unroll
      for (int j = 0; j < SEQ / 64; ++j) cgt += (f2ord(val[j]) > T) ? 1 : 0;
      cgt = wave_sum_i(cgt);
      int base_gt = 0, base_eq = cgt;
#pragma unroll
      for (int j = 0; j < SEQ / 64; ++j) {
        const unsigned kj = f2ord(val[j]);
        const bool mg = kj > T, me = kj == T;
        const unsigned long long bg = __ballot(mg), be = __ballot(me);
        if (mg) sel[base_gt + __popcll(bg & lt)] = j * 64 + lane;
        if (me) { int pos = base_eq + __popcll(be & lt); if (pos < TOPK) sel[pos] = j * 64 + lane; }
        base_gt += __popcll(bg); base_eq += __popcll(be);
      }
    }
    sel[TOPK + lane] = 0;
  }
  wave_sync();
  }
  const int ng = (cnt + 63) / 64;
  const size_t trow = (size_t)b * SEQ + t;
  const hf* kvb = P1 + (size_t)b * SEQ * LP1;
  const int k8 = lane >> 3, dch = lane & 7;
  h8 vc[8], vn[8];
#pragma unroll
  for (int j = 0; j < 4; ++j) { const hf* vr = kvb + (size_t)sel[j * 8 + k8] * LP1 + C_VA + dch * 8; vc[j] = *(const h8*)vr; vc[4 + j] = *(const h8*)(vr + 64); }
  hf* P16 = (hf*)Sb;
  hf* Vt = (hf*)Sb + 8 * SELN;
  {
    constexpr int NG = TOPK / 64;
    const h8 z8 = h8{0, 0, 0, 0, 0, 0, 0, 0};
    h8 qb[4];
#pragma unroll
    for (int s = 0; s < 4; ++s) {
      const h8 v = *(const h8*)(P1 + trow * LP1 + C_QA + (cl & 7) * 64 + 32 * (s & 1) + 8 * q);
      qb[s] = (cl < 8 && (cl >> 2) == (s >> 1)) ? v : z8;
    }
    f4 S[NG * 4];
    h8 kc[4][4], kn[4][4];
#pragma unroll
    for (int u = 0; u < 4; ++u) { const hf* kr = kvb + (size_t)sel[u * 16 + cl] * LP1 + C_KA + 8 * q;
#pragma unroll
      for (int s = 0; s < 4; ++s) kc[u][s] = *(const h8*)(kr + 32 * s); }
#pragma unroll
    for (int gg = 0; gg < NG; ++gg) {
      if (gg < ng) {
        if (gg + 1 < NG) {
          const int g2 = (gg + 1 < ng) ? gg + 1 : gg;
#pragma unroll
          for (int u = 0; u < 4; ++u) { const hf* kr = kvb + (size_t)sel[g2 * 64 + u * 16 + cl] * LP1 + C_KA + 8 * q;
#pragma unroll
            for (int s = 0; s < 4; ++s) kn[u][s] = *(const h8*)(kr + 32 * s); }
        }
#pragma unroll
        for (int u = 0; u < 4; ++u) {
          f4 acc = f4{0, 0, 0, 0};
#pragma unroll
          for (int s = 0; s < 4; ++s) acc = mfma16(kc[u][s], qb[s], acc);
#pragma unroll
          for (int r = 0; r < 4; ++r) if (gg * 64 + u * 16 + 4 * q + r >= cnt) acc[r] = -INFINITY;
          S[gg * 4 + u] = acc;
        }
        if (gg + 1 < NG) {
#pragma unroll
          for (int u = 0; u < 4; ++u)
#pragma unroll
            for (int s = 0; s < 4; ++s) kc[u][s] = kn[u][s];
        }
      } else {
#pragma unroll
        for (int u = 0; u < 4; ++u) S[gg * 4 + u] = f4{-INFINITY, -INFINITY, -INFINITY, -INFINITY};
      }
    }
    float mx = -INFINITY;
#pragma unroll
    for (int j = 0; j < NG * 4; ++j)
#pragma unroll
      for (int r = 0; r < 4; ++r) mx = fmaxf(mx, S[j][r]);
    mx = fmaxf(mx, __shfl_xor(mx, 16)); mx = fmaxf(mx, __shfl_xor(mx, 32));
    float sm = 0.f;
#pragma unroll
    for (int j = 0; j < NG * 4; ++j)
#pragma unroll
      for (int r = 0; r < 4; ++r) { const float e = __expf(S[j][r] - mx); S[j][r] = e; sm += e; }
    sm += __shfl_xor(sm, 16); sm += __shfl_xor(sm, 32);
    const float inv = 1.0f / sm;
    if (cl < 8) {
#pragma unroll
      for (int j = 0; j < NG * 4; ++j) if (j < ng * 4) {
        h4 pv; pv[0] = (hf)(S[j][0] * inv); pv[1] = (hf)(S[j][1] * inv); pv[2] = (hf)(S[j][2] * inv); pv[3] = (hf)(S[j][3] * inv);
        *(h4*)(P16 + cl * SELN + j * 16 + 4 * q) = pv;
      }
    }
  }
  wave_sync();
  {
    f4 O[2][4];
#pragma unroll
    for (int g = 0; g < 2; ++g)
#pragma unroll
      for (int nt = 0; nt < 4; ++nt) O[g][nt] = f4{0, 0, 0, 0};
    const int nst = ng * 2;
    for (int st = 0; st < nst; ++st) {
      {
        const int st2 = (st + 1 < nst) ? st + 1 : st;
#pragma unroll
        for (int j = 0; j < 4; ++j) { const hf* vr = kvb + (size_t)sel[st2 * 32 + j * 8 + k8] * LP1 + C_VA + dch * 8; vn[j] = *(const h8*)vr; vn[4 + j] = *(const h8*)(vr + 64); }
      }
      wave_sync();
#pragma unroll
      for (int j = 0; j < 4; ++j) { *(h8*)(Vt + (j * 8 + k8) * 72 + dch * 8) = vc[j]; *(h8*)(Vt1 + (j * 8 + k8) * 72 + dch * 8) = vc[4 + j]; }
      wave_sync();
#pragma unroll
      for (int g = 0; g < 2; ++g) {
        h8 pa;
        if (cl < 4) pa = *(const h8*)(P16 + (g * 4 + cl) * SELN + st * 32 + q * 8); else pa = h8{0, 0, 0, 0, 0, 0, 0, 0};
        const hf* vt = g ? Vt1 : Vt;
#pragma unroll
        for (int nt = 0; nt < 4; ++nt) {
          const hf* tp = vt + (q * 8 + (cl >> 2)) * 72 + nt * 16 + (cl & 3) * 4;
          const h4 lo = lds_read_tr16(tp), hi = lds_read_tr16(tp + 4 * 72);
          O[g][nt] = mfma16(pa, cat44(lo, hi), O[g][nt]);
        }
      }
#pragma unroll
      for (int j = 0; j < 8; ++j) vc[j] = vn[j];
    }
    if (q == 0) {
#pragma unroll
      for (int g = 0; g < 2; ++g)
#pragma unroll
        for (int nt = 0; nt < 4; ++nt)
#pragma unroll
          for (int r = 0; r < 4; ++r) {
            hf* dst = dry ? ((hf*)srow + (g * 4 + r) * 64 + nt * 16 + cl) : (P1 + trow * LP1 + C_QA + (g * 4 + r) * 64 + nt * 16 + cl);
            *dst = (hf)O[g][nt][r];
          }
    }
  }
  wave_sync();
}

DI void phase_E2(const Params& p, char* smem, bool dry) {
  const hf* P1 = (const hf*)(p.ws + O_P1); const float* aux = (const float*)(p.ws + O_AUX);
  int* cnt = (int*)(p.ws + O_CNT) + (dry ? 1 : 0);
  const int tid = get_tid(), lane = tid & 63, wave = tid >> 6;
  float* scr = (float*)(p.ws + O_SCR) + (size_t)blockIdx.x * QBT * SEQ;
  int* item_s = (int*)smem;
  char* wl = smem + 16 + wave * E2_WAVE_LDS;
  int* sel = (int*)wl; float* Sb = (float*)(wl + SELN * 4);
  constexpr int NQB = SEQ / QBT;
#ifdef EMU
  const int xq = (int)blockIdx.x % BATCH;
#else
  const int xq = (int)(xcd_words(smem)[2] % (unsigned)BATCH);
#endif
  int dq = 0;
  for (;;) {
    __syncthreads();
    const int bq = (xq + dq) % BATCH;
    if (tid == 0) item_s[0] = atomicAdd(cnt + 2 * bq, 1);
    __syncthreads();
    const int item = item_s[0];
    if (item >= NQB) { if (++dq >= BATCH) break; continue; }
    const int b = bq, qb = NQB - 1 - item;
    int lane_i = lane;
#ifndef EMU
    asm volatile("" : "+v"(lane_i));
#endif
    const int q = lane_i >> 4, cl = lane_i & 15;
    const int tw0 = qb * QBT + wave * 4;
    h8 aq[4][2]; h8 wA01, wA23;
    {
      f4 wv[4];
#pragma unroll
      for (int i = 0; i < 4; ++i) {
        const size_t row = (size_t)b * SEQ + tw0 + i;
        const hf* qp = P1 + row * LP1 + C_QI + cl * 64 + q * 8;
        aq[i][0] = *(const h8*)qp; aq[i][1] = *(const h8*)(qp + 32);
        wv[i] = *(const f4*)(aux + row * 32 + q * 4);
      }
      const f4 z4 = f4{0, 0, 0, 0};
      wA01 = cvt_f4f4(cl == 0 ? wv[0] : z4, cl == 4 ? wv[1] : z4);
      wA23 = cvt_f4f4(cl == 8 ? wv[2] : z4, cl == 12 ? wv[3] : z4);
    }
    const int ngrp = (tw0 + 3) / 64 + 1;
    const int ngrp_blk = (qb * QBT + QBT - 1) / 64 + 1;
    hf* kst = (hf*)(smem + 16 + 4 * E2_WAVE_LDS);
    const int tid_s = get_tid();
    const int skey = tid_s >> 3, sch = tid_s & 7;
    const hf* ksrc = P1 + ((size_t)b * SEQ + skey) * LP1 + C_KI + sch * 8;
    hf* scr_q = (hf*)(scr + (size_t)(wave * 4 + q) * SEQ) + cl;
    h8 sr0 = *(const h8*)ksrc, sr1 = *(const h8*)(ksrc + (size_t)32 * LP1);
    *(h8*)(kst + skey * 72 + sch * 8) = sr0; *(h8*)(kst + (skey + 32) * 72 + sch * 8) = sr1;
    { const int g1 = ngrp_blk > 1 ? 1 : 0; sr0 = *(const h8*)(ksrc + (size_t)(g1 * 64) * LP1); sr1 = *(const h8*)(ksrc + (size_t)(g1 * 64 + 32) * LP1); }
    h8 sq0, sq1;
    { const int g2 = ngrp_blk > 2 ? 2 : ngrp_blk - 1; sq0 = *(const h8*)(ksrc + (size_t)(g2 * 64) * LP1); sq1 = *(const h8*)(ksrc + (size_t)(g2 * 64 + 32) * LP1); }
    __syncthreads();
#define IDX_COMPUTE(STG, G) if ((G) < ngrp) { const hf* ks = kst + (STG) * (64 * 72); \
        _Pragma("unroll") for (int u = 0; u < 4; ++u) { \
          const h8 b0 = *(const h8*)(ks + (u * 16 + cl) * 72 + q * 8), b1 = *(const h8*)(ks + (u * 16 + cl) * 72 + 32 + q * 8); \
          f4 c4[4]; \
          _Pragma("unroll") for (int i = 0; i < 4; ++i) { f4 t4 = f4{0, 0, 0, 0}; t4 = mfma16(aq[i][0], b0, t4); t4 = mfma16(aq[i][1], b1, t4); c4[i] = t4; } \
          f4 sc = f4{0, 0, 0, 0}; sc = mfma16(wA01, relu8(cvt_f4f4(c4[0], c4[1])), sc); sc = mfma16(wA23, relu8(cvt_f4f4(c4[2], c4[3])), sc); \
          scr_q[(G) * 64 + u * 16] = (hf)sc[0]; } }
#define IDX_STAGE(R0, R1, STG, GNEXT) { hf* kn = kst + (STG) * (64 * 72); \
        *(h8*)(kn + skey * 72 + sch * 8) = R0; *(h8*)(kn + (skey + 32) * 72 + sch * 8) = R1; \
        const int gn_ = ((GNEXT) < ngrp_blk) ? (GNEXT) : ngrp_blk - 1; \
        R0 = *(const h8*)(ksrc + (size_t)(gn_ * 64) * LP1); R1 = *(const h8*)(ksrc + (size_t)(gn_ * 64 + 32) * LP1); }
    for (int grp = 0; grp < ngrp_blk; grp += 2) {
      IDX_COMPUTE(0, grp)
      if (grp + 1 < ngrp_blk) IDX_STAGE(sr0, sr1, 1, grp + 3)
      __syncthreads();
      if (grp + 1 >= ngrp_blk) break;
      IDX_COMPUTE(1, grp + 1)
      if (grp + 2 < ngrp_blk) IDX_STAGE(sq0, sq1, 0, grp + 4)
      __syncthreads();
    }
#undef IDX_COMPUTE
#undef IDX_STAGE
    gmem_wave_sync();
#pragma unroll 1
    for (int i = 0; i < 4; ++i) attn_token(p, b, tw0 + i, scr + (size_t)(wave * 4 + i) * SEQ, sel, Sb, kst + wave * (32 * 72), lane, dry);
  }
  if (!dry) {
    unsigned* e1done = (unsigned*)(p.ws + O_CNT) + 48;
    if (get_tid() == 0) {
      unsigned spins = 0;
      while (ld_relaxed_agent(e1done) < (unsigned)(BATCH * 8)) { spin_pause(); if (++spins > (1u << 26)) break; }
      fence_acquire_agent();
    }
    __syncthreads();
    obnorm_pass(p);
  }
}

DI void phase_F1(const Params& p, char* smem) {
  const hf* P1 = (const hf*)(p.ws + O_P1); const hf* ob = (const hf*)(p.ws + O_OB); const hf* P4 = (const hf*)(p.ws + O_P4);
  const hf* WpaT = (const hf*)(p.ws + O_WPA); const hf* WpbT = (const hf*)(p.ws + O_WPB);
  hf* merged = (hf*)(p.ws + O_MERGED);
  const int lane = get_tid() & 63, wave = get_tid() >> 6, wm = wave >> 1, wn = wave & 1, q = lane >> 4, cl = lane & 15;
  constexpr int NTN = DM / 128, NTM = NTOK / 128;
  TileSched ts = tile_begin(NTM, NTN, p.ws + O_BAR, xcd_words(smem)); int tm, tn;
  while (tile_next(ts, tm, tn)) {
    const int m0 = tm * 128, n0 = tn * 128;
    f4 a1[4][4], a2[4][4]; zero_acc<4>(a1); zero_acc<4>(a2);
    gemm_mainloop<128, 64>(a1, P1 + C_QA, LP1, WpaT, 512, 512, m0, n0, smem);
    gemm_mainloop<128, 64>(a2, ob, 512, WpbT, 512, 512, m0, n0, smem);
    hf* t1 = (hf*)smem; hf* t2 = t1 + 128 * TLD;
    __syncthreads();
#pragma unroll
    for (int mt = 0; mt < 4; ++mt)
#pragma unroll
      for (int nt = 0; nt < 4; ++nt)
#pragma unroll
        for (int r = 0; r < 4; ++r) {
          const int lrow = wm * 64 + mt * 16 + q * 4 + r, lcol = wn * 64 + nt * 16 + cl;
          t1[lrow * TLD + lcol] = (hf)a1[mt][nt][r]; t2[lrow * TLD + lcol] = (hf)a2[mt][nt][r];
        }
    __syncthreads();
    {
      const int tid = get_tid();
#pragma unroll
      for (int i = 0; i < 8; ++i) {
        const int idx = tid + i * 256, row = idx >> 4, ch = idx & 15;
        const size_t grow = (size_t)(m0 + row);
        const h8 v1 = *(const h8*)(t1 + row * TLD + ch * 8), v2 = *(const h8*)(t2 + row * TLD + ch * 8);
        const h8 sa = *(const h8*)(P4 + grow * LP4 + n0 + ch * 8), sb = *(const h8*)(P4 + grow * LP4 + DM + n0 + ch * 8);
        h8 o;
#pragma unroll
        for (int e = 0; e < 8; ++e) o[e] = (hf)((float)sa[e] * (float)v1[e] + (float)sb[e] * (float)v2[e]);
        *(h8*)(merged + pr32_off((int)grow, n0 + ch * 8, DM)) = o;
      }
    }
  }
}
DI void phase_F2(const Params& p, char* smem) {
  const hf* merged = (const hf*)(p.ws + O_MERGED); const hf* WoT = (const hf*)(p.ws + O_WO); const float* mod = (const float*)(p.ws + O_MOD);
  const int lane = get_tid() & 63, wave = get_tid() >> 6, wm = wave >> 1, wn = wave & 1, q = lane >> 4, cl = lane & 15;
  constexpr int CBM = 256, CMT = CBM / 32, NTN = DM / 128, NTM = NTOK / CBM;
  TileSched ts = tile_begin(NTM, NTN, p.ws + O_BAR, xcd_words(smem)); int tm, tn;
  while (tile_next(ts, tm, tn)) {
    const int m0 = tm * CBM, n0 = tn * 128;
    f4 acc[CMT][4]; zero_acc<CMT>(acc);
    gemm_mainloop_2set<CBM, false>(acc, merged, WoT, DM, m0, n0, smem);
    hf* t1 = (hf*)smem;
    __syncthreads();
#pragma unroll
    for (int mt = 0; mt < CMT; ++mt)
#pragma unroll
      for (int nt = 0; nt < 4; ++nt)
#pragma unroll
        for (int r = 0; r < 4; ++r) t1[(wm * (CBM / 2) + mt * 16 + q * 4 + r) * TLD + wn * 64 + nt * 16 + cl] = (hf)acc[mt][nt][r];
    __syncthreads();
    {
      const int tid = get_tid();
#pragma unroll
      for (int i = 0; i < CBM / 16; ++i) {
        const int idx = tid + i * 256, row = idx >> 4, ch = idx & 15;
        const size_t grow = (size_t)(m0 + row); const int b = (int)(grow / SEQ), col = n0 + ch * 8;
        const h8 y = *(const h8*)(t1 + row * TLD + ch * 8);
        const float* xp = p.x + grow * DM + col; const float* gp = mod + (size_t)b * 6 * DM + 2 * DM + col; hf* op = (hf*)(p.ws + O_H16) + grow * DM + col;
        const f4 x0 = NTLD4(xp), x1 = NTLD4(xp + 4), g0 = *(const f4*)gp, g1 = *(const f4*)(gp + 4);
        h8 o;
#pragma unroll
        for (int e = 0; e < 4; ++e) { o[e] = (hf)(x0[e] + g0[e] * (float)y[e]); o[4 + e] = (hf)(x1[e] + g1[e] * (float)y[4 + e]); }
        *(h8*)op = o;
      }
    }
  }
}
DI float quant_row_store(const float (&v)[DM / 64], unsigned char* dst, int lane, int bias) {
  float mx = 0.f;
#pragma unroll
  for (int i = 0; i < DM / 64; ++i) mx = fmaxf(mx, fabsf(v[i]));
#pragma unroll
  for (int m = 32; m >= 1; m >>= 1) mx = fmaxf(mx, __shfl_xor(mx, m));
  const float sc = mx > 0.f ? mx * (1.0f / 127.0f) : 1.0f, inv = 1.0f / sc;
#pragma unroll
  for (int i = 0; i < DM / 256; ++i) {
    unsigned w = 0;
#pragma unroll
    for (int j = 0; j < 4; ++j) { int qv = (int)rintf(v[4 * i + j] * inv); qv = qv > 127 ? 127 : (qv < -127 ? -127 : qv); w |= ((unsigned)(qv + bias) & 255u) << (8 * j); }
    *(unsigned*)(dst + i * 256 + lane * 4) = w;
  }
  return sc;
}
template <int MODE> DI void quant4_row_store(const float (&v)[DM / 64], unsigned char* dst, int lane, float& sc_o, float& mn_o) {
  float mx = v[0], mn = v[0];
#pragma unroll
  for (int i = 1; i < DM / 64; ++i) { mx = fmaxf(mx, v[i]); mn = fminf(mn, v[i]); }
#pragma unroll
  for (int m = 32; m >= 1; m >>= 1) { mx = fmaxf(mx, __shfl_xor(mx, m)); mn = fminf(mn, __shfl_xor(mn, m)); }
  {
    float s1 = 0.f, s2 = 0.f;
#pragma unroll
    for (int i = 0; i < DM / 64; ++i) { s1 += v[i]; s2 += v[i] * v[i]; }
    s1 = wave_sum(s1); s2 = wave_sum(s2);
    const float mean = s1 * (1.0f / DM), sd = sqrtf(fmaxf(s2 * (1.0f / DM) - mean * mean, 0.f));
    mn = fmaxf(mn, mean - 2.514f * sd); mx = fminf(mx, mean + 2.514f * sd);
  }
  const float sc = mx > mn ? (mx - mn) * (1.0f / 15.0f) : 1.0f, inv = 1.0f / sc;
#pragma unroll
  for (int i = 0; i < DM / 256; ++i) {
    unsigned nq = 0;
#pragma unroll
    for (int j = 0; j < 4; ++j) { int qv = (int)rintf((v[4 * i + j] - mn) * inv); qv = qv > 15 ? 15 : (qv < 0 ? 0 : qv);
      if (MODE == 0) nq |= (unsigned)qv << (8 * j);
      else { const int t = 4 * (lane & 1) + j; nq |= (unsigned)qv << (4 * ((t & 1) * 4 + (t >> 1))); } }
    const unsigned pn = __shfl_xor(nq, 1);
    if ((lane & 1) == 0) *(unsigned*)(dst + (i * 32 + (lane >> 1)) * 4) = (MODE == 0) ? (nq | (pn << 4)) : (nq | pn);
  }
  sc_o = sc; mn_o = mn;
}
DI void phase_F3(const Params& p) {
  const int tid = get_tid(), lane = tid & 63, wave = tid >> 6;
  const float* mod = (const float*)(p.ws + O_MOD);
  unsigned char* u8 = (unsigned char*)(p.uv + UV_U8); unsigned char* v8 = (unsigned char*)(p.uv + UV_V8); unsigned char* n2q = (unsigned char*)(p.uv + UV_N2Q);
  float* su = (float*)(p.uv + UV_SU); float* sv = (float*)(p.uv + UV_SV); float* sn = (float*)(p.uv + UV_SN);
  for (int row = blockIdx.x * 4 + wave; row < NTOK + 2 * NEXP; row += gridDim.x * 4) {
    float v[DM / 64];
    if (row < NTOK) {
      const hf* xr = (const hf*)(p.ws + O_H16) + (size_t)row * DM; const int b = row / SEQ; float ss = 0.f;
#pragma unroll
      for (int i = 0; i < DM / 256; ++i) { const h4 t4 = *(const h4*)(xr + i * 256 + lane * 4); f4 t = {(float)t4[0], (float)t4[1], (float)t4[2], (float)t4[3]}; v[4 * i] = t[0]; v[4 * i + 1] = t[1]; v[4 * i + 2] = t[2]; v[4 * i + 3] = t[3]; ss += t[0] * t[0] + t[1] * t[1] + t[2] * t[2] + t[3] * t[3]; }
      ss = wave_sum(ss);
      const float rstd = rsqrtf(ss * (1.0f / DM) + EPSN);
      const float* mb = mod + (size_t)b * 6 * DM;
#pragma unroll
      for (int i = 0; i < DM / 256; ++i) {
        const int d = i * 256 + lane * 4;
#pragma unroll
        for (int j = 0; j < 4; ++j) v[4 * i + j] = v[4 * i + j] * rstd * (1.0f + mb[4 * DM + d + j]) + mb[3 * DM + d + j];
      }
      const float sc = quant_row_store(v, n2q + (size_t)row * DM, lane, 0);
      if (lane == 0) sn[row] = sc;
    } else {
      const bool isu = row < NTOK + NEXP; const int e = isu ? row - NTOK : row - NTOK - NEXP;
      const float* xr = (isu ? p.pu : p.pv) + (size_t)e * DM;
#pragma unroll
      for (int i = 0; i < DM / 256; ++i) { f4 t = NTLD4(xr + i * 256 + lane * 4); v[4 * i] = t[0]; v[4 * i + 1] = t[1]; v[4 * i + 2] = t[2]; v[4 * i + 3] = t[3]; }
      float sc, mn;
      if (isu) { quant4_row_store<0>(v, u8 + (size_t)e * (DM / 2), lane, sc, mn); if (lane == 0) { su[2 * e] = sc; su[2 * e + 1] = mn; } }
      else { quant4_row_store<1>(v, v8 + (size_t)e * (DM / 2), lane, sc, mn); if (lane == 0) { sv[2 * e] = sc; sv[2 * e + 1] = mn; } }
    }
  }
}
DI void cmpx_desc(unsigned& hi, unsigned& lo) { const unsigned x = hi, y = lo; hi = x > y ? x : y; lo = x > y ? y : x; }
DI void bitonic_merge16(unsigned (&v)[16]) {
#pragma unroll
  for (int j = 8; j > 0; j >>= 1)
#pragma unroll
    for (int i = 0; i < 16; ++i) { const int l = i ^ j; if (l > i) cmpx_desc(v[i], v[l]); }
}
DI void bitonic_sort16(unsigned (&v)[16]) {
#pragma unroll
  for (int k = 2; k <= 16; k <<= 1)
#pragma unroll
    for (int j = k >> 1; j > 0; j >>= 1)
#pragma unroll
      for (int i = 0; i < 16; ++i) { const int l = i ^ j; if (l > i) { if ((i & k) == 0) cmpx_desc(v[i], v[l]); else cmpx_desc(v[l], v[i]); } }
}
DI void phase_G1(const Params& p, char* smem) {
  const hf* subk = (const hf*)(p.ws + O_SUBK);
  int* experts = (int*)(p.ws + O_P4); float* gates = (float*)(p.ws + O_P4 + (size_t)NTOK * 128 * 4);
  const float* sn_ = (const float*)(p.uv + UV_SN); const float* sq8 = (const float*)(p.ws + O_SQ8);
  const int tid = get_tid(), lane = tid & 63, wave = tid >> 6, wm = wave >> 1, wn = wave & 1, q = lane >> 4, cl = lane & 15;
  constexpr int NTM = NTOK / 128;
  hf* qt = (hf*)smem;
  float* sb = (float*)smem;
  unsigned* tl = (unsigned*)(smem + 2 * 64 * 129 * 4);
  TileSched ts = tile_begin(NTM, 8, p.ws + O_BAR, xcd_words(smem)); int tm, tn;
  while (tile_next(ts, tm, tn)) {
    const int hh = tn, mbase = tm * 128, n0 = hh * 128;
    f4 acc[4][4]; zero_acc<4>(acc);
    gemm_mainloop_r3<128, true>(acc, (const hf*)(p.uv + UV_N2Q), DM / 2, (const hf*)(p.ws + O_WQ8), DM / 2, DM / 2, mbase, n0, smem);
    for (int half = 0; half < 2; ++half) {
    const int m0 = mbase + half * 64;
    __syncthreads();
    if (wm == half) {
#pragma unroll
      for (int mt = 0; mt < 4; ++mt)
#pragma unroll
        for (int nt = 0; nt < 4; ++nt)
#pragma unroll
          for (int r = 0; r < 4; ++r) { const int row = mt * 16 + q * 4 + r, col = wn * 64 + nt * 16 + cl; const i4 ai = __builtin_bit_cast(i4, acc[mt][nt]);
            qt[row * 136 + col] = (hf)((float)ai[r] * (sn_[m0 + row] * sq8[n0 + col])); }
    }
    __syncthreads();
    const int pp = wave & 1, mh = wave >> 1;
    h8 af[2][2];
#pragma unroll
    for (int mt = 0; mt < 2; ++mt)
#pragma unroll
      for (int ks = 0; ks < 2; ++ks) af[mt][ks] = *(const h8*)(qt + (mh * 32 + mt * 16 + cl) * 136 + pp * 64 + ks * 32 + q * 8);
    __syncthreads();
    const hf* skp = subk + (size_t)(hh * 2 + pp) * 128 * 64;
#pragma unroll
    for (int nt = 0; nt < 8; ++nt) {
      h8 b0 = *(const h8*)(skp + (nt * 16 + cl) * 64 + q * 8), b1 = *(const h8*)(skp + (nt * 16 + cl) * 64 + 32 + q * 8);
#pragma unroll
      for (int mt = 0; mt < 2; ++mt) {
        f4 s = f4{0, 0, 0, 0};
        s = mfma16(af[mt][0], b0, s); s = mfma16(af[mt][1], b1, s);
#pragma unroll
        for (int r = 0; r < 4; ++r) sb[(pp * 64 + mh * 32 + mt * 16 + q * 4 + r) * 129 + nt * 16 + cl] = s[r];
      }
    }
    __syncthreads();
    {
      const int rp = tid >> 1, sub = tid & 1;
      const float* sr = sb + rp * 129 + sub * 64;
      unsigned top[16];
#pragma unroll
      for (int g = 0; g < 4; ++g) {
        unsigned v[16];
#pragma unroll
        for (int i = 0; i < 16; ++i) { const int n = sub * 64 + g * 16 + i; v[i] = (f2ord(sr[g * 16 + i]) & ~127u) | (unsigned)(127 - n); }
        bitonic_sort16(v);
        if (g == 0) {
#pragma unroll
          for (int i = 0; i < 16; ++i) top[i] = v[i];
        } else {
#pragma unroll
          for (int i = 0; i < 16; ++i) top[i] = top[i] > v[15 - i] ? top[i] : v[15 - i];
          bitonic_merge16(top);
        }
      }
      unsigned oth[16];
#pragma unroll
      for (int i = 0; i < 16; ++i) oth[i] = __shfl_xor(top[i], 1);
#pragma unroll
      for (int i = 0; i < 16; ++i) top[i] = top[i] > oth[15 - i] ? top[i] : oth[15 - i];
      bitonic_merge16(top);
      if (sub == 0) {
#pragma unroll
        for (int i = 0; i < 16; ++i) tl[rp * 16 + i] = top[i];
      }
    }
    __syncthreads();
    {
      const int tid2 = get_tid();
      const int rp = tid2 >> 2, sub = tid2 & 3;
      constexpr unsigned long long PT0 = 0x7060504030201000ull;
      constexpr unsigned long long PT1 = 0xf0e0d0c0b0a09080ull;
      constexpr unsigned long long PT2 = 0x7161514131211101ull;
      constexpr unsigned long long PT3 = 0x2313034232221202ull;
      constexpr unsigned long long PT4 = 0x1606150524140433ull;
      constexpr unsigned long long PT5 = 0x0d0c0b0a09081707ull;
      constexpr unsigned long long PT6 = 0xffffffffffff0f0eull;
      constexpr unsigned long long PT7 = 0xffffffffffffffffull;
      const unsigned long long wlo = sub == 0 ? PT0 : sub == 1 ? PT2 : sub == 2 ? PT4 : PT6;
      const unsigned long long whi = sub == 0 ? PT1 : sub == 1 ? PT3 : sub == 2 ? PT5 : PT7;
      const unsigned* t1 = tl + rp * 16; const unsigned* t2 = tl + (64 + rp) * 16;
      unsigned top[16];
#pragma unroll
      for (int s = 0; s < 16; ++s) {
        const unsigned e = (unsigned)(((s < 8 ? wlo : whi) >> (8 * (s & 7))) & 255ull);
        const int i = e & 15, j = (e >> 4) & 15;
        const float v = ord2f(t1[i] & ~127u) + ord2f(t2[j] & ~127u);
        top[s] = (e == 255u) ? 0u : ((f2ord(v) & ~255u) | (unsigned)(255 - (i * 16 + j)));
      }
      bitonic_sort16(top);
#pragma unroll
      for (int x = 1; x <= 2; x <<= 1) {
        unsigned oth[16];
#pragma unroll
        for (int i = 0; i < 16; ++i) oth[i] = __shfl_xor(top[i], x);
#pragma unroll
        for (int i = 0; i < 16; ++i) top[i] = top[i] > oth[15 - i] ? top[i] : oth[15 - i];
        bitonic_merge16(top);
      }
      float vals[16], sm = 0.f;
#pragma unroll
      for (int s = 0; s < 16; ++s) vals[s] = ord2f(top[s] & ~255u);
      const float mx = vals[0];
#pragma unroll
      for (int s = 0; s < 16; ++s) { vals[s] = __expf(vals[s] - mx); sm += vals[s]; }
      const float inv = 1.0f / sm;
      i4 eo; f4 go;
#pragma unroll
      for (int t = 0; t < 4; ++t) {
        const unsigned k = sub == 0 ? top[t] : sub == 1 ? top[4 + t] : sub == 2 ? top[8 + t] : top[12 + t];
        const float g = sub == 0 ? vals[t] : sub == 1 ? vals[4 + t] : sub == 2 ? vals[8 + t] : vals[12 + t];
        const int ci = 255 - (int)(k & 255u);
        const int e1 = 127 - (int)(t1[ci >> 4] & 127u), e2 = 127 - (int)(t2[ci & 15] & 127u);
        eo[t] = e1 * 128 + e2; go[t] = g * inv;
      }
      const size_t ob_ = ((size_t)(m0 + rp) * 8 + hh) * 16 + sub * 4;
      *(i4*)(experts + ob_) = eo; *(f4*)(gates + ob_) = go;
    }
  }
  }
}
#ifdef EMU
DI h2 pkfma(h2 a, h2 b, h2 c) { return a * b + c; }
#else
DI h2 pkfma(h2 a, h2 b, h2 c) { return __builtin_elementwise_fma(a, b, c); }
#endif
constexpr int VPL = DM / 64;
constexpr int G2_WAVE_LDS = 128 * 8 + 128 * 4;
DI void phase_G2(const Params& p, char* smem, bool dry) {
  const unsigned char* u8 = (const unsigned char*)(p.uv + UV_U8); const unsigned char* v8 = (const unsigned char*)(p.uv + UV_V8); const unsigned char* n2q = (const unsigned char*)(p.uv + UV_N2Q);
  const float* su = (const float*)(p.uv + UV_SU); const float* sv = (const float*)(p.uv + UV_SV); const float* sn = (const float*)(p.uv + UV_SN);
  const int* experts = (const int*)(p.ws + O_P4); const float* gates = (const float*)(p.ws + O_P4 + (size_t)NTOK * 128 * 4);
  const float* mod = (const float*)(p.ws + O_MOD);
  const int tid = get_tid(), lane = tid & 63, wave = tid >> 6, half = lane >> 5, li = lane & 31;
  char* wl = smem + wave * G2_WAVE_LDS;
  unsigned* coef2 = (unsigned*)wl; int* eix = (int*)(wl + 1024);
  constexpr int DW = VPL / 4;
  const int tok0 = blockIdx.x * 4 + wave;
  int e0n = 0, e1n = 0; float sntn = 0.f; int xqn[2 * DW];
  { const int tc = tok0 < NTOK ? tok0 : NTOK - 1;
    e0n = experts[(size_t)tc * 128 + lane]; e1n = experts[(size_t)tc * 128 + 64 + lane]; sntn = sn[tc];
#pragma unroll
    for (int w = 0; w < 2 * DW; ++w) xqn[w] = ((const int*)(n2q + (size_t)tc * DM + li * (8 * DW)))[w]; }
  for (int tok = tok0; tok < NTOK; tok += gridDim.x * 4) {
    const int b = tok / SEQ;
    wave_sync();
    eix[lane] = e0n; eix[64 + lane] = e1n;
    const float snt = sntn;
    int xq[2 * DW];
#pragma unroll
    for (int w = 0; w < 2 * DW; ++w) xq[w] = xqn[w];
    int sxq = 0;
#pragma unroll
    for (int w = 0; w < 2 * DW; ++w) sxq = __builtin_amdgcn_sdot4(xq[w], 0x01010101, sxq, false);
#pragma unroll
    for (int m = 16; m >= 1; m >>= 1) sxq += __shfl_xor(sxq, m);
    const float fsx = (float)sxq;
    wave_sync();
    float cmn = 0.f;
    for (int eb = 0; eb < 2; ++eb) {
      int part[32];
      const int em = eb * 64 + lane; const int eim = eix[em];
      const float su_e = su[2 * eim], mu_e = su[2 * eim + 1], sv_e = sv[2 * eim], mv_e = sv[2 * eim + 1], g_e = gates[(size_t)tok * 128 + em];
#pragma unroll
      for (int e = 0; e < 32; ++e) {
        const unsigned* ur = (const unsigned*)(u8 + (size_t)eix[eb * 64 + half * 32 + e] * (DM / 2) + li * (4 * DW));
        int acc = 0;
#pragma unroll
        for (int k = 0; k < DW; ++k) { const unsigned w = ur[k];
          acc = __builtin_amdgcn_sdot4((int)(w & 0x0F0F0F0Fu), xq[2 * k], acc, false);
          acc = __builtin_amdgcn_sdot4((int)((w >> 4) & 0x0F0F0F0Fu), xq[2 * k + 1], acc, false); }
        part[e] = acc;
      }
      const bool b4 = (lane & 16) != 0, b3 = (lane & 8) != 0, b2 = (lane & 4) != 0, b1 = (lane & 2) != 0, b0 = (lane & 1) != 0;
      int r16[16], r8[8], r4[4], r2[2];
#pragma unroll
      for (int i = 0; i < 16; ++i) { const int snd = b4 ? part[i] : part[16 + i], kp = b4 ? part[16 + i] : part[i]; r16[i] = kp + __shfl_xor(snd, 16); }
#pragma unroll
      for (int i = 0; i < 8; ++i) { const int snd = b3 ? r16[i] : r16[8 + i], kp = b3 ? r16[8 + i] : r16[i]; r8[i] = kp + __shfl_xor(snd, 8); }
#pragma unroll
      for (int i = 0; i < 4; ++i) { const int snd = b2 ? r8[i] : r8[4 + i], kp = b2 ? r8[4 + i] : r8[i]; r4[i] = kp + __shfl_xor(snd, 4); }
#pragma unroll
      for (int i = 0; i < 2; ++i) { const int snd = b1 ? r4[i] : r4[2 + i], kp = b1 ? r4[2 + i] : r4[i]; r2[i] = kp + __shfl_xor(snd, 2); }
      const int r1 = (b0 ? r2[1] : r2[0]) + __shfl_xor(b0 ? r2[0] : r2[1], 1);
      { const float av = ((float)r1 * su_e + fsx * mu_e) * snt;
        const float cr = 0.5f * av * (1.0f + erff(av * 0.70710678118654752f)) * g_e, cs = cr * sv_e;
        cmn += cr * mv_e;
        const hf ca = (hf)(cs * 16384.0f), cb = (hf)(cs * 1024.0f);
        h2 pa = {ca, ca}, pb = {cb, cb};
        coef2[2 * em] = __builtin_bit_cast(unsigned, pa); coef2[2 * em + 1] = __builtin_bit_cast(unsigned, pb); }
    }
    wave_sync();
    { const int tn = tok + gridDim.x * 4; const int tc = tn < NTOK ? tn : NTOK - 1;
      e0n = experts[(size_t)tc * 128 + lane]; e1n = experts[(size_t)tc * 128 + 64 + lane]; sntn = sn[tc];
#pragma unroll
      for (int w = 0; w < 2 * DW; ++w) xqn[w] = ((const int*)(n2q + (size_t)tc * DM + li * (8 * DW)))[w]; }
    const int dbase = li * (8 * DW) + half * (4 * DW);
    float hres[VPL], mg[VPL];
#pragma unroll
    for (int i = 0; i < VPL; ++i) { hres[i] = (float)((const hf*)(p.ws + O_H16))[(size_t)tok * DM + dbase + i]; mg[i] = mod[(size_t)b * 6 * DM + 5 * DM + dbase + i]; }
    cmn = wave_sum(cmn);
    h2 ya[4 * DW];
#pragma unroll
    for (int i = 0; i < 4 * DW; ++i) ya[i] = (h2){(hf)0.f, (hf)0.f};
#pragma unroll 8
    for (int e = 0; e < 64; ++e) {
      const int row = 2 * e + half;
      const unsigned* vr = (const unsigned*)(v8 + (size_t)eix[row] * (DM / 2) + li * (4 * DW));
      const h2 ca = __builtin_bit_cast(h2, coef2[2 * row]), cb = __builtin_bit_cast(h2, coef2[2 * row + 1]);
#pragma unroll
      for (int k = 0; k < DW; ++k) { const unsigned w = vr[k], w8 = w >> 8;
        ya[4 * k + 0] = pkfma(__builtin_bit_cast(h2, w & 0x000F000Fu), ca, ya[4 * k + 0]);
        ya[4 * k + 1] = pkfma(__builtin_bit_cast(h2, w & 0x00F000F0u), cb, ya[4 * k + 1]);
        ya[4 * k + 2] = pkfma(__builtin_bit_cast(h2, w8 & 0x000F000Fu), ca, ya[4 * k + 2]);
        ya[4 * k + 3] = pkfma(__builtin_bit_cast(h2, w8 & 0x00F000F0u), cb, ya[4 * k + 3]); }
    }
    float y[VPL];
#pragma unroll
    for (int i = 0; i < 2 * DW; ++i) {
      const unsigned snd = __builtin_bit_cast(unsigned, half ? ya[i] : ya[2 * DW + i]);
      const h2 oth = __builtin_bit_cast(h2, (unsigned)__shfl_xor((int)snd, 32));
      const h2 mine = half ? ya[2 * DW + i] : ya[i];
      y[2 * i] = ((float)mine[0] + (float)oth[0]) * 1024.0f + cmn; y[2 * i + 1] = ((float)mine[1] + (float)oth[1]) * 1024.0f + cmn;
    }
    float hv[VPL]; float ss = 0.f;
#pragma unroll
    for (int i = 0; i < VPL; ++i) { const float v = hres[i] + mg[i] * y[i]; hv[i] = v; ss += v * v; }
    ss = wave_sum(ss);
    const float rstd = rsqrtf(ss * (1.0f / DM) + EPSN);
#pragma unroll
    for (int i4_ = 0; i4_ < VPL / 4; ++i4_) {
      f4 ov;
#pragma unroll
      for (int j = 0; j < 4; ++j) { const int d = dbase + i4_ * 4 + j; ov[j] = hv[i4_ * 4 + j] * rstd * p.fnw[d]; }
      if (dry) { h4 oh; oh[0] = (hf)ov[0]; oh[1] = (hf)ov[1]; oh[2] = (hf)ov[2]; oh[3] = (hf)ov[3]; *(h4*)((hf*)(p.ws + O_MERGED) + (size_t)tok * DM + dbase + i4_ * 4) = oh; }
#ifdef EMU
      else *(f4*)(p.out + (size_t)tok * DM + dbase + i4_ * 4) = ov;
#else
      else __builtin_nontemporal_store(ov, (f4*)(p.out + (size_t)tok * DM + dbase + i4_ * 4));
#endif
    }
  }
}

constexpr int cmax(int a, int b) { return a > b ? a : b; }
constexpr int LDS_GEMM = cmax(cmax((128 + 128) * (GBK_MAX + 8) * 2, 2 * 128 * TLD * 2), 256 * TLD * 2);
constexpr int LDS_A = cmax(64 * 65 * 4, (BATCH * DM + 4 * BATCH * 64) * 4);
constexpr int LDS_D1 = 2 * 64 * 72 * 2 + 64 * 128 * 4 + 64 * 64 * 4 + 512;
constexpr int LDS_E2 = 16 + 4 * E2_WAVE_LDS + 2 * 64 * 72 * 2;
constexpr int LDS_G1 = 2 * 64 * 129 * 4 + 2 * 64 * 16 * 4;
constexpr int LDS_G2 = 4 * G2_WAVE_LDS;
constexpr int SMEM_BYTES = cmax(cmax(cmax(LDS_GEMM, LDS_A), cmax(LDS_D1, LDS_E2)), cmax(cmax(LDS_G1, LDS_G2), LDS_E1));
constexpr int NPHASE = 11;
DI const volatile unsigned* xcd_words(char* smem) { return (const volatile unsigned*)(smem + SMEM_BYTES); }

DI void run_phase(const Params& p, int ph, char* smem, bool dry) {
  switch (ph) {
    case 0: phase_A(p, smem); break;
    case 1: phase_B(p); break;
    case 2: phase_C(p, smem); break;
    case 3: phase_D1(p, smem); break;
    case 4: if (!dry) phase_E1(p, smem); phase_E2(p, smem, dry); break;
    case 5: break;
    case 6: phase_F1(p, smem); break;
    case 7: phase_F2(p, smem); break;
    case 8: phase_F3(p); break;
    case 9: phase_G1(p, smem); break;
    case 10: phase_G2(p, smem, dry); break;
  }
}

#ifdef EMU
static void emu_kernel_all(void* arg) {
  const Params& p = *(const Params*)arg; char* smem = emu_cur->blk->smem;
  for (int ph = 0; ph < NPHASE; ++ph) { run_phase(p, ph, smem, false); emu_grid_sync(); }
}
#else
template <int PH> __global__ void __launch_bounds__(256, 2) phase_kernel(Params p) {
  __shared__ __attribute__((aligned(16))) char smem[SMEM_BYTES + 16];
  run_phase(p, PH, smem, false);
}
#if !MULTI_LAUNCH
#ifndef PROBE_DUP
#define PROBE_DUP 0
#endif
__global__ void __launch_bounds__(256, 2) mega_kernel(Params p) {
  __shared__ __attribute__((aligned(16))) char smem[SMEM_BYTES + 16];
  cooperative_groups::grid_group grid = cooperative_groups::this_grid();
  volatile LAS unsigned* st = (volatile LAS unsigned*)(smem + SMEM_BYTES);
  g_wtab[hw_wave_key()] = (unsigned char)(threadIdx.x >> 6);
  if (threadIdx.x == 0) { st[0] = 0u; st[1] = 0u; }
  __syncthreads();
  if (PROBE_DUP & 1) run_phase(p, 0, smem, false);
  run_phase(p, 0, smem, false);
  grid.sync();
  XcdBarrier xb = xcd_barrier_post((unsigned*)(p.ws + O_BAR), st);
#define XBAR() { xcd_barrier(xb); if (PROBE_BAR2) xcd_barrier(xb); }
#define PH(k) { if (PROBE_DUP & (1 << (k))) { run_phase(p, (k), smem, true); xcd_barrier(xb); } run_phase(p, (k), smem, false); }
  PH(1); XBAR(); PH(2); XBAR(); PH(3); XBAR(); PH(4); XBAR();
  PH(6); XBAR(); PH(7); XBAR(); PH(8); XBAR(); PH(9); XBAR(); PH(10);
#undef PH
}
#endif
#endif

extern "C" void kernel_launch(void* const* d_in, const int* in_sizes, int n_in, void* d_out, int out_size, void* d_ws, size_t ws_size, hipStream_t stream) {
  Params p{};
  p.x = (const float*)d_in[0]; p.c = (const float*)d_in[1]; p.pos = (const int*)d_in[2]; p.w_ada = (const float*)d_in[3]; p.b_ada = (const float*)d_in[4];
  p.w_in = (const float*)d_in[5]; p.conv_w = (const float*)d_in[6]; p.a_log = (const float*)d_in[7]; p.dt_bias = (const float*)d_in[8]; p.norm_b_w = (const float*)d_in[9];
  p.w_pa = (const float*)d_in[10]; p.w_pb = (const float*)d_in[11]; p.w_o = (const float*)d_in[12]; p.wq = (const float*)d_in[13]; p.subk = (const float*)d_in[14];
  p.pu = (const float*)d_in[15]; p.pv = (const float*)d_in[16]; p.fnw = (const float*)d_in[17];
  p.out = (float*)d_out; p.ws = (char*)d_ws;
#ifdef EMU
  const int grid = 4;
  p.dscan = p.ws + WS_TOTAL; p.uv = p.ws + WS_TOTAL + DSCAN_BYTES;
  if (WS_TOTAL + DSCAN_BYTES + UV_BYTES > ws_size) { fprintf(stderr, "ws too small\n"); exit(2); }
  if (O_SCR + (size_t)grid * QBT * SEQ * 4 > O_OB) { fprintf(stderr, "scratch overflow\n"); exit(2); }
  fprintf(stderr, "emu: SMEM_BYTES=%d WS_TOTAL=%zu\n", SMEM_BYTES, WS_TOTAL);
  emu_launch(emu_kernel_all, &p, grid, 256, SMEM_BYTES);
#else
  static_assert((size_t)NTOK * DM * 4 >= DSCAN_BYTES, "d_out too small for scan scratch");
  static_assert(UV_BYTES <= (size_t)NTOK * LP1 * 2, "P1 too small for expert tables");
  p.dscan = (char*)d_out; p.uv = p.ws + O_P1;
  static int grid = 0;
  if (!grid) {
    int dev = 0, cus = 0, per_cu = 0;
    hipGetDevice(&dev); hipDeviceGetAttribute(&cus, hipDeviceAttributeMultiprocessorCount, dev);
#if MULTI_LAUNCH
    hipOccupancyMaxActiveBlocksPerMultiprocessor(&per_cu, phase_kernel<5>, 256, 0);
#else
    hipOccupancyMaxActiveBlocksPerMultiprocessor(&per_cu, mega_kernel, 256, 0);
#endif
    if (per_cu > 2) per_cu = 2;
    if (per_cu < 1) per_cu = 1;
    grid = cus * per_cu;
    if (grid > 512) grid = 512;
  }
  if (WS_TOTAL > ws_size) { fprintf(stderr, "workspace too small: need %zu have %zu\n", WS_TOTAL, ws_size); return; }
#if MULTI_LAUNCH
  hipLaunchKernelGGL(phase_kernel<0>, dim3(grid), dim3(256), 0, stream, p);
  hipLaunchKernelGGL(phase_kernel<1>, dim3(grid), dim3(256), 0, stream, p);
  hipLaunchKernelGGL(phase_kernel<2>, dim3(grid), dim3(256), 0, stream, p);
  hipLaunchKernelGGL(phase_kernel<3>, dim3(grid), dim3(256), 0, stream, p);
  hipLaunchKernelGGL(phase_kernel<4>, dim3(grid), dim3(256), 0, stream, p);
  hipLaunchKernelGGL(phase_kernel<5>, dim3(grid), dim3(256), 0, stream, p);
  hipLaunchKernelGGL(phase_kernel<6>, dim3(grid), dim3(256), 0, stream, p);
  hipLaunchKernelGGL(phase_kernel<7>, dim3(grid), dim3(256), 0, stream, p);
  hipLaunchKernelGGL(phase_kernel<8>, dim3(grid), dim3(256), 0, stream, p);
  hipLaunchKernelGGL(phase_kernel<9>, dim3(grid), dim3(256), 0, stream, p);
  hipLaunchKernelGGL(phase_kernel<10>, dim3(grid), dim3(256), 0, stream, p);
#else
  void* args[] = {&p};
  hipError_t e = hipLaunchCooperativeKernel((void*)mega_kernel, dim3(grid), dim3(256), args, 0, stream);
  if (e != hipSuccess) fprintf(stderr, "cooperative launch failed: %s (grid %d)\n", hipGetErrorString(e), grid);
#endif
#endif
}
```
